# Optimizing an MI355X kernel written in HIP

```python
import jax, jax.numpy as jnp
from jax import lax
import numpy as np

D_MODEL = 1024
BATCH = 32
SEQ = 2048
DEPTH = 1

RMS_EPS = 1e-5
HEAD_DIM = 64
ATT_HEADS = D_MODEL // HEAD_DIM
ATT_KV_HEADS = 4
WINDOW = 128
BLOCK = 128
ROT_DIM = HEAD_DIM // 4
ROPE_THETA = 500000.0
RWKV_HEAD_DIM = 64
RWKV_HEADS = D_MODEL // RWKV_HEAD_DIM
RWKV_WIDTH = RWKV_HEADS * RWKV_HEAD_DIM
DECAY_LORA = 64
AAA_LORA = 64
GATE_LORA = 128
RWKV_GN_EPS = 64e-5
MEM_LEN = 256
CROSS_HEADS = 4
CROSS_HEAD_DIM = 128
PEER_HEADS = 8
N_KEYS = 128
N_EXPERTS = N_KEYS * N_KEYS
PEER_QUERY_DIM = 256
PEER_TOPK = 16
PEER_CHUNK = 128
ATT_Q_WIDTH = ATT_HEADS * HEAD_DIM
ATT_KV_WIDTH = ATT_KV_HEADS * HEAD_DIM
RWKV_IN_WIDTH = 3 * RWKV_WIDTH + DECAY_LORA + AAA_LORA + GATE_LORA
GATE_WIDTH = 2 * D_MODEL
IN_WIDTH = ATT_Q_WIDTH + 2 * ATT_KV_WIDTH + RWKV_IN_WIDTH + GATE_WIDTH

kernel_name = 'hybrid_swa_rwkv7_peer_block'


def rms_norm(x, g):
    xf = x.astype(jnp.float32)
    y = xf * lax.rsqrt(jnp.mean(xf * xf, axis=-1, keepdims=True) + RMS_EPS)
    return (y * g.astype(jnp.float32)).astype(x.dtype)


def partial_rope(x, positions):
    half = ROT_DIM // 2
    inv_freq = 1.0 / (ROPE_THETA ** (jnp.arange(0, ROT_DIM, 2, dtype=jnp.float32) / ROT_DIM))
    ang = positions.astype(jnp.float32)[..., None] * inv_freq
    cos = jnp.cos(ang)[:, :, None, :]
    sin = jnp.sin(ang)[:, :, None, :]
    xr = x[..., :ROT_DIM].astype(jnp.float32)
    x1, x2 = xr[..., :half], xr[..., half:]
    rot = jnp.concatenate([x1 * cos - x2 * sin, x2 * cos + x1 * sin], axis=-1)
    return jnp.concatenate([rot.astype(x.dtype), x[..., ROT_DIM:]], axis=-1)


def sliding_window_attention(q, k, v, sinks):
    B, S = q.shape[0], q.shape[1]
    nb = S // BLOCK
    G = ATT_HEADS // ATT_KV_HEADS
    qb = q.reshape(B, nb, BLOCK, ATT_KV_HEADS, G, HEAD_DIM).transpose(1, 0, 2, 3, 4, 5)

    def band_keys(t):
        tb = t.reshape(B, nb, BLOCK, ATT_KV_HEADS, HEAD_DIM)
        prev = jnp.pad(tb, ((0, 0), (1, 0), (0, 0), (0, 0), (0, 0)))[:, :-1]
        return jnp.concatenate([prev, tb], axis=2).transpose(1, 0, 2, 3, 4)

    kw, vw = band_keys(k), band_keys(v)
    i = jnp.arange(BLOCK)[:, None]
    j = jnp.arange(2 * BLOCK)[None, :]
    band = (j > i) & (j <= i + WINDOW)
    sink = sinks.astype(jnp.float32).reshape(ATT_KV_HEADS, G)[None, :, :, None, None]
    scale = HEAD_DIM ** -0.5

    def one_block(args):
        qn, kn, vn, n = args
        s = jnp.einsum('bqkgd,bskd->bkgqs', qn.astype(jnp.float32), kn.astype(jnp.float32)) * scale
        valid = band & (n * BLOCK - BLOCK + j >= 0)
        s = jnp.where(valid, s, -1e30)
        m = jnp.maximum(jnp.max(s, axis=-1, keepdims=True), sink)
        p = jnp.exp(s - m)
        denom = jnp.sum(p, axis=-1, keepdims=True) + jnp.exp(sink - m)
        o = jnp.einsum('bkgqs,bskd->bqkgd', p / denom, vn.astype(jnp.float32))
        return o.astype(qn.dtype)

    out = lax.map(one_block, (qb, kw, vw, jnp.arange(nb)))
    return out.transpose(1, 0, 2, 3, 4, 5).reshape(B, S, ATT_HEADS * HEAD_DIM)


def rwkv7_time_mix(p, mu, w0, w2, a0, a2, g2, k_k, k_a, r_k, ln_w, ln_b):
    B, S = p.shape[0], p.shape[1]
    H, N, W = RWKV_HEADS, RWKV_HEAD_DIM, RWKV_WIDTH
    prev = jnp.pad(p, ((0, 0), (1, 0), (0, 0)))[:, :-1]
    p = p + (prev - p) * mu
    r = p[..., :W]
    k = p[..., W:2 * W]
    v = p[..., 2 * W:3 * W]
    dw = p[..., 3 * W:3 * W + DECAY_LORA]
    da = p[..., 3 * W + DECAY_LORA:3 * W + DECAY_LORA + AAA_LORA]
    dg = p[..., 3 * W + DECAY_LORA + AAA_LORA:]
    w_log = -jax.nn.softplus(-(w0 + jnp.tanh(dw) @ w2).astype(jnp.float32)) - 0.5
    decay = jnp.exp(-jnp.exp(w_log))
    a = jax.nn.sigmoid((a0 + da @ a2).astype(jnp.float32))
    g = jax.nn.sigmoid(dg) @ g2
    hs = lambda t: t.astype(jnp.float32).reshape(B, S, H, N)
    kk = hs(k * k_k)
    kk = kk / jnp.maximum(jnp.sqrt(jnp.sum(kk * kk, axis=-1, keepdims=True)), 1e-12)
    k = k.astype(jnp.float32) * (1.0 + (a - 1.0) * k_a.astype(jnp.float32))
    rh, kh, vh, wh, ah = hs(r), hs(k), hs(v), hs(decay), hs(a)

    def step(state, inp):
        r_t, w_t, k_t, v_t, kk_t, a_t = inp
        sa = jnp.einsum('bhij,bhj->bhi', state, -kk_t)
        state = (state * w_t[:, :, None, :]
                 + sa[..., :, None] * (kk_t * a_t)[:, :, None, :]
                 + v_t[..., :, None] * k_t[:, :, None, :])
        return state, jnp.einsum('bhij,bhj->bhi', state, r_t)

    tmaj = lambda t: t.transpose(1, 0, 2, 3)
    state0 = jnp.zeros((B, H, N, N), jnp.float32)
    _, o = lax.scan(step, state0, (tmaj(rh), tmaj(wh), tmaj(kh), tmaj(vh), tmaj(kk), tmaj(ah)))
    o = o.transpose(1, 0, 2, 3)
    mean = jnp.mean(o, axis=-1, keepdims=True)
    var = jnp.mean(jnp.square(o - mean), axis=-1, keepdims=True)
    on = ((o - mean) * lax.rsqrt(var + RWKV_GN_EPS)).reshape(B, S, W)
    on = on * ln_w.astype(jnp.float32) + ln_b.astype(jnp.float32)
    bonus = (jnp.sum(rh * kh * r_k.astype(jnp.float32), axis=-1, keepdims=True) * vh).reshape(B, S, W)
    return ((on + bonus) * g.astype(jnp.float32)).astype(p.dtype)


def memory_cross_attention(xn, mem_n, w_q, w_kv, w_o):
    B, S = xn.shape[0], xn.shape[1]
    M = mem_n.shape[1]
    q = (xn @ w_q).reshape(B, S, CROSS_HEADS, CROSS_HEAD_DIM)
    kv = (mem_n @ w_kv).reshape(B, M, 2, CROSS_HEADS, CROSS_HEAD_DIM)
    k, v = kv[:, :, 0], kv[:, :, 1]
    s = jnp.einsum('bshd,bmhd->bhsm', q.astype(jnp.float32), k.astype(jnp.float32)) * (CROSS_HEAD_DIM ** -0.5)
    pr = jax.nn.softmax(s, axis=-1)
    o = jnp.einsum('bhsm,bmhd->bshd', pr, v.astype(jnp.float32)).reshape(B, S, CROSS_HEADS * CROSS_HEAD_DIM)
    return o.astype(xn.dtype) @ w_o


def peer_ffn(xn, w_q, sub_keys_1, sub_keys_2, u, v):
    B, S, D = xn.shape
    half = PEER_QUERY_DIM // 2
    xc = xn.reshape((B * S) // PEER_CHUNK, PEER_CHUNK, D)
    k1 = sub_keys_1.astype(jnp.float32)
    k2 = sub_keys_2.astype(jnp.float32)

    def one_chunk(xt):
        q = (xt @ w_q).reshape(PEER_CHUNK, PEER_HEADS, PEER_QUERY_DIM).astype(jnp.float32)
        s1 = jnp.einsum('chd,nd->chn', q[..., :half], k1)
        s2 = jnp.einsum('chd,nd->chn', q[..., half:], k2)
        v1, i1 = lax.top_k(s1, PEER_TOPK)
        v2, i2 = lax.top_k(s2, PEER_TOPK)
        cand = (v1[..., :, None] + v2[..., None, :]).reshape(PEER_CHUNK, PEER_HEADS, PEER_TOPK * PEER_TOPK)
        sc, ci = lax.top_k(cand, PEER_TOPK)
        e = (jnp.take_along_axis(i1, ci // PEER_TOPK, axis=-1) * N_KEYS
             + jnp.take_along_axis(i2, ci % PEER_TOPK, axis=-1))
        gate = jax.nn.softmax(sc, axis=-1)
        act = jax.nn.gelu(jnp.einsum('cd,chkd->chk', xt, u[e]).astype(jnp.float32), approximate=False)
        return jnp.einsum('chk,chkd->cd', (gate * act).astype(xt.dtype), v[e])

    return lax.map(one_chunk, xc).reshape(B, S, D)


def hybrid_layer(h, mem, positions, g_mix, w_in, attn_sinks, rwkv_mu, rwkv_w0, rwkv_w2, rwkv_a0,
                 rwkv_a2, rwkv_g2, rwkv_k_k, rwkv_k_a, rwkv_r_k, rwkv_ln_w, rwkv_ln_b, w_out,
                 g_cross, g_mem, w_q_cross, w_kv_cross, w_o_cross, g_ffn, peer_w_q,
                 peer_sub_keys_1, peer_sub_keys_2, peer_u, peer_v):
    B, S = h.shape[0], h.shape[1]
    xn = rms_norm(h, g_mix)
    proj = xn @ w_in
    o1 = ATT_Q_WIDTH
    o2 = o1 + ATT_KV_WIDTH
    o3 = o2 + ATT_KV_WIDTH
    o4 = o3 + RWKV_IN_WIDTH
    q = partial_rope(proj[..., :o1].reshape(B, S, ATT_HEADS, HEAD_DIM), positions)
    k = partial_rope(proj[..., o1:o2].reshape(B, S, ATT_KV_HEADS, HEAD_DIM), positions)
    v = proj[..., o2:o3].reshape(B, S, ATT_KV_HEADS, HEAD_DIM)
    attn = sliding_window_attention(q, k, v, attn_sinks)
    rwkv = rwkv7_time_mix(proj[..., o3:o4], rwkv_mu, rwkv_w0, rwkv_w2, rwkv_a0, rwkv_a2, rwkv_g2,
                          rwkv_k_k, rwkv_k_a, rwkv_r_k, rwkv_ln_w, rwkv_ln_b)
    gates = jax.nn.sigmoid(proj[..., o4:])
    mixed = gates[..., :D_MODEL] * attn + gates[..., D_MODEL:] * rwkv
    h = h + mixed @ w_out
    h = h + memory_cross_attention(rms_norm(h, g_cross), rms_norm(mem, g_mem), w_q_cross, w_kv_cross, w_o_cross)
    h = h + peer_ffn(rms_norm(h, g_ffn), peer_w_q, peer_sub_keys_1, peer_sub_keys_2, peer_u, peer_v)
    return h


def setup_inputs(seed: int = 0) -> dict:
    key = jax.random.key(seed)
    ks = jax.random.split(key, 32)
    f32 = jnp.float32
    nrm = lambda i, shape, s: jax.random.normal(ks[i], shape, f32) * s
    L, D = DEPTH, D_MODEL
    half = PEER_QUERY_DIM // 2
    offsets = jax.random.randint(ks[2], (BATCH, 1), 0, 4096, dtype=jnp.int32)
    return {
        'x': nrm(0, (BATCH, SEQ, D), 1.0),
        'mem': nrm(1, (BATCH, MEM_LEN, D), 1.0),
        'positions': offsets + jnp.arange(SEQ, dtype=jnp.int32)[None, :],
        'g_mix': 1.0 + nrm(3, (L, D), 0.02),
        'w_in': nrm(4, (L, D, IN_WIDTH), D ** -0.5),
        'attn_sinks': nrm(5, (L, ATT_HEADS), 0.5),
        'rwkv_mu': jax.random.uniform(ks[6], (L, RWKV_IN_WIDTH), f32),
        'rwkv_w0': -0.5 + nrm(7, (L, RWKV_WIDTH), 0.5),
        'rwkv_w2': nrm(8, (L, DECAY_LORA, RWKV_WIDTH), 0.1),
        'rwkv_a0': nrm(9, (L, RWKV_WIDTH), 0.1),
        'rwkv_a2': nrm(10, (L, AAA_LORA, RWKV_WIDTH), 0.1),
        'rwkv_g2': nrm(11, (L, GATE_LORA, RWKV_WIDTH), GATE_LORA ** -0.5),
        'rwkv_k_k': 0.85 + nrm(12, (L, RWKV_WIDTH), 0.02),
        'rwkv_k_a': 1.0 + nrm(13, (L, RWKV_WIDTH), 0.02),
        'rwkv_r_k': nrm(14, (L, RWKV_HEADS, RWKV_HEAD_DIM), 0.1),
        'rwkv_ln_w': 1.0 + nrm(15, (L, RWKV_WIDTH), 0.02),
        'rwkv_ln_b': nrm(16, (L, RWKV_WIDTH), 0.02),
        'w_out': nrm(17, (L, D, D), D ** -0.5),
        'g_cross': 1.0 + nrm(18, (L, D), 0.02),
        'g_mem': 1.0 + nrm(19, (L, D), 0.02),
        'w_q_cross': nrm(20, (L, D, CROSS_HEADS * CROSS_HEAD_DIM), D ** -0.5),
        'w_kv_cross': nrm(21, (L, D, 2 * CROSS_HEADS * CROSS_HEAD_DIM), D ** -0.5),
        'w_o_cross': nrm(22, (L, CROSS_HEADS * CROSS_HEAD_DIM, D), (CROSS_HEADS * CROSS_HEAD_DIM) ** -0.5),
        'g_ffn': 1.0 + nrm(23, (L, D), 0.02),
        'peer_w_q': nrm(24, (L, D, PEER_HEADS * PEER_QUERY_DIM), D ** -0.5),
        'peer_sub_keys_1': nrm(25, (L, N_KEYS, half), half ** -0.5),
        'peer_sub_keys_2': nrm(26, (L, N_KEYS, half), half ** -0.5),
        'peer_u': nrm(27, (L, N_EXPERTS, D), D ** -0.5),
        'peer_v': nrm(28, (L, N_EXPERTS, D), PEER_HEADS ** -0.5),
        'g_final': 1.0 + nrm(29, (D,), 0.02),
    }


def reference(x, mem, positions, g_mix, w_in, attn_sinks, rwkv_mu, rwkv_w0, rwkv_w2, rwkv_a0,
              rwkv_a2, rwkv_g2, rwkv_k_k, rwkv_k_a, rwkv_r_k, rwkv_ln_w, rwkv_ln_b, w_out,
              g_cross, g_mem, w_q_cross, w_kv_cross, w_o_cross, g_ffn, peer_w_q,
              peer_sub_keys_1, peer_sub_keys_2, peer_u, peer_v, g_final):
    h = x
    for layer in range(DEPTH):
        h = hybrid_layer(h, mem, positions, g_mix[layer], w_in[layer], attn_sinks[layer],
                         rwkv_mu[layer], rwkv_w0[layer], rwkv_w2[layer], rwkv_a0[layer],
                         rwkv_a2[layer], rwkv_g2[layer], rwkv_k_k[layer], rwkv_k_a[layer],
                         rwkv_r_k[layer], rwkv_ln_w[layer], rwkv_ln_b[layer], w_out[layer],
                         g_cross[layer], g_mem[layer], w_q_cross[layer], w_kv_cross[layer],
                         w_o_cross[layer], g_ffn[layer], peer_w_q[layer],
                         peer_sub_keys_1[layer], peer_sub_keys_2[layer], peer_u[layer], peer_v[layer])
    return rms_norm(h, g_final)
```

```cpp
#include <hip/hip_runtime.h>
#include <hip/hip_cooperative_groups.h>
#include <cstdio>
#include <cstdint>
namespace cg = cooperative_groups;

constexpr int D_MODEL = 1024, BATCH = 32, SEQ = 2048, T_TOK = BATCH * SEQ;
constexpr int IN_WIDTH = 6912, N_PROJA = 4864, RW_W = 3328;
constexpr int MEM_LEN = 256, MEM_ROWS = BATCH * MEM_LEN;
constexpr int N_EXPERTS = 16384;
constexpr float RMS_EPS = 1e-5f, LOG2E = 1.4426950408889634f;
constexpr int NTHREADS = 512, NWAVES = 8;
constexpr int LDS_BYTES = 160 * 1024;

constexpr size_t MiB = 1u << 20;
constexpr size_t WS_CTL = 0;
constexpr size_t WS_ROPE_C = 1 * MiB, WS_ROPE_S = 3 * MiB;
constexpr size_t WS_W2T = 5 * MiB, WS_A2T = WS_W2T + 131072, WS_G2T = WS_A2T + 131072;
constexpr size_t WS_PK1 = 6 * MiB, WS_PK2 = WS_PK1 + 32768;
constexpr size_t WS_WINA = 8 * MiB;
constexpr size_t WS_WING = 18 * MiB;
constexpr size_t WS_WOUT = 22 * MiB;
constexpr size_t WS_WQC = 24 * MiB;
constexpr size_t WS_WOC = 25 * MiB;
constexpr size_t WS_WKVC = 26 * MiB;
constexpr size_t WS_WPQ = 28 * MiB;
constexpr size_t WS_PU = 32 * MiB;
constexpr size_t WS_PV = 64 * MiB;
constexpr size_t WS_ACT0 = 48 * MiB, WS_ACT1 = 80 * MiB;
constexpr size_t WS_MEMN = 96 * MiB;
constexpr size_t WS_KVC = 112 * MiB;
constexpr size_t WS_XN = 128 * MiB;
constexpr size_t WS_H = WS_XN;
constexpr size_t WS_Q = 256 * MiB;
constexpr size_t WS_K = 384 * MiB;
constexpr size_t WS_V = 416 * MiB;
constexpr size_t WS_RW = 448 * MiB;
constexpr size_t WS_Y = 864 * MiB;
constexpr size_t WS_SSQ1 = 992 * MiB, WS_SSQ2 = 996 * MiB;
constexpr size_t WS_QC8 = 256 * MiB;
constexpr size_t WS_QC = 384 * MiB;
constexpr size_t WS_PQ = 448 * MiB;
constexpr size_t WS_RE = 704 * MiB;
constexpr size_t WS_RS = 736 * MiB;
constexpr size_t WS_END = 1024 * MiB;

#ifndef GATE_FP8
#define GATE_FP8 1
#endif
constexpr float GATE_WSCALE = 32.f;
#ifndef CROSS_FP8
#define CROSS_FP8 0
#endif
constexpr float CROSS_OSCALE = 16.f, CROSS_WSCALE = 16.f;
#define LAS __attribute__((address_space(3)))
typedef unsigned short bf16_t;
typedef short bf16x8 __attribute__((ext_vector_type(8)));
typedef float f32x4 __attribute__((ext_vector_type(4)));
typedef float f32x2 __attribute__((ext_vector_type(2)));
typedef float f32x16 __attribute__((ext_vector_type(16)));
typedef unsigned u32x4 __attribute__((ext_vector_type(4)));
typedef unsigned u32x2 __attribute__((ext_vector_type(2)));
typedef __bf16 bf16x2_t __attribute__((ext_vector_type(2)));
typedef __bf16 bf16x32_t __attribute__((ext_vector_type(32)));
typedef unsigned u32x6 __attribute__((ext_vector_type(6)));
typedef unsigned u32x16 __attribute__((ext_vector_type(16)));
typedef int i32x8g __attribute__((ext_vector_type(8)));
typedef int i32x6g __attribute__((ext_vector_type(6)));

__device__ __forceinline__ unsigned pk_bf16(float lo, float hi) { f32x2 v = {lo, hi}; bf16x2_t b = __builtin_convertvector(v, bf16x2_t); return __builtin_bit_cast(unsigned, b); }
__device__ __forceinline__ float bf_lo(unsigned u) { return __uint_as_float(u << 16); }
__device__ __forceinline__ float bf_hi(unsigned u) { return __uint_as_float(u & 0xffff0000u); }
__device__ __forceinline__ float bf1(bf16_t h) { return __uint_as_float((unsigned)h << 16); }
__device__ __forceinline__ float fast_exp2(float x) { return __builtin_amdgcn_exp2f(x); }
__device__ __forceinline__ float fast_rcp(float x) { return __builtin_amdgcn_rcpf(x); }
__device__ __forceinline__ float sigmoidf_(float x) { return fast_rcp(1.f + fast_exp2(-LOG2E * x)); }
template <int CTRL> __device__ __forceinline__ float dpp(float x) { return __builtin_bit_cast(float, __builtin_amdgcn_mov_dpp(__builtin_bit_cast(int, x), CTRL, 0xf, 0xf, true)); }
constexpr int DPP_XOR1 = 0xB1, DPP_XOR2 = 0x4E, DPP_HMIRROR = 0x141, DPP_ROR8 = 0x128;
__device__ __forceinline__ float sum8(float x) { x += dpp<DPP_XOR1>(x); x += dpp<DPP_XOR2>(x); x += dpp<DPP_HMIRROR>(x); return x; }
__device__ __forceinline__ float sum16(float x) { x = sum8(x); x += dpp<DPP_ROR8>(x); return x; }
__device__ __forceinline__ float max16(float x) { x = fmaxf(x, dpp<DPP_XOR1>(x)); x = fmaxf(x, dpp<DPP_XOR2>(x)); x = fmaxf(x, dpp<DPP_HMIRROR>(x)); x = fmaxf(x, dpp<DPP_ROR8>(x)); return x; }
__device__ __forceinline__ float xrow_sum(float x) {
    auto s = __builtin_amdgcn_permlane16_swap(__float_as_uint(x), __float_as_uint(x), false, false); x = __uint_as_float(s[0]) + __uint_as_float(s[1]);
    auto t = __builtin_amdgcn_permlane32_swap(__float_as_uint(x), __float_as_uint(x), false, false); return __uint_as_float(t[0]) + __uint_as_float(t[1]); }
__device__ __forceinline__ float xrow_max(float x) {
    auto s = __builtin_amdgcn_permlane16_swap(__float_as_uint(x), __float_as_uint(x), false, false); x = fmaxf(__uint_as_float(s[0]), __uint_as_float(s[1]));
    auto t = __builtin_amdgcn_permlane32_swap(__float_as_uint(x), __float_as_uint(x), false, false); return fmaxf(__uint_as_float(t[0]), __uint_as_float(t[1])); }
__device__ __forceinline__ float wave_sum(float x) { return xrow_sum(sum16(x)); }
#define GAS __attribute__((address_space(1)))
typedef GAS unsigned gu32;
#define RLX_AGENT __ATOMIC_RELAXED, __HIP_MEMORY_SCOPE_AGENT
#define LDS_WAIT() asm volatile("s_waitcnt lgkmcnt(0)" ::: "memory")

struct Params {
    const float* in[30];
    float* out;
    unsigned char* ws;
};
#define STAGE_MIX 1
#define STAGE_CROSS 1
#define STAGE_PEER 1
#define GATHER_SYNC 0
#define GNT 4
#define GATHER_SPLIT 1
#define GATHER_VMMA 2
#define GATHER_UI4 1
#define VBUF4 1
#define UBUF4 1
#ifndef PG8_WGM
#define PG8_WGM 8
#endif
namespace pg8 {
#define PG8_LAS __attribute__((address_space(3)))
typedef int i32x8 __attribute__((ext_vector_type(8)));
typedef int i32x4 __attribute__((ext_vector_type(4)));
constexpr int BM = 256, BK = 64, HALF = 128, HTB = HALF * BK * 2  , STAGE_BYTES = 8 * HTB, NXCD = 8, WGM = PG8_WGM;

__host__ __device__ __forceinline__ int lds_byte(int r, int c) { const int st = (r >> 4) * 2 + (c >> 5), rr = r & 15, cc = c & 31, ob = rr * 64 + cc * 2; return st * 1024 + (ob ^ (((ob >> 9) & 1) << 5)); }
__host__ __device__ __forceinline__ void stage_rc(int b, int& R, int& C) { const int st = b / 1024, sb = b % 1024, swz = sb ^ (((sb >> 9) & 1) << 5); R = (st >> 1) * 16 + swz / 64; C = (st & 1) * 32 + (swz % 64) / 2; }
__host__ __device__ __forceinline__ int perm32(int rho) { const int n = rho >> 4, i = rho & 15; return 8 * (i >> 2) + 4 * n + (i & 3); }

struct Unit { int pm, pn; };
struct Gemm { const bf16_t* A; const bf16_t* Bt; int M, N, K; };

struct StaticOrder {
    int nM, nN, nwg, G, c;
    __host__ __device__ void init(int M, int N, int G_, int c_) { nM = M / BM; nN = N / BM; nwg = nM * nN; G = G_; c = c_; }
    __host__ __device__ bool next(int i, Unit& u) const {
        const long L = (long)i * G + c; if (L >= nwg) return false;
        int wgid = (int)L; { const int q = nwg / NXCD, r = nwg % NXCD, xcd = wgid % NXCD, off = wgid / NXCD; wgid = (xcd < r ? xcd * (q + 1) : r * (q + 1) + (xcd - r) * q) + off; }
        const int nig = WGM * nN, gid = wgid / nig, fm = gid * WGM, gsz = (nM - fm) < WGM ? (nM - fm) : WGM;
        u.pm = fm + ((wgid % nig) % gsz); u.pn = (wgid % nig) / gsz; return true;
    }
    __device__ __forceinline__ void a_ready(const Unit&) const {}
    __device__ __forceinline__ void done(const Unit&) const {}
};

__device__ __forceinline__ u32x4 pack8(const f32x4 v0, const f32x4 v1) { u32x4 w; w.x = pk_bf16(v0[0], v0[1]); w.y = pk_bf16(v0[2], v0[3]); w.z = pk_bf16(v1[0], v1[1]); w.w = pk_bf16(v1[2], v1[3]); return w; }
__device__ __forceinline__ f32x4 shfl4(const f32x4 v, int m) { f32x4 r; r[0] = __shfl_xor(v[0], m); r[1] = __shfl_xor(v[1], m); r[2] = __shfl_xor(v[2], m); r[3] = __shfl_xor(v[3], m); return r; }

struct EpiPlain {
    static constexpr bool PERM = true, AFTER_DRAIN = false;
    bf16_t* O; int ldc;
    __device__ __forceinline__ void operator()(const f32x4 (&acc)[2][2][4][2], const Unit& u, int wr, int wc, int fr, int fq) const {
        const int row0 = u.pm * BM + wr * 64 + fr, col0 = u.pn * BM + wc * 32 + 8 * fq;
#pragma unroll
        for (int ai = 0; ai < 2; ++ai)
#pragma unroll
            for (int m = 0; m < 4; ++m) { bf16_t* rowp = O + (size_t)(row0 + ai * HALF + m * 16) * ldc + col0;
#pragma unroll
                for (int bj = 0; bj < 2; ++bj) *(u32x4*)(rowp + bj * HALF) = pack8(acc[ai][bj][m][0], acc[ai][bj][m][1]); }
    }
};
struct EpiProj {
    static constexpr bool PERM = true, AFTER_DRAIN = false;
    bf16_t *Q, *Kb, *Vb, *RW; const bf16_t* rt; float qscale; int norope;
    __device__ __forceinline__ void operator()(const f32x4 (&acc)[2][2][4][2], const Unit& u, int wr, int wc, int fr, int fq) const {
        const int pn = u.pn; bf16_t* base; int ldc, colt; bool rope = false; float sc = 1.f;
        if (pn < 4) { base = Q; ldc = 1024; colt = pn * 256; rope = true; sc = qscale; }
        else if (pn == 4) { base = Kb; ldc = 256; colt = 0; rope = true; }
        else if (pn == 5) { base = Vb; ldc = 256; colt = 0; }
        else { base = RW; ldc = RW_W; colt = (pn - 6) * 256; }
        const int row0 = u.pm * BM + wr * 64 + fr, col0 = colt + wc * 32 + 8 * fq;
        const bool dorope = rope && ((wc & 1) == 0) && !norope;
        if (dorope) {
#pragma unroll
            for (int ai = 0; ai < 2; ++ai) {
                u32x4 tc[4], ts[4];
#pragma unroll
                for (int m = 0; m < 4; ++m) { const bf16_t* tp = rt + (size_t)(row0 + ai * HALF + m * 16) * 16; tc[m] = *(const u32x4*)tp; ts[m] = *(const u32x4*)(tp + 8); }
#pragma unroll
                for (int m = 0; m < 4; ++m) { const int row = row0 + ai * HALF + m * 16; bf16_t* rowp = base + (size_t)row * ldc + col0; const u32x4 cw = tc[m], sw = ts[m];
                    const f32x4 c0 = {bf_lo(cw.x), bf_hi(cw.x), bf_lo(cw.y), bf_hi(cw.y)}, c1 = {bf_lo(cw.z), bf_hi(cw.z), bf_lo(cw.w), bf_hi(cw.w)};
                    const f32x4 s0 = {bf_lo(sw.x), bf_hi(sw.x), bf_lo(sw.y), bf_hi(sw.y)}, s1 = {bf_lo(sw.z), bf_hi(sw.z), bf_lo(sw.w), bf_hi(sw.w)};
#pragma unroll
                    for (int bj = 0; bj < 2; ++bj) { f32x4 v0 = acc[ai][bj][m][0], v1 = acc[ai][bj][m][1]; f32x4 p0, p1;
#pragma unroll
                        for (int e = 0; e < 4; ++e) { const auto xa = __builtin_amdgcn_permlane16_swap(__float_as_uint(v0[e]), __float_as_uint(v0[e]), false, false); p0[e] = __uint_as_float((fq & 1) ? xa[0] : xa[1]);
                            const auto xb = __builtin_amdgcn_permlane16_swap(__float_as_uint(v1[e]), __float_as_uint(v1[e]), false, false); p1[e] = __uint_as_float((fq & 1) ? xb[0] : xb[1]); }
                        if (fq == 0) { v0 = v0 * c0 - p0 * s0; v1 = v1 * c1 - p1 * s1; }
                        else if (fq == 1) { v0 = v0 * c0 + p0 * s0; v1 = v1 * c1 + p1 * s1; }
                        *(u32x4*)(rowp + bj * HALF) = pack8(v0 * sc, v1 * sc); } } }
        } else {
#pragma unroll
            for (int ai = 0; ai < 2; ++ai)
#pragma unroll
                for (int m = 0; m < 4; ++m) { bf16_t* rowp = base + (size_t)(row0 + ai * HALF + m * 16) * ldc + col0;
#pragma unroll
                    for (int bj = 0; bj < 2; ++bj) *(u32x4*)(rowp + bj * HALF) = pack8(acc[ai][bj][m][0] * sc, acc[ai][bj][m][1] * sc); }
        }
    }
};
struct EpiGate {
    static constexpr bool PERM = true, AFTER_DRAIN = false;
    bf16_t* MX; const bf16_t* Y; int useA, useB; float nk;
    __device__ __forceinline__ void operator()(const f32x4 (&acc)[2][2][4][2], const Unit& u, int wr, int wc, int fr, int fq) const {
        const int row0 = u.pm * BM + wr * 64 + fr, ch0 = u.pn * HALF + wc * 32 + 8 * fq;
#pragma unroll
        for (int ai = 0; ai < 2; ++ai)
#pragma unroll
            for (int m = 0; m < 4; ++m) { const size_t off = (size_t)(row0 + ai * HALF + m * 16) * D_MODEL + ch0;
                const u32x4 av = useA ? *(const u32x4*)(MX + off) : (u32x4){0u, 0u, 0u, 0u}; const u32x4 yv = useB ? *(const u32x4*)(Y + off) : (u32x4){0u, 0u, 0u, 0u};
                f32x4 o0, o1;
#pragma unroll
                for (int e = 0; e < 4; ++e) {
                    const float a0 = (e & 1) ? bf_hi(av[e >> 1]) : bf_lo(av[e >> 1]), a1 = (e & 1) ? bf_hi(av[2 + (e >> 1)]) : bf_lo(av[2 + (e >> 1)]);
                    const float y0 = (e & 1) ? bf_hi(yv[e >> 1]) : bf_lo(yv[e >> 1]), y1 = (e & 1) ? bf_hi(yv[2 + (e >> 1)]) : bf_lo(yv[2 + (e >> 1)]);
                    o0[e] = fast_rcp(1.f + fast_exp2(nk * acc[ai][0][m][0][e])) * a0 + fast_rcp(1.f + fast_exp2(nk * acc[ai][1][m][0][e])) * y0;
                    o1[e] = fast_rcp(1.f + fast_exp2(nk * acc[ai][0][m][1][e])) * a1 + fast_rcp(1.f + fast_exp2(nk * acc[ai][1][m][1][e])) * y1; }
                *(u32x4*)(MX + off) = pack8(o0, o1); }
    }
};
template <bool RES_F32> struct EpiRes {
    static constexpr bool PERM = true, AFTER_DRAIN = false;
    const float* xres; bf16_t* H; float* ssq; float amp;
    __device__ __forceinline__ void operator()(const f32x4 (&acc)[2][2][4][2], const Unit& u, int wr, int wc, int fr, int fq) const {
        const int row0 = u.pm * BM + wr * 64 + fr, col0 = u.pn * BM + wc * 32 + 8 * fq;
#pragma unroll
        for (int ai = 0; ai < 2; ++ai)
#pragma unroll
            for (int m = 0; m < 4; ++m) { const int row = row0 + ai * HALF + m * 16; float ss = 0.f;
#pragma unroll
                for (int bj = 0; bj < 2; ++bj) { const size_t off = (size_t)row * D_MODEL + col0 + bj * HALF; f32x4 r0, r1;
                    if (RES_F32) { r0 = *(const f32x4*)(xres + off); r1 = *(const f32x4*)(xres + off + 4); }
                    else { const u32x4 hv = *(const u32x4*)(H + off); r0 = (f32x4){bf_lo(hv.x), bf_hi(hv.x), bf_lo(hv.y), bf_hi(hv.y)}; r1 = (f32x4){bf_lo(hv.z), bf_hi(hv.z), bf_lo(hv.w), bf_hi(hv.w)}; }
                    const f32x4 v0 = acc[ai][bj][m][0] * amp + r0, v1 = acc[ai][bj][m][1] * amp + r1;
                    ss += (v0[0] * v0[0] + v0[1] * v0[1]) + (v0[2] * v0[2] + v0[3] * v0[3]) + (v1[0] * v1[0] + v1[1] * v1[1]) + (v1[2] * v1[2] + v1[3] * v1[3]);
                    *(u32x4*)(H + off) = pack8(v0, v1); }
                ss += __shfl_xor(ss, 16); ss += __shfl_xor(ss, 32);
                if (fq == 0) ssq[(size_t)row * 16 + u.pn * 4 + wc] = ss; }
    }
};
struct EpiScaled {
    static constexpr bool PERM = true, AFTER_DRAIN = false;
    bf16_t* O; int ldc; const float* ssq; float mul;
    __device__ __forceinline__ void operator()(const f32x4 (&acc)[2][2][4][2], const Unit& u, int wr, int wc, int fr, int fq) const {
        const int row0 = u.pm * BM + wr * 64 + fr, col0 = u.pn * BM + wc * 32 + 8 * fq;
#pragma unroll
        for (int ai = 0; ai < 2; ++ai)
#pragma unroll
            for (int m = 0; m < 4; ++m) { const int row = row0 + ai * HALF + m * 16; const f32x4* sp = (const f32x4*)(ssq + (size_t)row * 16);
                const f32x4 a = sp[0], b = sp[1], c = sp[2], d = sp[3]; const f32x4 t = (a + b) + (c + d);
                const float rstd = mul / sqrtf(((t[0] + t[1]) + (t[2] + t[3])) * (1.f / D_MODEL) + RMS_EPS);
                bf16_t* rowp = O + (size_t)row * ldc + col0;
#pragma unroll
                for (int bj = 0; bj < 2; ++bj) *(u32x4*)(rowp + bj * HALF) = pack8(acc[ai][bj][m][0] * rstd, acc[ai][bj][m][1] * rstd); }
    }
};
template <class Epi, class Sched, bool ALIGN_EPI = false, bool SP2 = false, bool FP8 = false>
__device__ __forceinline__ void gemm_phase(PG8_LAS unsigned char* lds, const Gemm g, const Sched& S, const Epi& E) {
    int tid_ = threadIdx.x; asm volatile("" : "+v"(tid_));
    const int tid = tid_, wid = __builtin_amdgcn_readfirstlane(tid >> 6), lane = tid & 63, wr = wid >> 2, wc = wid & 3, fr = lane & 15, fq = lane >> 4;
    const int K = g.K, nt = K / BK;
    unsigned voffA[2], voffB[2];
#pragma unroll
    for (int i = 0; i < 2; ++i) { int R, C; stage_rc(tid * 16 + i * 8192, R, C); const int Rb = Epi::PERM ? ((R & ~31) + perm32(R & 31)) : R;
        voffA[i] = (unsigned)(R * K + C) * 2u; voffB[i] = (unsigned)(Rb * K + C) * 2u; }
    const size_t kstep = (size_t)(BK * 2);
    const size_t hstep = (size_t)HALF * K * 2;
    const size_t tstep = 2 * hstep;
    const unsigned ldsw = (unsigned)wid * 1024u;
    const int aoff = lds_byte(wr * 64 + fr, fq * 8), boff = lds_byte(wc * 32 + fr, fq * 8);
#define PG8_SA(b, h) (((b) * 2 + (h)) * HTB)
#define PG8_SB(b, h) ((4 + (b) * 2 + (h)) * HTB)
#define PG8_STAGE(bufoff, gbase, voff) do { _Pragma("unroll") for (int _i = 0; _i < 2; ++_i) \
        __builtin_amdgcn_global_load_lds((const unsigned*)((const char*)(gbase) + (voff)[_i]), (PG8_LAS unsigned*)(lds + (bufoff) + ldsw + _i * 8192), 16, 0, 0); } while (0)
#define PG8_LDA(dst, b, h) do { _Pragma("unroll") for (int m = 0; m < 4; ++m) _Pragma("unroll") for (int k = 0; k < 2; ++k) dst[m][k] = *(const PG8_LAS bf16x8*)(lds + PG8_SA(b, h) + aoff + m * 2048 + k * 1024); } while (0)
#define PG8_LDB(dst, b, h) do { _Pragma("unroll") for (int n = 0; n < 2; ++n) _Pragma("unroll") for (int k = 0; k < 2; ++k) dst[n][k] = *(const PG8_LAS bf16x8*)(lds + PG8_SB(b, h) + boff + n * 2048 + k * 1024); } while (0)
#define PG8_MMA(ai, bj, At, Bt) do { __builtin_amdgcn_s_setprio(1); _Pragma("unroll") for (int m = 0; m < 4; ++m) _Pragma("unroll") for (int n = 0; n < 2; ++n) { \
        if constexpr (FP8) { const i32x8 bb_ = __builtin_shufflevector(__builtin_bit_cast(i32x4, Bt[n][0]), __builtin_bit_cast(i32x4, Bt[n][1]), 0, 1, 2, 3, 4, 5, 6, 7), \
                                         aa_ = __builtin_shufflevector(__builtin_bit_cast(i32x4, At[m][0]), __builtin_bit_cast(i32x4, At[m][1]), 0, 1, 2, 3, 4, 5, 6, 7); \
            asm volatile("v_mfma_f32_16x16x128_f8f6f4 %0, %1, %2, %0" : "+v"(acc[ai][bj][m][n]) : "v"(bb_), "v"(aa_)); } \
        else { _Pragma("unroll") for (int k = 0; k < 2; ++k) acc[ai][bj][m][n] = __builtin_amdgcn_mfma_f32_16x16x32_bf16(Bt[n][k], At[m][k], acc[ai][bj][m][n], 0, 0, 0); } } \
        __builtin_amdgcn_s_setprio(0); } while (0)
#define PG8_WAIT_V(n) asm volatile("s_waitcnt vmcnt(" #n ")" ::: "memory")
#define PG8_WAIT_L(n) asm volatile("s_waitcnt lgkmcnt(" #n ")" ::: "memory")
#define PG8_BAR __builtin_amdgcn_s_barrier()
#define PG8_SCHED __builtin_amdgcn_sched_barrier(0)
    Unit cur, nxt; int ui = 0;
    if (!S.next(0, cur)) return;
    f32x4 acc[2][2][4][2];
#pragma unroll
    for (int a = 0; a < 2; ++a)
#pragma unroll
        for (int b = 0; b < 2; ++b)
#pragma unroll
            for (int m = 0; m < 4; ++m)
#pragma unroll
                for (int n = 0; n < 2; ++n) acc[a][b][m][n] = (f32x4){0.f, 0.f, 0.f, 0.f};
    bf16x8 At[4][2], B0[2][2], B1[2][2];
    const char* cA = (const char*)g.A + (size_t)cur.pm * tstep; const char* cB = (const char*)g.Bt + (size_t)cur.pn * tstep;
    S.a_ready(cur);
    if constexpr (SP2) {
        PG8_STAGE(PG8_SB(0, 0), cB, voffB); PG8_STAGE(PG8_SB(0, 1), cB + hstep, voffB); PG8_STAGE(PG8_SA(0, 0), cA, voffA); PG8_STAGE(PG8_SA(0, 1), cA + hstep, voffA);
        if (wr == 1) PG8_BAR;
        PG8_WAIT_V(2); PG8_BAR;
        PG8_STAGE(PG8_SB(1, 0), cB + kstep, voffB); PG8_STAGE(PG8_SA(1, 0), cA + kstep, voffA); PG8_STAGE(PG8_SB(1, 1), cB + hstep + kstep, voffB);
        PG8_WAIT_V(6); PG8_BAR;
    } else {
        PG8_STAGE(PG8_SB(0, 0), cB, voffB); PG8_STAGE(PG8_SA(0, 0), cA, voffA); PG8_STAGE(PG8_SB(0, 1), cB + hstep, voffB); PG8_STAGE(PG8_SA(0, 1), cA + hstep, voffA);
        if (wr == 1) PG8_BAR;
        PG8_WAIT_V(4); PG8_BAR;
        PG8_STAGE(PG8_SB(1, 0), cB + kstep, voffB); PG8_STAGE(PG8_SA(1, 0), cA + kstep, voffA); PG8_STAGE(PG8_SB(1, 1), cB + hstep + kstep, voffB);
        PG8_WAIT_V(6); PG8_BAR;
    }
    for (;;) {
        const bool has_next = S.next(ui + 1, nxt);
        const char* nA = has_next ? (const char*)g.A + (size_t)nxt.pm * tstep : cA; const char* nB = has_next ? (const char*)g.Bt + (size_t)nxt.pn * tstep : cB;
#pragma clang loop unroll(disable)
        for (int t = 0; t < nt; t += 2) {
            const bool last = (t == nt - 2);
            const char* a1 = cA + (size_t)(t + 1) * kstep;
            const char* a2 = last ? nA : cA + (size_t)(t + 2) * kstep; const char* b2 = last ? nB : cB + (size_t)(t + 2) * kstep;
            const char* a3 = a2 + kstep; const char* b3 = b2 + kstep;
            if (last && has_next) S.a_ready(nxt);
            if constexpr (SP2) {
            PG8_LDB(B0, 0, 0); PG8_LDB(B1, 0, 1); PG8_SCHED; PG8_LDA(At, 0, 0); PG8_STAGE(PG8_SA(1, 1), a1 + hstep, voffA);
            PG8_WAIT_V(8); PG8_WAIT_L(0); PG8_BAR; PG8_MMA(0, 0, At, B0); PG8_MMA(0, 1, At, B1); PG8_BAR; PG8_SCHED;
            PG8_LDA(At, 0, 1); PG8_STAGE(PG8_SB(0, 0), b2, voffB); PG8_STAGE(PG8_SB(0, 1), b2 + hstep, voffB); PG8_STAGE(PG8_SA(0, 0), a2, voffA);
            PG8_WAIT_V(8); PG8_WAIT_L(0); PG8_BAR; PG8_MMA(1, 0, At, B0); PG8_MMA(1, 1, At, B1); PG8_BAR; PG8_SCHED;
            PG8_LDB(B0, 1, 0); PG8_LDB(B1, 1, 1); PG8_SCHED; PG8_LDA(At, 1, 0); PG8_STAGE(PG8_SA(0, 1), a2 + hstep, voffA);
            PG8_WAIT_V(8); PG8_WAIT_L(0); PG8_BAR; PG8_MMA(0, 0, At, B0); PG8_MMA(0, 1, At, B1); PG8_BAR; PG8_SCHED;
            PG8_LDA(At, 1, 1); PG8_STAGE(PG8_SB(1, 0), b3, voffB); PG8_STAGE(PG8_SB(1, 1), b3 + hstep, voffB); PG8_STAGE(PG8_SA(1, 0), a3, voffA);
            PG8_WAIT_V(8); PG8_WAIT_L(0); PG8_BAR; PG8_MMA(1, 0, At, B0); PG8_MMA(1, 1, At, B1); PG8_BAR; PG8_SCHED;
            } else {
            PG8_LDB(B0, 0, 0); PG8_SCHED; PG8_LDA(At, 0, 0); PG8_STAGE(PG8_SA(1, 1), a1 + hstep, voffA);
            PG8_WAIT_L(8); PG8_BAR; PG8_WAIT_L(0); PG8_MMA(0, 0, At, B0); PG8_BAR; PG8_SCHED;
            PG8_LDB(B1, 0, 1); PG8_STAGE(PG8_SB(0, 0), b2, voffB);
            PG8_BAR; PG8_WAIT_L(0); PG8_MMA(0, 1, At, B1); PG8_BAR;
            PG8_LDA(At, 0, 1); PG8_STAGE(PG8_SA(0, 0), a2, voffA);
            PG8_BAR; PG8_WAIT_L(0); PG8_MMA(1, 0, At, B0); PG8_BAR; PG8_SCHED;
            PG8_STAGE(PG8_SB(0, 1), b2 + hstep, voffB);
            PG8_WAIT_V(6); PG8_BAR; PG8_MMA(1, 1, At, B1); PG8_BAR;
            PG8_LDB(B0, 1, 0); PG8_SCHED; PG8_LDA(At, 1, 0); PG8_STAGE(PG8_SA(0, 1), a2 + hstep, voffA);
            PG8_WAIT_L(8); PG8_BAR; PG8_WAIT_L(0); PG8_MMA(0, 0, At, B0); PG8_BAR; PG8_SCHED;
            PG8_LDB(B1, 1, 1); PG8_STAGE(PG8_SB(1, 0), b3, voffB);
            PG8_BAR; PG8_WAIT_L(0); PG8_MMA(0, 1, At, B1); PG8_BAR;
            PG8_LDA(At, 1, 1); PG8_STAGE(PG8_SA(1, 0), a3, voffA);
            PG8_BAR; PG8_WAIT_L(0); PG8_MMA(1, 0, At, B0); PG8_BAR; PG8_SCHED;
            PG8_STAGE(PG8_SB(1, 1), b3 + hstep, voffB);
            PG8_WAIT_V(6); PG8_BAR; PG8_MMA(1, 1, At, B1); PG8_BAR;
            }
        }
        if constexpr (ALIGN_EPI) { if (wr == 0) PG8_BAR; }
        if constexpr (!Epi::AFTER_DRAIN) {
            if constexpr (FP8) { int fr_ = fr, fq_ = fq; asm volatile("s_nop 15\n\ts_nop 15" : "+v"(fr_), "+v"(fq_));
                _Pragma("unroll") for (int a = 0; a < 2; ++a) _Pragma("unroll") for (int b = 0; b < 2; ++b) _Pragma("unroll") for (int m = 0; m < 4; ++m) _Pragma("unroll") for (int n = 0; n < 2; ++n) asm volatile("" : "+v"(acc[a][b][m][n]));
                E(acc, cur, wr, wc, fr_, fq_); }
            else E(acc, cur, wr, wc, fr, fq);
            S.done(cur); }
        if (!has_next) break;
#pragma unroll
        for (int a = 0; a < 2; ++a)
#pragma unroll
            for (int b = 0; b < 2; ++b)
#pragma unroll
                for (int m = 0; m < 4; ++m)
#pragma unroll
                    for (int n = 0; n < 2; ++n) acc[a][b][m][n] = (f32x4){0.f, 0.f, 0.f, 0.f};
        cur = nxt; cA = nA; cB = nB; ++ui;
        if constexpr (ALIGN_EPI) { if (wr == 1) PG8_BAR; }
    }
    PG8_WAIT_V(0);
    if constexpr (!ALIGN_EPI) { if (wr == 0) PG8_BAR; }
    PG8_BAR;
    if constexpr (Epi::AFTER_DRAIN) { E.fused(acc, cur, wr, wc, fr, fq, lds, wid, lane); S.done(cur); }
#undef PG8_SA
#undef PG8_SB
#undef PG8_STAGE
#undef PG8_LDA
#undef PG8_LDB
#undef PG8_MMA
#undef PG8_WAIT_V
#undef PG8_WAIT_L
#undef PG8_BAR
#undef PG8_SCHED
}
}
#ifndef GATHER_VMMA
#define GATHER_VMMA 0
#endif
#ifndef GATHER_UI4
#define GATHER_UI4 0
#endif
constexpr int PU_ROWB = GATHER_UI4 ? 512 : 1024; constexpr float PU_QS = 91.2f;
#ifndef V6_DIAG_FP8
#define V6_DIAG_FP8 0
#endif
constexpr int PV_ROWB = (GATHER_VMMA == 2 && !V6_DIAG_FP8) ? 768 : 1024; constexpr float PV_SCALE = (GATHER_VMMA == 2 && !V6_DIAG_FP8) ? 5.5f : 64.f;
template <int MODE  >
__device__ __forceinline__ void transpose_item(const float* W, int ldw, int c0, int K, int N, bf16_t* WT, const float* gain, LAS float* scr, int item, int lane) {
    const int nblk = N / 32, kb = item / nblk, nb = item % nblk, k0 = 64 * kb, n0 = 32 * nb;
#pragma unroll 8
    for (int i = 0; i < 32; ++i) { const int kk = 2 * i + (lane >> 5); float v = W[(size_t)(k0 + kk) * ldw + c0 + n0 + (lane & 31)]; if (gain) v *= gain[k0 + kk]; scr[kk * 33 + (lane & 31)] = v; }
    LDS_WAIT(); asm volatile("" ::: "memory");
    const int c = lane & 7;
    int rbase = n0;
    if (MODE == 1 || MODE == 2) { const int isB = n0 >> 10, ch = n0 & 1023; rbase = 256 * (ch >> 7) + 128 * isB + (ch & 127); }
#pragma unroll
    for (int j = 0; j < 4; ++j) { const int n = (lane >> 3) + 8 * j; const LAS float* s = scr + (8 * c) * 33 + n;
        if (MODE >= 2) { constexpr float WS8 = MODE == 2 ? GATE_WSCALE : CROSS_WSCALE; int w0 = __builtin_amdgcn_cvt_pk_fp8_f32(s[0 * 33] * WS8, s[1 * 33] * WS8, 0, false); w0 = __builtin_amdgcn_cvt_pk_fp8_f32(s[2 * 33] * WS8, s[3 * 33] * WS8, w0, true);
            int w1 = __builtin_amdgcn_cvt_pk_fp8_f32(s[4 * 33] * WS8, s[5 * 33] * WS8, 0, false); w1 = __builtin_amdgcn_cvt_pk_fp8_f32(s[6 * 33] * WS8, s[7 * 33] * WS8, w1, true);
            *(u32x2*)((unsigned char*)WT + (size_t)(rbase + n) * K + k0 + 8 * c) = (u32x2){(unsigned)w0, (unsigned)w1}; }
        else { u32x4 o; o.x = pk_bf16(s[0 * 33], s[1 * 33]); o.y = pk_bf16(s[2 * 33], s[3 * 33]); o.z = pk_bf16(s[4 * 33], s[5 * 33]); o.w = pk_bf16(s[6 * 33], s[7 * 33]);
            *(u32x4*)(WT + (size_t)(rbase + n) * K + k0 + 8 * c) = o; } }
    LDS_WAIT(); asm volatile("" ::: "memory");
}
__device__ __forceinline__ void rms_row_to_bf16(const float* xrow, const float* gain, bf16_t* orow, int lane) {
    const f32x4* xr = (const f32x4*)xrow + lane; const f32x4* gr = (const f32x4*)gain + lane;
    f32x4 v[4]; float s = 0.f;
#pragma unroll
    for (int j = 0; j < 4; ++j) { v[j] = xr[64 * j]; s += (v[j].x * v[j].x + v[j].y * v[j].y) + (v[j].z * v[j].z + v[j].w * v[j].w); }
    const float rstd = 1.f / sqrtf(wave_sum(s) * (1.f / D_MODEL) + RMS_EPS);
    u32x2* o8 = (u32x2*)orow + lane;
#pragma unroll
    for (int j = 0; j < 4; ++j) { const f32x4 g = gr[64 * j]; u32x2 w; w.x = pk_bf16(v[j].x * rstd * g.x, v[j].y * rstd * g.y); w.y = pk_bf16(v[j].z * rstd * g.z, v[j].w * rstd * g.w); o8[64 * j] = w; }
}
__device__ __forceinline__ void cvt_row_to_bf16(const float* xrow, const float* gain, bf16_t* orow, int lane) {
    const f32x4* xr = (const f32x4*)xrow + lane; u32x2* o8 = (u32x2*)orow + lane;
#pragma unroll
    for (int j = 0; j < 4; ++j) { f32x4 v = xr[64 * j]; if (gain) v = v * ((const f32x4*)gain + lane)[64 * j]; u32x2 w; w.x = pk_bf16(v.x, v.y); w.y = pk_bf16(v.z, v.w); o8[64 * j] = w; }
}
__device__ __forceinline__ bf16_t bf16_of_(float v) { return (bf16_t)(pk_bf16(v, 0.f) & 0xffffu); }
__device__ __forceinline__ void cvt_row_to_fp8(const float* xrow, const float* gain, float scale, unsigned char* orow, int lane) {
    const f32x4* xr = (const f32x4*)(xrow + 16 * lane); u32x4 o;
#pragma unroll
    for (int q = 0; q < 4; ++q) { f32x4 v = xr[q] * scale; if (gain) v = v * ((const f32x4*)(gain + 16 * lane))[q];
        int w = __builtin_amdgcn_cvt_pk_fp8_f32(v.x, v.y, 0, false); w = __builtin_amdgcn_cvt_pk_fp8_f32(v.z, v.w, w, true); o[q] = (unsigned)w; }
    *(u32x4*)(orow + 16 * lane) = o;
}
__device__ __forceinline__ void cvt_row_to_fp6_planes(const float* xrow, float scale, unsigned char* orow, int n) {
    const f32x4* xr = (const f32x4*)(xrow + 32 * n); u32x16 w;
#pragma unroll
    for (int q = 0; q < 8; ++q) { const f32x4 v = xr[q] * scale; w[2 * q] = pk_bf16(v.x, v.y); w[2 * q + 1] = pk_bf16(v.z, v.w); }
    const u32x6 r = __builtin_amdgcn_cvt_scalef32_pk32_fp6_bf16(__builtin_bit_cast(bf16x32_t, w), 1.0f);
    *(u32x4*)(orow + 16 * n) = (u32x4){r[0], r[1], r[2], r[3]}; *(u32x2*)(orow + 512 + 8 * n) = (u32x2){r[4], r[5]};
}
__device__ __forceinline__ void cvt_row_to_i4(const float* xrow, const float* gain, float scale, unsigned char* orow, int n) {
    const f32x4* xr = (const f32x4*)(xrow + 32 * n); const f32x4* gr = (const f32x4*)(gain + 32 * n); u32x4 o;
#pragma unroll
    for (int d = 0; d < 4; ++d) { const f32x4 a = xr[2 * d] * gr[2 * d] * scale, b = xr[2 * d + 1] * gr[2 * d + 1] * scale; unsigned w = 0u;
#pragma unroll
        for (int k = 0; k < 4; ++k) { const int qa = (int)fminf(fmaxf(rintf(a[k]), -7.f), 7.f), qb = (int)fminf(fmaxf(rintf(b[k]), -7.f), 7.f);
            w |= ((unsigned)qa & 15u) << (8 * k) | ((unsigned)qb & 15u) << (8 * k + 4); }
        o[d] = w; }
    *(u32x4*)(orow + 16 * n) = o;
}
#ifndef TABLES_LATE
#define TABLES_LATE 0
#endif
__device__ __forceinline__ void peer_tables_lowp(const Params& p, int wave, int lane) {
    unsigned char* ws = p.ws; const int gw = blockIdx.x * NWAVES + wave, NGW = gridDim.x * NWAVES; (void)ws; (void)gw; (void)NGW;
#if GATHER_UI4
    for (int m0 = 2 * gw; m0 < N_EXPERTS; m0 += 2 * NGW) { const int m = m0 + (lane >> 5);
        cvt_row_to_i4(p.in[27] + (size_t)m * D_MODEL, p.in[23], PU_QS, ws + WS_PU + (size_t)m * PU_ROWB, lane & 31); }
#endif
#if GATHER_VMMA == 2 && !V6_DIAG_FP8
    for (int m0 = 2 * gw; m0 < N_EXPERTS; m0 += 2 * NGW) { const int m = m0 + (lane >> 5);
        cvt_row_to_fp6_planes(p.in[28] + (size_t)m * D_MODEL, PV_SCALE, ws + WS_PV + (size_t)m * PV_ROWB, lane & 31); }
#endif
}
__device__ __forceinline__ void p0_prologue(const Params& p, LAS unsigned char* lds, int wave, int lane) {
    LAS float* scr = (LAS float*)(lds + wave * 16384);
    const int gw = blockIdx.x * NWAVES + wave, NGW = gridDim.x * NWAVES;
    unsigned char* ws = p.ws;
    int base = 0;
#define TJOB(MODE, W, LDW, C0, KK, NN, WT, GAIN) do { const int nitems_ = ((KK) / 64) * ((NN) / 32); const int first_ = (gw - base % NGW + NGW) % NGW; \
        for (int it = first_; it < nitems_; it += NGW) transpose_item<MODE>((W), (LDW), (C0), (KK), (NN), (bf16_t*)(ws + (WT)), (GAIN), scr, it, lane); base += nitems_; } while (0)
    TJOB(0, p.in[4], IN_WIDTH, 0, 1024, N_PROJA, WS_WINA, nullptr);
    TJOB(GATE_FP8 ? 2 : 1, p.in[4], IN_WIDTH, N_PROJA, 1024, 2048, WS_WING, nullptr);
    TJOB(0, p.in[17], 1024, 0, 1024, 1024, WS_WOUT, nullptr);
    TJOB(0, p.in[20], 512, 0, 1024, 512, WS_WQC, p.in[18]);
    TJOB(0, p.in[21], 1024, 0, 1024, 1024, WS_WKVC, nullptr);
    TJOB(CROSS_FP8 ? 3 : 0, p.in[22], 1024, 0, 512, 1024, WS_WOC, nullptr);
    TJOB(0, p.in[24], 2048, 0, 1024, 2048, WS_WPQ, p.in[23]);
    TJOB(0, p.in[8], 1024, 0, 64, 1024, WS_W2T, nullptr);
    TJOB(0, p.in[10], 1024, 0, 64, 1024, WS_A2T, nullptr);
    TJOB(0, p.in[11], 1024, 0, 128, 1024, WS_G2T, nullptr);
#undef TJOB
    {
        const f32x4* gr = (const f32x4*)p.in[3] + lane; const f32x4 gq0 = gr[0], gq1 = gr[64], gq2 = gr[128], gq3 = gr[192];
        for (int m0 = gw * 4; m0 < T_TOK; m0 += NGW * 4) {
            f32x4 v[4][4];
#pragma unroll
            for (int r = 0; r < 4; ++r) { const f32x4* xr = (const f32x4*)(p.in[0] + (size_t)(m0 + r) * D_MODEL) + lane;
#pragma unroll
                for (int j = 0; j < 4; ++j) v[r][j] = xr[64 * j]; }
#pragma unroll
            for (int r = 0; r < 4; ++r) { float s_ = 0.f;
#pragma unroll
                for (int j = 0; j < 4; ++j) s_ += (v[r][j].x * v[r][j].x + v[r][j].y * v[r][j].y) + (v[r][j].z * v[r][j].z + v[r][j].w * v[r][j].w);
                const float rstd = 1.f / sqrtf(wave_sum(s_) * (1.f / D_MODEL) + RMS_EPS);
                u32x2* o8 = (u32x2*)((bf16_t*)(ws + WS_XN) + (size_t)(m0 + r) * D_MODEL) + lane;
#pragma unroll
                for (int j = 0; j < 4; ++j) { const f32x4 gq = j == 0 ? gq0 : (j == 1 ? gq1 : (j == 2 ? gq2 : gq3)); u32x2 w; w.x = pk_bf16(v[r][j].x * rstd * gq.x, v[r][j].y * rstd * gq.y); w.y = pk_bf16(v[r][j].z * rstd * gq.z, v[r][j].w * rstd * gq.w); o8[64 * j] = w;
#if GATE_FP8
                    { int q8 = __builtin_amdgcn_cvt_pk_fp8_f32(v[r][j].x * rstd * gq.x, v[r][j].y * rstd * gq.y, 0, false); q8 = __builtin_amdgcn_cvt_pk_fp8_f32(v[r][j].z * rstd * gq.z, v[r][j].w * rstd * gq.w, q8, true);
                      ((unsigned*)((unsigned char*)p.out + (size_t)(m0 + r) * D_MODEL))[lane + 64 * j] = (unsigned)q8; }
#endif
                } }
        }
    }
    for (int m = gw; m < MEM_ROWS; m += NGW) rms_row_to_bf16(p.in[1] + (size_t)m * D_MODEL, p.in[19], (bf16_t*)(ws + WS_MEMN) + (size_t)m * D_MODEL, lane);
    for (int m = gw; m < N_EXPERTS; m += NGW) {
#if !GATHER_UI4
        cvt_row_to_fp8(p.in[27] + (size_t)m * D_MODEL, p.in[23], 512.f, ws + WS_PU + (size_t)m * D_MODEL, lane);
#endif
#if GATHER_VMMA != 2 || V6_DIAG_FP8
        cvt_row_to_fp8(p.in[28] + (size_t)m * D_MODEL, nullptr, 64.f, ws + WS_PV + (size_t)m * D_MODEL, lane);
#endif
    }
#if !TABLES_LATE
    peer_tables_lowp(p, wave, lane);
#endif
    { const int gt = blockIdx.x * NTHREADS + threadIdx.x, NGT = gridDim.x * NTHREADS;
      for (int i = gt; i < 2 * 128 * 128 / 4; i += NGT) { const int which = i / 4096, j = i % 4096; const f32x4 v = which ? ((const f32x4*)p.in[26])[j] : ((const f32x4*)p.in[25])[j];
          u32x2 w; w.x = pk_bf16(v.x, v.y); w.y = pk_bf16(v.z, v.w); ((u32x2*)(ws + (which ? WS_PK2 : WS_PK1)))[j] = w; }
      const int* pos = (const int*)p.in[2];
      for (int i = gt; i < T_TOK * 8; i += NGT) { const int t = i >> 3, f = i & 7;
          const double inv = f == 0 ? 1.0 : f == 1 ? 0.19392274474868576 : f == 2 ? 0.03760603093086393 : f == 3 ? 0.007292664737217109 : f == 4 ? 0.001414213562373095 : f == 5 ? 0.0002742481756762073 : f == 6 ? 5.318295896944988e-05 : 1.031338537721246e-05;
          const double rev = (double)pos[t] * inv * 0.15915494309189535; const float fr = (float)(rev - floor(rev));
          bf16_t* rt = (bf16_t*)(ws + WS_ROPE_C) + (size_t)t * 16; rt[f] = bf16_of_(__builtin_amdgcn_cosf(fr)); rt[8 + f] = bf16_of_(__builtin_amdgcn_sinf(fr)); }
    }
}
__device__ __forceinline__ void final_norm_rows(const bf16_t* H, const float* gain, float* out, int wave, int lane) {
    const int gw = blockIdx.x * NWAVES + wave, NGW = gridDim.x * NWAVES;
    for (int m = gw; m < T_TOK; m += NGW) {
        const u32x2* hr = (const u32x2*)(H + (size_t)m * D_MODEL) + lane; const f32x4* gr = (const f32x4*)gain + lane;
        f32x4 v[4]; float s = 0.f;
#pragma unroll
        for (int j = 0; j < 4; ++j) { const u32x2 w = hr[64 * j]; v[j] = (f32x4){bf_lo(w.x), bf_hi(w.x), bf_lo(w.y), bf_hi(w.y)}; s += (v[j].x * v[j].x + v[j].y * v[j].y) + (v[j].z * v[j].z + v[j].w * v[j].w); }
        const float rstd = 1.f / sqrtf(wave_sum(s) * (1.f / D_MODEL) + RMS_EPS);
        f32x4* orow = (f32x4*)(out + (size_t)m * D_MODEL) + lane;
#pragma unroll
        for (int j = 0; j < 4; ++j) orow[64 * j] = v[j] * rstd * gr[64 * j];
    }
}
#define MFMA16(a, b, c) __builtin_amdgcn_mfma_f32_16x16x32_bf16((a), (b), (c), 0, 0, 0)
template <int HD, int NT, bool SWA, bool OUT8 = false>
__device__ __forceinline__ void attn_group(const bf16_t* qp, LAS const unsigned char* Kimg, int kstr, LAS const unsigned char* VTimg, int vstr, bf16_t* op, int lane,
                                           int i0, int jmin, int jt0, float sink2, unsigned char* op8 = nullptr) {
    const int fr = lane & 15, g = lane >> 4;
    constexpr int KS = HD / 32, DT = HD / 16, NP = NT / 2;
    bf16x8 qf[KS];
#pragma unroll
    for (int ks = 0; ks < KS; ++ks) qf[ks] = *(const bf16x8*)(qp + 32 * ks);
    f32x4 s[NT];
#pragma unroll
    for (int kt = 0; kt < NT; ++kt) { s[kt] = (f32x4){0.f, 0.f, 0.f, 0.f};
#pragma unroll
        for (int ks = 0; ks < KS; ++ks) { const bf16x8 kf = *(const LAS bf16x8*)(Kimg + (16 * kt + fr) * kstr + 16 * g + 64 * ks); s[kt] = MFMA16(kf, qf[ks], s[kt]); }
        if ((kt & 1) == 1) __builtin_amdgcn_sched_barrier(0); }
    if (SWA) { const int i = i0 + fr;
#pragma unroll
        for (int kt = 0; kt < NT; ++kt)
#pragma unroll
            for (int r = 0; r < 4; ++r) { const int j = 16 * (jt0 + kt) + 4 * g + r; const bool valid = (j > i) && (j <= i + 128) && (j >= jmin); s[kt][r] = valid ? s[kt][r] : -1e30f; } }
    float m = -1e30f;
#pragma unroll
    for (int kt = 0; kt < NT; ++kt) m = fmaxf(fmaxf(m, fmaxf(s[kt][0], s[kt][1])), fmaxf(s[kt][2], s[kt][3]));
    m = xrow_max(m);
    if (SWA) m = fmaxf(m, sink2);
    float l = 0.f;
#pragma unroll
    for (int kt = 0; kt < NT; ++kt)
#pragma unroll
        for (int r = 0; r < 4; ++r) { const float pe = fast_exp2(s[kt][r] - m); s[kt][r] = pe; l += pe; }
    l = xrow_sum(l);
    if (SWA) l += fast_exp2(sink2 - m);
    const float rl = 1.f / l;
    bf16x8 pf[NP];
#pragma unroll
    for (int sp = 0; sp < NP; ++sp) { u32x4 w; w.x = pk_bf16(s[2 * sp][0], s[2 * sp][1]); w.y = pk_bf16(s[2 * sp][2], s[2 * sp][3]); w.z = pk_bf16(s[2 * sp + 1][0], s[2 * sp + 1][1]); w.w = pk_bf16(s[2 * sp + 1][2], s[2 * sp + 1][3]);
        pf[sp] = __builtin_bit_cast(bf16x8, w); }
#pragma unroll
    for (int dt = 0; dt < DT; ++dt) { f32x4 o = (f32x4){0.f, 0.f, 0.f, 0.f};
#pragma unroll
        for (int sp = 0; sp < NP; ++sp) { LAS const unsigned char* vp = VTimg + (16 * dt + fr) * vstr + (32 * sp + 4 * g) * 2;
            const u32x2 lo = *(const LAS u32x2*)vp, hi = *(const LAS u32x2*)(vp + 32); const u32x4 w = {lo.x, lo.y, hi.x, hi.y};
            o = MFMA16(__builtin_bit_cast(bf16x8, w), pf[sp], o); }
        if constexpr (OUT8) { const float r8 = rl * CROSS_OSCALE; int w8 = __builtin_amdgcn_cvt_pk_fp8_f32(o[0] * r8, o[1] * r8, 0, false); w8 = __builtin_amdgcn_cvt_pk_fp8_f32(o[2] * r8, o[3] * r8, w8, true); *(unsigned*)(op8 + 16 * dt) = (unsigned)w8; }
        else { u32x2 ow; ow.x = pk_bf16(o[0] * rl, o[1] * rl); ow.y = pk_bf16(o[2] * rl, o[3] * rl); *(u32x2*)(op + 16 * dt) = ow; }
        __builtin_amdgcn_sched_barrier(0); }
}
constexpr int SWA_KSTR = 144, SWA_VSTR = 560, SWA_VT_OFF = 40960, SWA_NT = 10;
__device__ __forceinline__ void swa_phase(const Params& p, LAS unsigned char* lds, int tid, int wave, int lane) {
    unsigned char* ws = p.ws; bf16_t* Q = (bf16_t*)(ws + WS_Q); const bf16_t* Kb = (const bf16_t*)(ws + WS_K); const bf16_t* Vb = (const bf16_t*)(ws + WS_V);
    LAS unsigned char* Kimg = lds; LAS unsigned char* VTimg = lds + SWA_VT_OFF;
    for (int i = tid; i < 16 * SWA_KSTR / 4; i += NTHREADS) ((LAS unsigned*)(Kimg + 256 * SWA_KSTR))[i] = 0u;
    for (int i = tid; i < 64 * 8; i += NTHREADS) ((LAS unsigned*)(VTimg + (i >> 3) * SWA_VSTR + 512))[i & 7] = 0u;
    const int fr = lane & 15, g = lane >> 4;
    for (int unit = blockIdx.x; unit < BATCH * 4 * 16; unit += gridDim.x) {
        const int b = unit >> 6, kvh = (unit >> 4) & 3, qb = unit & 15;
        const bf16_t* Kg = Kb + (size_t)b * SEQ * 256 + kvh * 64; const bf16_t* Vg = Vb + (size_t)b * SEQ * 256 + kvh * 64;
        __syncthreads();
        u32x4 kvr[4], vvr[4];
#pragma unroll
        for (int it = 0; it < 4; ++it) { const int idx = tid + NTHREADS * it, key = idx & 255, c = idx >> 8, t = qb * 128 - 128 + key, tc = t >= 0 ? t : 0;
            kvr[it] = *(const u32x4*)(Kg + (size_t)tc * 256 + 8 * c); vvr[it] = *(const u32x4*)(Vg + (size_t)tc * 256 + 8 * c); }
#pragma unroll
        for (int it = 0; it < 4; ++it) { const int idx = tid + NTHREADS * it, key = idx & 255, c = idx >> 8, t = qb * 128 - 128 + key;
            const u32x4 z = {0u, 0u, 0u, 0u}; const u32x4 kv = t >= 0 ? kvr[it] : z, vv = t >= 0 ? vvr[it] : z;
            *(LAS u32x4*)(Kimg + key * SWA_KSTR + 16 * c) = kv;
#pragma unroll
            for (int i = 0; i < 8; ++i) *(LAS bf16_t*)(VTimg + (8 * c + i) * SWA_VSTR + key * 2) = (bf16_t)((vv[i >> 1] >> (16 * (i & 1))) & 0xffffu); }
        __syncthreads();
        const int head = kvh * 4 + (wave >> 1); const float sink2 = p.in[5][head] * LOG2E;
#pragma unroll 1
        for (int gi = 0; gi < 4; ++gi) { const int i0 = (wave & 1) * 64 + 16 * gi, jt0 = i0 >> 4; const size_t tok = (size_t)b * SEQ + qb * 128 + i0 + fr;
            attn_group<64, SWA_NT, true>(Q + tok * D_MODEL + head * 64 + 8 * g, Kimg + jt0 * 16 * SWA_KSTR, SWA_KSTR, VTimg + jt0 * 32, SWA_VSTR,
                                        Q + tok * D_MODEL + head * 64 + 4 * g, lane, i0, qb == 0 ? 128 : 0, jt0, sink2); }
    }
    __syncthreads();
}
constexpr int CR_KSTR = 272, CR_VSTR = 528, CR_VT_OFF = 69632;
__device__ __forceinline__ void cross_phase(const Params& p, LAS unsigned char* lds, int tid, int wave, int lane) {
    unsigned char* ws = p.ws; bf16_t* QC = (bf16_t*)(ws + WS_QC); const bf16_t* KVC = (const bf16_t*)(ws + WS_KVC);
    LAS unsigned char* Kimg = lds; LAS unsigned char* VTimg = lds + CR_VT_OFF;
    const int fr = lane & 15, g = lane >> 4;
    for (int unit = blockIdx.x; unit < BATCH * 4 * 2; unit += gridDim.x) {
        const int b = unit >> 3, h = (unit >> 1) & 3, half = unit & 1;
        const bf16_t* src = KVC + (size_t)b * MEM_LEN * 1024 + h * 128;
        __syncthreads();
        u32x4 kvr[8], vvr[8];
#pragma unroll
        for (int it = 0; it < 8; ++it) { const int idx = tid + NTHREADS * it, key = idx & 255, c = idx >> 8;
            kvr[it] = *(const u32x4*)(src + (size_t)key * 1024 + 8 * c); vvr[it] = *(const u32x4*)(src + (size_t)key * 1024 + 512 + 8 * c); }
#pragma unroll
        for (int it = 0; it < 8; ++it) { const int idx = tid + NTHREADS * it, key = idx & 255, c = idx >> 8; const u32x4 vv = vvr[it];
            *(LAS u32x4*)(Kimg + key * CR_KSTR + 16 * c) = kvr[it];
#pragma unroll
            for (int i = 0; i < 8; ++i) *(LAS bf16_t*)(VTimg + (8 * c + i) * CR_VSTR + key * 2) = (bf16_t)((vv[i >> 1] >> (16 * (i & 1))) & 0xffffu); }
        __syncthreads();
#pragma unroll 1
        for (int gi = 0; gi < 8; ++gi) { const size_t tok = (size_t)b * SEQ + half * 1024 + (wave * 8 + gi) * 16 + fr;
#if CROSS_FP8
            attn_group<128, 16, false, true>(QC + tok * 512 + h * 128 + 8 * g, Kimg, CR_KSTR, VTimg, CR_VSTR, nullptr, lane, 0, 0, 0, 0.f, ws + WS_QC8 + tok * 512 + h * 128 + 4 * g); }
#else
            attn_group<128, 16, false>(QC + tok * 512 + h * 128 + 8 * g, Kimg, CR_KSTR, VTimg, CR_VSTR, QC + tok * 512 + h * 128 + 4 * g, lane, 0, 0, 0, 0.f); }
#endif
    }
    __syncthreads();
}
constexpr int CK_STR = 144, CK_TSTR = 80;
constexpr int RW_LAM = 0, RW_A = 4096, RW_G = 8192, RW_V = 16384, RW_O = 24576;
constexpr int RW_AT = 28672, RW_RT = RW_AT + 16 * CK_STR, RW_BT = RW_RT + 16 * CK_STR, RW_KT = RW_BT + 16 * CK_STR;
constexpr int CK_VSTR = 40;
constexpr int RW_BKT = RW_KT + 16 * CK_STR, RW_VT = RW_BKT + 64 * CK_TSTR, RW_GA = RW_VT + 64 * CK_VSTR;
constexpr int RW_NN = RW_GA + 2 * 16 * CK_TSTR, RW_GC = RW_NN + 1024, RW_BON = RW_GC + 256, RW_C = RW_BON + 128, RWG_BYTES = RW_C + 2560;
constexpr int RW_MU = 2 * RWG_BYTES;
static_assert(RW_MU + 1024 <= LDS_BYTES - 16, "rwkv LDS map");
#define LBAR() do { asm volatile("s_waitcnt lgkmcnt(0)" ::: "memory"); __builtin_amdgcn_s_barrier(); asm volatile("" ::: "memory"); } while (0)
__device__ __forceinline__ f32x4 lds4(LAS const unsigned char* p) { return *(const LAS f32x4*)p; }
__device__ __forceinline__ void unpack8(const u32x4 w, float (&o)[8]) { o[0] = bf_lo(w.x); o[1] = bf_hi(w.x); o[2] = bf_lo(w.y); o[3] = bf_hi(w.y); o[4] = bf_lo(w.z); o[5] = bf_hi(w.z); o[6] = bf_lo(w.w); o[7] = bf_hi(w.w); }
__device__ __forceinline__ f32x4 unpack4(const u32x2 w) { return (f32x4){bf_lo(w.x), bf_hi(w.x), bf_lo(w.y), bf_hi(w.y)}; }
__device__ __forceinline__ u32x2 pack4(const f32x4 v) { u32x2 w; w.x = pk_bf16(v[0], v[1]); w.y = pk_bf16(v[2], v[3]); return w; }
__device__ __forceinline__ bf16_t bf16_of(float v) { return (bf16_t)(pk_bf16(v, 0.f) & 0xffffu); }
__device__ __forceinline__ float prefix16(float x) {
    x += dpp<0x111>(x); x += dpp<0x112>(x); x += dpp<0x114>(x); x += dpp<0x118>(x); return x; }
__device__ __forceinline__ bf16x8 frag2(LAS const unsigned char* p, int d) { const u32x2 lo = *(const LAS u32x2*)p, hi = *(const LAS u32x2*)(p + d); const u32x4 w = {lo.x, lo.y, hi.x, hi.y}; return __builtin_bit_cast(bf16x8, w); }
__device__ __forceinline__ bf16_t* act_row(unsigned char* ws, size_t row) { return (bf16_t*)(ws + (row < (size_t)T_TOK / 2 ? WS_ACT0 : WS_ACT1)) + (row & ((size_t)T_TOK / 2 - 1)) * 256; }
__device__ __forceinline__ void rwkv_act_phase(const Params& p, int wave, int lane) {
    unsigned char* ws = p.ws; const bf16_t* RW = (const bf16_t*)(ws + WS_RW);
    const int gw = blockIdx.x * NWAVES + wave, NGW = gridDim.x * NWAVES;
    const f32x4 mu4 = *(const f32x4*)(p.in[6] + 3072 + 4 * lane);
    for (int row = gw; row < T_TOK; row += NGW) {
        const f32x4 cu = unpack4(*(const u32x2*)(RW + (size_t)row * RW_W + 3072 + 4 * lane));
        const f32x4 z4 = {0.f, 0.f, 0.f, 0.f};
        const f32x4 pv = (row & (SEQ - 1)) ? unpack4(*(const u32x2*)(RW + (size_t)(row - 1) * RW_W + 3072 + 4 * lane)) : z4;
        f32x4 x = cu + (pv - cu) * mu4;
#pragma unroll
        for (int e = 0; e < 4; ++e) { const float th = 1.f - 2.f * fast_rcp(1.f + fast_exp2(2.f * LOG2E * x[e])), sg = sigmoidf_(x[e]); x[e] = lane < 16 ? th : (lane < 32 ? x[e] : sg); }
        *(u32x2*)(act_row(ws, (size_t)row) + 4 * lane) = pack4(x);
    }
}
__device__ __forceinline__ void rwkv_phase(const Params& p, LAS unsigned char* lds, int tid, int wave, int lane) {
    unsigned char* ws = p.ws;
    const bf16_t* RW = (const bf16_t*)(ws + WS_RW); bf16_t* Y = (bf16_t*)(ws + WS_Y);
    const int gidx = wave >> 2, wv = wave & 3, L = wv * 64 + lane;
    LAS unsigned char* gb = lds + gidx * RWG_BYTES;
    const int fr = lane & 15, g = lane >> 4;
    const int tk = L >> 4, cg = L & 15;
    const float* mu = p.in[6];
#if TABLES_LATE
    peer_tables_lowp(p, wave, lane);
#endif
#pragma unroll 1
    for (int pp = blockIdx.x; pp < BATCH * 16 / 2; pp += gridDim.x) {
        const int pair = pp * 2 + gidx, b = pair >> 4, h = pair & 15;
        __syncthreads();
        if (L < 64) { LAS float* C = (LAS float*)(gb + RW_C); const int c = h * 64 + L;
            C[0 * 64 + L] = mu[c]; C[1 * 64 + L] = mu[1024 + c]; C[2 * 64 + L] = mu[2048 + c]; C[3 * 64 + L] = p.in[12][c]; C[4 * 64 + L] = p.in[13][c];
            C[5 * 64 + L] = p.in[14][c]; C[6 * 64 + L] = p.in[15][c]; C[7 * 64 + L] = p.in[16][c]; C[8 * 64 + L] = p.in[7][c]; C[9 * 64 + L] = p.in[9][c]; }
        for (int i = L; i < 2 * 16 * CK_TSTR / 4; i += 256) ((LAS unsigned*)(gb + RW_GA))[i] = 0u;
        bf16x8 wf[8];
        {   const bf16_t* W2 = (const bf16_t*)(ws + WS_W2T) + (size_t)(h * 64 + 16 * wv + fr) * 64 + 8 * g; const bf16_t* A2 = (const bf16_t*)(ws + WS_A2T) + (size_t)(h * 64 + 16 * wv + fr) * 64 + 8 * g;
            const bf16_t* G2 = (const bf16_t*)(ws + WS_G2T) + (size_t)(h * 64 + 16 * wv + fr) * 128 + 8 * g;
#pragma unroll
            for (int ks = 0; ks < 2; ++ks) { wf[ks] = *(const bf16x8*)(W2 + 32 * ks); wf[2 + ks] = *(const bf16x8*)(A2 + 32 * ks); }
#pragma unroll
            for (int ks = 0; ks < 4; ++ks) wf[4 + ks] = *(const bf16x8*)(G2 + 32 * ks); }
        f32x4 M[4];
#pragma unroll
        for (int kt = 0; kt < 4; ++kt) M[kt] = (f32x4){0.f, 0.f, 0.f, 0.f};
        const bf16_t* rwb = RW + (size_t)b * SEQ * RW_W;
        u32x4 p1c[8]; u32x2 p2c[3], p2p[3];
#define RW_PREF1(T0) do { const int tq_ = (T0) + fr < SEQ ? (T0) + fr : SEQ - 1; const bf16_t* ar_ = act_row(ws, (size_t)b * SEQ + tq_) + 8 * g; \
            _Pragma("unroll") for (int ks = 0; ks < 8; ++ks) p1c[ks] = *(const u32x4*)(ar_ + 32 * ks); } while (0)
#define RW_PREF2(T0) do { const int u_ = (T0) + tk < SEQ ? (T0) + tk : SEQ - 1, up_ = u_ > 0 ? u_ - 1 : 0; \
            _Pragma("unroll") for (int q = 0; q < 3; ++q) { p2c[q] = *(const u32x2*)(rwb + (size_t)u_ * RW_W + 1024 * q + h * 64 + 4 * cg); p2p[q] = *(const u32x2*)(rwb + (size_t)up_ * RW_W + 1024 * q + h * 64 + 4 * cg); } } while (0)
        RW_PREF1(0); RW_PREF2(0);
        LBAR();
#pragma unroll 1
        for (int ci = -1; ci < SEQ / 16; ++ci) {
            const int cn = ci + 1; const bool has_n = cn < SEQ / 16, has_c = ci >= 0;
            if (has_n) {
            {   f32x4 aw = lds4(gb + RW_C + 8 * 256 + (16 * wv + 4 * g) * 4), aa = lds4(gb + RW_C + 9 * 256 + (16 * wv + 4 * g) * 4), ag = (f32x4){0.f, 0.f, 0.f, 0.f};
#pragma unroll
                for (int ks = 0; ks < 2; ++ks) { aw = MFMA16(wf[ks], __builtin_bit_cast(bf16x8, p1c[ks]), aw); aa = MFMA16(wf[2 + ks], __builtin_bit_cast(bf16x8, p1c[2 + ks]), aa); }
#pragma unroll
                for (int ks = 0; ks < 4; ++ks) ag = MFMA16(wf[4 + ks], __builtin_bit_cast(bf16x8, p1c[4 + ks]), ag);
                f32x4 ow, oa;
#pragma unroll
                for (int r = 0; r < 4; ++r) { ow[r] = prefix16(-0.8750387749145276f * sigmoidf_(aw[r])); oa[r] = sigmoidf_(aa[r]); }
                const int o_ = fr * 256 + (16 * wv + 4 * g) * 4;
                *(LAS f32x4*)(gb + RW_LAM + o_) = ow; *(LAS f32x4*)(gb + RW_A + o_) = oa; *(LAS f32x4*)(gb + RW_G + (cn & 1) * 4096 + o_) = ag;
            }
            }
            RW_PREF1(16 * cn + 16);
            if (has_c) {
            {   bf16x8 mf[2];
#pragma unroll
                for (int ks = 0; ks < 2; ++ks) { u32x4 w; w.x = pk_bf16(M[2 * ks][0], M[2 * ks][1]); w.y = pk_bf16(M[2 * ks][2], M[2 * ks][3]); w.z = pk_bf16(M[2 * ks + 1][0], M[2 * ks + 1][1]); w.w = pk_bf16(M[2 * ks + 1][2], M[2 * ks + 1][3]);
                    mf[ks] = __builtin_bit_cast(bf16x8, w); }
                f32x4 x1 = (f32x4){0.f, 0.f, 0.f, 0.f}, x2 = x1;
#pragma unroll
                for (int ks = 0; ks < 2; ++ks) { x1 = MFMA16(frag2(gb + RW_AT + fr * CK_STR + (32 * ks + 4 * g) * 2, 32), mf[ks], x1); x2 = MFMA16(frag2(gb + RW_RT + fr * CK_STR + (32 * ks + 4 * g) * 2, 32), mf[ks], x2); }
                const u32x2 vfr = *(const LAS u32x2*)(gb + RW_VT + (16 * wv + fr) * CK_VSTR + 8 * g);
                f32x4 nt[15];
#pragma unroll
                for (int sc = 0; sc < 15; ++sc) nt[sc] = lds4(gb + RW_NN + sc * 64 + g * 16);
                const bf16x8 ga_r = *(const LAS bf16x8*)(gb + RW_GA + fr * CK_TSTR + 16 * g), ga_o = *(const LAS bf16x8*)(gb + RW_GA + 16 * CK_TSTR + fr * CK_TSTR + 16 * g);
                { const u32x4 w = {0u, 0u, vfr.x, vfr.y}; x1 = MFMA16(ga_r, __builtin_bit_cast(bf16x8, w), x1); }
                float u[4] = {x1[0], x1[1], x1[2], x1[3]};
#pragma unroll
                for (int sc = 0; sc < 15; ++sc) {
                    const auto a_ = __builtin_amdgcn_permlane32_swap(__float_as_uint(u[sc & 3]), __float_as_uint(u[sc & 3]), false, false); const unsigned y_ = (sc >> 2) >= 2 ? a_[1] : a_[0];
                    const auto b_ = __builtin_amdgcn_permlane16_swap(y_, y_, false, false); const float ub = __uint_as_float(((sc >> 2) & 1) ? b_[1] : b_[0]);
#pragma unroll
                    for (int r = 0; r < 4; ++r) u[r] = fmaf(nt[sc][r], ub, u[r]); }
                const u32x4 uvw = {pk_bf16(u[0], u[1]), pk_bf16(u[2], u[3]), vfr.x, vfr.y}; const bf16x8 uv1 = __builtin_bit_cast(bf16x8, uvw);
                x2 = MFMA16(ga_o, uv1, x2);
#pragma unroll
                for (int r = 0; r < 4; ++r) *(LAS float*)(gb + RW_O + (4 * g + r) * 256 + (16 * wv + fr) * 4) = x2[r];
#pragma unroll
                for (int kt = 0; kt < 4; ++kt) { M[kt] = MFMA16(*(const LAS bf16x8*)(gb + RW_BKT + (16 * kt + fr) * CK_TSTR + 16 * g), uv1, M[kt]); M[kt] = M[kt] * lds4(gb + RW_GC + (16 * kt + 4 * g) * 4); }
            }
            }
            LBAR();
            if (has_n) {
            {   LAS const unsigned char* C = gb + RW_C + cg * 16; const bool first = (16 * cn + tk) == 0;
                const f32x4 rc = unpack4(p2c[0]), kc = unpack4(p2c[1]), vc = unpack4(p2c[2]);
                const f32x4 z4 = {0.f, 0.f, 0.f, 0.f};
                const f32x4 rp = first ? z4 : unpack4(p2p[0]), kp_ = first ? z4 : unpack4(p2p[1]), vp = first ? z4 : unpack4(p2p[2]);
                const f32x4 rs = rc + (rp - rc) * lds4(C), ksh = kc + (kp_ - kc) * lds4(C + 256), vs = vc + (vp - vc) * lds4(C + 512);
                const f32x4 a = lds4(gb + RW_A + tk * 256 + cg * 16);
                f32x4 kk = ksh * lds4(C + 768);
                const float ss = sum16((kk[0] * kk[0] + kk[1] * kk[1]) + (kk[2] * kk[2] + kk[3] * kk[3]));
                kk = kk * (1.f / fmaxf(sqrtf(ss), 1e-12f));
                const f32x4 kpv = ksh * (1.f + (a - 1.f) * lds4(C + 1024));
                const f32x4 rkk = rs * kpv * lds4(C + 1280);
                const float bon = sum16((rkk[0] + rkk[1]) + (rkk[2] + rkk[3]));
                const f32x4 lam = lds4(gb + RW_LAM + tk * 256 + cg * 16), lamp = tk > 0 ? lds4(gb + RW_LAM + (tk - 1) * 256 + cg * 16) : z4;
                f32x4 gm, gp, gi;
#pragma unroll
                for (int e = 0; e < 4; ++e) { gm[e] = fast_exp2(lam[e]); gp[e] = fast_exp2(lamp[e]); gi[e] = fast_exp2(-lam[e]); }
                const f32x4 At = -kk * gp, Rt = rs * gm, Bt = kk * a * gi, Kt = kpv * gi;
                const int ro = tk * CK_STR + cg * 8;
                *(LAS u32x2*)(gb + RW_AT + ro) = pack4(At); *(LAS u32x2*)(gb + RW_RT + ro) = pack4(Rt); *(LAS u32x2*)(gb + RW_BT + ro) = pack4(Bt); *(LAS u32x2*)(gb + RW_KT + ro) = pack4(Kt);
#pragma unroll
                for (int e = 0; e < 4; ++e) { LAS unsigned char* q = gb + RW_BKT + (4 * cg + e) * CK_TSTR + (8 * (tk >> 2) + (tk & 3)) * 2;
                    *(LAS bf16_t*)q = bf16_of(Bt[e]); *(LAS bf16_t*)(q + 8) = bf16_of(Kt[e]); *(LAS bf16_t*)(gb + RW_VT + (4 * cg + e) * CK_VSTR + tk * 2) = bf16_of(vs[e]); }
                *(LAS f32x4*)(gb + RW_V + (cn & 1) * 4096 + tk * 256 + cg * 16) = vs;
                if (tk == 15) *(LAS f32x4*)(gb + RW_GC + cg * 16) = gm;
                if (cg == 0) *(LAS float*)(gb + RW_BON + (cn & 1) * 64 + tk * 4) = bon; }
            }
            RW_PREF2(16 * cn + 16);
            if (has_c) {
            {   LAS const unsigned char* C = gb + RW_C + cg * 16; const int o_ = tk * 256 + cg * 16;
                const f32x4 o = lds4(gb + RW_O + o_);
                const float mean = sum16((o[0] + o[1]) + (o[2] + o[3])) * (1.f / 64.f);
                const f32x4 d = o - mean;
                const float var = sum16((d[0] * d[0] + d[1] * d[1]) + (d[2] * d[2] + d[3] * d[3])) * (1.f / 64.f);
                const f32x4 on = d * (1.f / sqrtf(var + 64e-5f)) * lds4(C + 1536) + lds4(C + 1792);
                const f32x4 vs = lds4(gb + RW_V + (ci & 1) * 4096 + o_); const float bon = *(const LAS float*)(gb + RW_BON + (ci & 1) * 64 + tk * 4);
                const f32x4 gg = lds4(gb + RW_G + (ci & 1) * 4096 + o_);
                const f32x4 y = (on + vs * bon) * gg;
                *(u32x2*)(Y + ((size_t)b * SEQ + 16 * ci + tk) * D_MODEL + h * 64 + 4 * cg) = pack4(y); }
            }
            LBAR();
            if (has_n) {
            {   LAS const unsigned char* Xa = gb + (wv < 2 ? RW_AT : RW_RT) + fr * CK_STR + 16 * g; LAS const unsigned char* Yb = gb + ((wv & 1) ? RW_KT : RW_BT) + fr * CK_STR + 16 * g;
                f32x4 d = (f32x4){0.f, 0.f, 0.f, 0.f};
#pragma unroll
                for (int ks = 0; ks < 2; ++ks) d = MFMA16(*(const LAS bf16x8*)(Xa + 64 * ks), *(const LAS bf16x8*)(Yb + 64 * ks), d);
                f32x4 dm;
#pragma unroll
                for (int r = 0; r < 4; ++r) { const int t = 4 * g + r; const bool keep = wv < 2 ? (fr < t) : (fr <= t); dm[r] = keep ? d[r] : 0.f; }
                if (wv == 0) *(LAS f32x4*)(gb + RW_NN + fr * 64 + g * 16) = dm;
                else {
#pragma unroll
                    for (int r = 0; r < 4; ++r) *(LAS bf16_t*)(gb + RW_GA + (wv == 1 ? 0 : 16 * CK_TSTR) + (4 * g + r) * CK_TSTR + (8 * (fr >> 2) + (fr & 3) + (wv == 2 ? 0 : 4)) * 2) = bf16_of(dm[r]); } }
            }
            LBAR();
        }
#undef RW_PREF1
#undef RW_PREF2
    }
    __syncthreads();
}
#define MFMA32(a, b, c) __builtin_amdgcn_mfma_f32_32x32x16_bf16((a), (b), (c), 0, 0, 0)
constexpr int PK_STR = 272, PK2_OFF = 128 * PK_STR;
__device__ __forceinline__ void ce_(float& a, float& b) { const float hi = fmaxf(a, b), lo = fminf(a, b); a = hi; b = lo; }
template <int LO, int N, int R> __device__ __forceinline__ void oe_merge(float (&v)[16]) {
    constexpr int M = R * 2;
    if constexpr (M < N) { oe_merge<LO, N, M>(v); oe_merge<LO + R, N, M>(v);
#pragma unroll
        for (int i = LO + R; i + R < LO + N; i += M) ce_(v[i], v[i + R]); }
    else ce_(v[LO], v[LO + R]);
}
template <int LO, int N> __device__ __forceinline__ void oe_sort(float (&v)[16]) {
    if constexpr (N > 1) { oe_sort<LO, N / 2>(v); oe_sort<LO + N / 2, N / 2>(v); oe_merge<LO, N, 1>(v); }
}
__device__ __forceinline__ void merge_top16(float (&a)[16], const float (&b)[16]) {
#pragma unroll
    for (int i = 0; i < 16; ++i) a[i] = fmaxf(a[i], b[15 - i]);
#pragma unroll
    for (int st = 8; st >= 1; st >>= 1)
#pragma unroll
        for (int i = 0; i < 16; ++i) if ((i & st) == 0) ce_(a[i], a[i + st]);
}
__device__ __forceinline__ void topk_side(float (&Lst)[16], const bf16_t* qptr, LAS const unsigned char* Kimg, int c, int hh) {
    f32x16 acc[4];
#pragma unroll
    for (int kt = 0; kt < 4; ++kt)
#pragma unroll
        for (int i = 0; i < 16; ++i) acc[kt][i] = 0.f;
#pragma unroll
    for (int ks = 0; ks < 8; ++ks) { const bf16x8 bq = *(const bf16x8*)(qptr + 16 * ks + 8 * hh);
#pragma unroll
        for (int kt = 0; kt < 4; ++kt) { const bf16x8 ak = *(const LAS bf16x8*)(Kimg + (32 * kt + c) * PK_STR + (16 * ks + 8 * hh) * 2); acc[kt] = MFMA32(ak, bq, acc[kt]); } }
    float g1[16], g2[16], g3[16];
#pragma unroll
    for (int i = 0; i < 16; ++i) { const unsigned idx = (unsigned)((i & 3) + 8 * (i >> 2)) + 4u * (unsigned)hh;
        Lst[i] = __uint_as_float((__float_as_uint(acc[0][i]) & 0xFFFFFF80u) | idx); g1[i] = __uint_as_float((__float_as_uint(acc[1][i]) & 0xFFFFFF80u) | (idx + 32u));
        g2[i] = __uint_as_float((__float_as_uint(acc[2][i]) & 0xFFFFFF80u) | (idx + 64u)); g3[i] = __uint_as_float((__float_as_uint(acc[3][i]) & 0xFFFFFF80u) | (idx + 96u)); }
    oe_sort<0, 16>(Lst); oe_sort<0, 16>(g1); oe_sort<0, 16>(g2); oe_sort<0, 16>(g3);
    merge_top16(Lst, g1); merge_top16(g2, g3); merge_top16(Lst, g2);
    float oth[16];
#pragma unroll
    for (int q = 0; q < 16; ++q) { auto r = __builtin_amdgcn_permlane32_swap(__float_as_uint(Lst[q]), __float_as_uint(Lst[q]), false, false); oth[q] = __uint_as_float(hh ? r[0] : r[1]); }
    merge_top16(Lst, oth);
}
__device__ __forceinline__ void peer_route_stage_keys(const Params& p, LAS unsigned char* lds, int tid) {
    unsigned char* ws = p.ws;
    __syncthreads();
    for (int idx = tid; idx < 2 * 128 * 16; idx += NTHREADS) { const int which = idx >> 11, rem = idx & 2047, key = rem >> 4, cc = rem & 15;
        *(LAS u32x4*)(lds + which * PK2_OFF + key * PK_STR + 16 * cc) = ((const u32x4*)(ws + (which ? WS_PK2 : WS_PK1)))[key * 16 + cc]; }
    __syncthreads();
}
__device__ __forceinline__ void peer_route_task(const Params& p, LAS unsigned char* lds, int task, int lane) {
    unsigned char* ws = p.ws; const bf16_t* PQ = (const bf16_t*)(ws + WS_PQ); int* RE = (int*)(ws + WS_RE); float* RS = (float*)(ws + WS_RS);
    const int c = lane & 31, hh = lane >> 5;
    {
        const size_t row = (size_t)task * 32 + c; const bf16_t* qptr = PQ + row * 256;
        float L1[16], L2[16];
        topk_side(L1, qptr, lds, c, hh);
        topk_side(L2, qptr + 128, lds + PK2_OFF, c, hh);
        float v1[16], v2[16];
#pragma unroll
        for (int q = 0; q < 16; ++q) { v1[q] = __uint_as_float(__float_as_uint(L1[q]) & 0xFFFFFF80u); v2[q] = __uint_as_float(__float_as_uint(L2[q]) & 0xFFFFFF80u); }
        float Tt[16], T1[16];
        {   float cand[64]; int nc = 0;
#pragma unroll
            for (int i = 0; i < 16; ++i)
#pragma unroll
                for (int j = 0; j < 16; ++j) if ((i + 1) * (j + 1) <= 16) { cand[nc] = v1[i] + v2[j]; ++nc; }
#pragma unroll
            for (int q = 0; q < 16; ++q) { Tt[q] = hh ? cand[32 + q] : cand[q]; T1[q] = hh ? ((48 + q < 50) ? cand[48 + q] : -3.0e38f) : cand[16 + q]; } }
        oe_sort<0, 16>(Tt); oe_sort<0, 16>(T1);
        merge_top16(Tt, T1);
        {   float oth[16];
#pragma unroll
            for (int q = 0; q < 16; ++q) { auto r = __builtin_amdgcn_permlane32_swap(__float_as_uint(Tt[q]), __float_as_uint(Tt[q]), false, false); oth[q] = __uint_as_float(hh ? r[0] : r[1]); }
            merge_top16(Tt, oth); }
        const float tau = Tt[15];
        int cnt = 0;
#pragma unroll
        for (int i = 0; i < 16; ++i)
#pragma unroll
            for (int j = 0; j < 16; ++j) if ((i + 1) * (j + 1) <= 16) { const float sm = v1[i] + v2[j];
                if (sm >= tau && cnt < 16 && hh == 0) { const int e = (int)((__float_as_uint(L1[i]) & 127u) * 128u + (__float_as_uint(L2[j]) & 127u)); RE[row * 16 + cnt] = e; RS[row * 16 + cnt] = sm; ++cnt; } }
    }
}
__device__ __forceinline__ void peer_route_phase(const Params& p, LAS unsigned char* lds, int tid, int wave, int lane) {
    peer_route_stage_keys(p, lds, tid);
#pragma unroll 1
    for (int task = blockIdx.x * NWAVES + wave; task < T_TOK / 4; task += gridDim.x * NWAVES) peer_route_task(p, lds, task, lane);
}
__device__ __forceinline__ float gelu_erf(float v) {
    const float av = fabsf(v), t = fast_rcp(av * 0.2316418882f + 1.0f);
    float q = t * 0.5307027145f + (-0.7265760135f); q = q * t + 0.7107068705f; q = q * t + (-0.142248368f); q = q * t + 0.127414796f; q = q * t;
    const float e = fast_exp2(v * v * (-0.72134752044f)); const float m = v * (q * e);
    return v < 0.f ? m : v - m;
}
__device__ __forceinline__ void unpack_fp8x16(const u32x4 w, float (&o)[16]) {
#pragma unroll
    for (int q = 0; q < 4; ++q) { const f32x2 lo = __builtin_amdgcn_cvt_pk_f32_fp8((int)w[q], false), hi = __builtin_amdgcn_cvt_pk_f32_fp8((int)w[q], true);
        o[4 * q] = lo.x; o[4 * q + 1] = lo.y; o[4 * q + 2] = hi.x; o[4 * q + 3] = hi.y; }
}
__device__ __forceinline__ float wave_prefix_incl(float x) {
    x = prefix16(x);
    const float t0 = __builtin_bit_cast(float, __builtin_amdgcn_readlane(__builtin_bit_cast(int, x), 15)), t1 = __builtin_bit_cast(float, __builtin_amdgcn_readlane(__builtin_bit_cast(int, x), 31)),
                t2 = __builtin_bit_cast(float, __builtin_amdgcn_readlane(__builtin_bit_cast(int, x), 47));
    const int row = (int)(__builtin_amdgcn_mbcnt_hi(~0u, __builtin_amdgcn_mbcnt_lo(~0u, 0u)) >> 4);
    return x + (row >= 1 ? t0 : 0.f) + (row >= 2 ? t1 : 0.f) + (row >= 3 ? t2 : 0.f);
}
template <class BarT> __device__ __forceinline__ void bar_sync(const BarT& b);
#ifndef GNT
#define GNT 2
#endif
#ifndef GATHER_SPLIT
#define GATHER_SPLIT 0
#endif

#ifndef GATHER_PROBE_LOADS
#define GATHER_PROBE_LOADS 0
#endif
#ifndef GATHER_PROBE2
#define GATHER_PROBE2 0
#endif
#ifndef VSET
#define VSET 4
#endif
#ifndef VBUF4
#define VBUF4 0
#endif
#ifndef UBUF4
#define UBUF4 0
#endif
#ifndef PEER_FUSED
#define PEER_FUSED 0
#endif
template <class BarT> __device__ __forceinline__ void bar_sync(const BarT& b);
template <class BarT> __device__ __forceinline__ void peer_gather_phase(const Params& p, LAS unsigned char* lds, int wave, int lane, float amp, const BarT& bar) {
    unsigned char* ws = p.ws; const bf16_t* H = (const bf16_t*)(ws + WS_H); const unsigned char* PU = ws + WS_PU; const unsigned char* PV = ws + WS_PV;
    const int* RE = (const int*)(ws + WS_RE); const float* RS = (const float*)(ws + WS_RS);
    const int gw = blockIdx.x * NWAVES + wave, NGW = gridDim.x * NWAVES;
    const float* gf = p.in[29] + 16 * lane;
#if PEER_FUSED
    LAS unsigned char* wb = lds + 2 * PK2_OFF + wave * (512 + 4096); LAS unsigned* cnt = (LAS unsigned*)wb; LAS unsigned char* lst = wb + 512;
    peer_route_stage_keys(p, lds, (int)(wave * 64 + lane));
#else
    LAS unsigned char* wb = lds + wave * (512 + 4096 + 8192); LAS unsigned* cnt = (LAS unsigned*)wb; LAS unsigned char* lst = wb + 512; LAS unsigned char* hxl = wb + 512 + 4096 + lane * 32;
#endif
    __syncthreads();
    const f32x4 g0 = *(const f32x4*)(gf), g1 = *(const f32x4*)(gf + 4), g2 = *(const f32x4*)(gf + 8), g3 = *(const f32x4*)(gf + 12);
    const int ngroups = (T_TOK + GNT - 1) / GNT, nrounds = (ngroups + NGW - 1) / NGW;
#pragma unroll 1
    for (int rnd = 0; rnd < nrounds; ++rnd) {
        const int tok0 = (rnd * NGW + gw) * GNT;
#if GATHER_SYNC
        if (rnd > 0 && (rnd % GATHER_SYNC) == 0) bar_sync(bar);
#endif
#if PEER_FUSED
        if (tok0 < T_TOK) peer_route_task(p, lds, tok0 >> 2, lane);
        asm volatile("s_waitcnt vmcnt(0)" ::: "memory");
#endif
#if PEER_FUSED
#define GS_KEEP(S) do { } while (0)
#else
#define GS_KEEP(S) do { *(LAS u32x4*)(hxl + S * 2048) = xa; *(LAS u32x4*)(hxl + S * 2048 + 16) = xb; } while (0)
#endif
#if GATHER_UI4
#define GS_DECL(S) float ac##S[16]; float c1_##S; float hs_##S
#define GS_AMAX(S) do { float am_ = 0.f; _Pragma("unroll") for (int j = 0; j < 16; ++j) am_ = fmaxf(am_, fabsf(hx_[j])); \
            hs_##S = 119.f / fmaxf(xrow_max(max16(am_)), 1e-20f); c1_##S = c1_##S * (512.f / PU_QS) / hs_##S; } while (0)
#else
#define GS_DECL(S) float ac##S[16]; float c1_##S
#define GS_AMAX(S) do { } while (0)
#endif
#define GS_HX(XA, XB) float hx_[16]; hx_[0] = bf_lo(XA.x); hx_[1] = bf_hi(XA.x); hx_[2] = bf_lo(XA.y); hx_[3] = bf_hi(XA.y); hx_[4] = bf_lo(XA.z); hx_[5] = bf_hi(XA.z); hx_[6] = bf_lo(XA.w); hx_[7] = bf_hi(XA.w); \
            hx_[8] = bf_lo(XB.x); hx_[9] = bf_hi(XB.x); hx_[10] = bf_lo(XB.y); hx_[11] = bf_hi(XB.y); hx_[12] = bf_lo(XB.z); hx_[13] = bf_hi(XB.z); hx_[14] = bf_lo(XB.w); hx_[15] = bf_hi(XB.w)
#define GS_SETUP(S) do { const int t_ = tok0 + S < T_TOK ? tok0 + S : T_TOK - 1; \
            const u32x4 xa = *(const u32x4*)(H + (size_t)t_ * D_MODEL + 16 * lane), xb = *(const u32x4*)(H + (size_t)t_ * D_MODEL + 16 * lane + 8); \
            GS_KEEP(S); GS_HX(xa, xb); \
            float ss_ = 0.f; _Pragma("unroll") for (int j = 0; j < 16; ++j) { ss_ = fmaf(hx_[j], hx_[j], ss_); ac##S[j] = 0.f; } \
            c1_##S = (1.f / 512.f) / sqrtf(wave_sum(ss_) * (1.f / D_MODEL) + RMS_EPS); \
            GS_AMAX(S); \
            const int e0_ = RE[(size_t)t_ * 128 + lane], e1_ = RE[(size_t)t_ * 128 + 64 + lane]; const float s0_ = RS[(size_t)t_ * 128 + lane], s1_ = RS[(size_t)t_ * 128 + 64 + lane]; \
            const float p0_ = fast_exp2((s0_ - max16(s0_)) * LOG2E), p1_ = fast_exp2((s1_ - max16(s1_)) * LOG2E); \
            const float gt0_ = p0_ / sum16(p0_) * (1.f / PV_SCALE), gt1_ = p1_ / sum16(p1_) * (1.f / PV_SCALE); \
            cnt[lane] = 0u; LDS_WAIT(); \
            const unsigned r0_ = __hip_atomic_fetch_add(cnt + (e0_ >> 8), 1u, __ATOMIC_RELAXED, __HIP_MEMORY_SCOPE_WAVEFRONT), r1_ = __hip_atomic_fetch_add(cnt + (e1_ >> 8), 1u, __ATOMIC_RELAXED, __HIP_MEMORY_SCOPE_WAVEFRONT); \
            LDS_WAIT(); \
            { const float cf_ = (float)cnt[lane]; const float incl_ = wave_prefix_incl(cf_); LDS_WAIT(); cnt[lane] = (unsigned)(incl_ - cf_); LDS_WAIT(); } \
            { LAS u32x2* list_ = (LAS u32x2*)(lst + S * 1024); list_[cnt[e0_ >> 8] + r0_] = (u32x2){(unsigned)e0_, __float_as_uint(gt0_)}; list_[cnt[e1_ >> 8] + r1_] = (u32x2){(unsigned)e1_, __float_as_uint(gt1_)}; } \
            LDS_WAIT(); } while (0)
#define GS_FIN(S) do { const u32x4 xa = *(const LAS u32x4*)(hxl + S * 2048), xb = *(const LAS u32x4*)(hxl + S * 2048 + 16); GS_HX(xa, xb); float s3_ = 0.f; _Pragma("unroll") for (int j = 0; j < 16; ++j) { hx_[j] = fmaf(amp, ac##S[j], hx_[j]); s3_ = fmaf(hx_[j], hx_[j], s3_); } \
            const float r3_ = 1.f / sqrtf(wave_sum(s3_) * (1.f / D_MODEL) + RMS_EPS); float* orow = p.out + (size_t)(tok0 + S) * D_MODEL + 16 * lane; if (tok0 + S < T_TOK) { \
            *(f32x4*)(orow) = (f32x4){hx_[0], hx_[1], hx_[2], hx_[3]} * r3_ * g0; *(f32x4*)(orow + 4) = (f32x4){hx_[4], hx_[5], hx_[6], hx_[7]} * r3_ * g1; \
            *(f32x4*)(orow + 8) = (f32x4){hx_[8], hx_[9], hx_[10], hx_[11]} * r3_ * g2; *(f32x4*)(orow + 12) = (f32x4){hx_[12], hx_[13], hx_[14], hx_[15]} * r3_ * g3; } } while (0)
#define G_LOAD(X, S, C) do { _Pragma("unroll") for (int i = 0; i < 4; ++i) { const size_t e_ = (size_t)(unsigned)__builtin_amdgcn_readfirstlane((int)((const LAS u32x2*)(lst + S * 1024))[4 * (C) + i].x); \
            X##u[i] = *(const u32x4*)(PU + e_ * D_MODEL + 16 * lane); X##v[i] = *(const u32x4*)(PV + e_ * D_MODEL + 16 * lane); } } while (0)
#define G_PROC(X, S, C) do { float pd_[4]; const u32x4 xa = *(const LAS u32x4*)(hxl + S * 2048), xb = *(const LAS u32x4*)(hxl + S * 2048 + 16); GS_HX(xa, xb); \
            _Pragma("unroll") for (int i = 0; i < 4; ++i) { float uf[16]; unpack_fp8x16(X##u[i], uf); float da = uf[0] * hx_[0], db = uf[1] * hx_[1]; \
                _Pragma("unroll") for (int j = 2; j < 16; j += 2) { da = fmaf(uf[j], hx_[j], da); db = fmaf(uf[j + 1], hx_[j + 1], db); } pd_[i] = da + db; } \
              \
            const auto s01_ = __builtin_amdgcn_permlane32_swap(__float_as_uint(pd_[0]), __float_as_uint(pd_[1]), false, false); const float r01_ = __uint_as_float(s01_[0]) + __uint_as_float(s01_[1]); \
            const auto s23_ = __builtin_amdgcn_permlane32_swap(__float_as_uint(pd_[2]), __float_as_uint(pd_[3]), false, false); const float r23_ = __uint_as_float(s23_[0]) + __uint_as_float(s23_[1]); \
            const auto sq_ = __builtin_amdgcn_permlane16_swap(__float_as_uint(r01_), __float_as_uint(r23_), false, false); const float dsum_ = sum16(__uint_as_float(sq_[0]) + __uint_as_float(sq_[1])); \
            const float q0_ = __uint_as_float(((const LAS u32x2*)(lst + S * 1024))[4 * (C)].y), q1_ = __uint_as_float(((const LAS u32x2*)(lst + S * 1024))[4 * (C) + 1].y), \
                        q2_ = __uint_as_float(((const LAS u32x2*)(lst + S * 1024))[4 * (C) + 2].y), q3_ = __uint_as_float(((const LAS u32x2*)(lst + S * 1024))[4 * (C) + 3].y); \
            const float gsel_ = lane < 16 ? q0_ : (lane < 32 ? q2_ : (lane < 48 ? q1_ : q3_)); \
            const float wvec_ = gelu_erf(dsum_ * c1_##S) * gsel_; float w_[4]; \
            w_[0] = __builtin_bit_cast(float, __builtin_amdgcn_readlane(__builtin_bit_cast(int, wvec_), 0)); w_[2] = __builtin_bit_cast(float, __builtin_amdgcn_readlane(__builtin_bit_cast(int, wvec_), 16)); \
            w_[1] = __builtin_bit_cast(float, __builtin_amdgcn_readlane(__builtin_bit_cast(int, wvec_), 32)); w_[3] = __builtin_bit_cast(float, __builtin_amdgcn_readlane(__builtin_bit_cast(int, wvec_), 48)); \
            _Pragma("unroll") for (int i = 0; i < 4; ++i) { float vf[16]; unpack_fp8x16(X##v[i], vf); _Pragma("unroll") for (int j = 0; j < 16; ++j) ac##S[j] = fmaf(w_[i], vf[j], ac##S[j]); } } while (0)
        u32x4 Au[4], Av[4], Bu[4], Bv[4];
#if GNT == 2
        GS_DECL(0); GS_DECL(1); GS_SETUP(0); GS_SETUP(1);
        G_LOAD(A, 0, 0);
#pragma unroll 1
        for (int c = 0; c < 32; ++c) {
            G_LOAD(B, 1, c); G_PROC(A, 0, c);
            if (c < 31) G_LOAD(A, 0, c + 1);
            G_PROC(B, 1, c);
        }
        GS_FIN(0); GS_FIN(1);
#elif GNT == 3
        GS_DECL(0); GS_DECL(1); GS_DECL(2); GS_SETUP(0); GS_SETUP(1); GS_SETUP(2);
        G_LOAD(A, 0, 0);
#pragma unroll 1
        for (int c = 0; c < 32; c += 2) {
            G_LOAD(B, 1, c); G_PROC(A, 0, c);
            G_LOAD(A, 2, c); G_PROC(B, 1, c);
            G_LOAD(B, 0, c + 1); G_PROC(A, 2, c);
            G_LOAD(A, 1, c + 1); G_PROC(B, 0, c + 1);
            G_LOAD(B, 2, c + 1); G_PROC(A, 1, c + 1);
            if (c < 30) G_LOAD(A, 0, c + 2);
            G_PROC(B, 2, c + 1);
        }
        GS_FIN(0); GS_FIN(1); GS_FIN(2);
#elif GNT == 4 && GATHER_SPLIT
        GS_DECL(0); GS_DECL(1); GS_DECL(2); GS_DECL(3); GS_SETUP(0); GS_SETUP(1); GS_SETUP(2); GS_SETUP(3);
#if GATHER_UI4
        {   u32x4 Ar[8], Br[8];
            const int un = lane & 31, uh = lane >> 5; const auto rsU = __builtin_amdgcn_make_buffer_rsrc((void*)PU, 0, N_EXPERTS * PU_ROWB, 0x00020000); const unsigned uoff = 16u * (unsigned)un;
#if PEER_FUSED
#define U_HROW(S) const u32x4* hr_ = (const u32x4*)(H + (size_t)(tok0 + S < T_TOK ? tok0 + S : T_TOK - 1) * D_MODEL + 32 * un)
#else
#define U_HROW(S) LAS const u32x4* hr_ = (const LAS u32x4*)(wb + 512 + 4096 + S * 2048 + 64 * un)
#endif
#define U_HQ(S) unsigned h0_##S[4], h1_##S[4]; { U_HROW(S); unsigned bb_[8]; \
                _Pragma("unroll") for (int q = 0; q < 4; ++q) { const u32x4 x_ = hr_[q]; unsigned b0_ = 0u, b1_ = 0u; \
                    b0_ = __builtin_amdgcn_cvt_pk_u8_f32(__builtin_rintf(fmaf(bf_lo(x_.x), hs_##S, 136.f)), 0, b0_); b0_ = __builtin_amdgcn_cvt_pk_u8_f32(__builtin_rintf(fmaf(bf_hi(x_.x), hs_##S, 136.f)), 1, b0_); \
                    b0_ = __builtin_amdgcn_cvt_pk_u8_f32(__builtin_rintf(fmaf(bf_lo(x_.y), hs_##S, 136.f)), 2, b0_); b0_ = __builtin_amdgcn_cvt_pk_u8_f32(__builtin_rintf(fmaf(bf_hi(x_.y), hs_##S, 136.f)), 3, b0_); \
                    b1_ = __builtin_amdgcn_cvt_pk_u8_f32(__builtin_rintf(fmaf(bf_lo(x_.z), hs_##S, 136.f)), 0, b1_); b1_ = __builtin_amdgcn_cvt_pk_u8_f32(__builtin_rintf(fmaf(bf_hi(x_.z), hs_##S, 136.f)), 1, b1_); \
                    b1_ = __builtin_amdgcn_cvt_pk_u8_f32(__builtin_rintf(fmaf(bf_lo(x_.w), hs_##S, 136.f)), 2, b1_); b1_ = __builtin_amdgcn_cvt_pk_u8_f32(__builtin_rintf(fmaf(bf_hi(x_.w), hs_##S, 136.f)), 3, b1_); \
                    bb_[2 * q] = b0_ ^ 0x88888888u; bb_[2 * q + 1] = b1_ ^ 0x88888888u; } \
                _Pragma("unroll") for (int d = 0; d < 4; ++d) { h0_##S[d] = (bb_[2 * d] & 0x0f0f0f0fu) | ((bb_[2 * d + 1] & 0x0f0f0f0fu) << 4); h1_##S[d] = ((bb_[2 * d] >> 4) & 0x0f0f0f0fu) | (bb_[2 * d + 1] & 0xf0f0f0f0u); } }
            U_HQ(0); U_HQ(1); U_HQ(2); U_HQ(3);
#define U_LOAD16(X, S, C) do { _Pragma("unroll") for (int i = 0; i < 8; ++i) X##r[i] = __builtin_amdgcn_raw_buffer_load_b128(rsU, (int)(((const LAS u32x2*)(lst + (S) * 1024))[16 * (C) + 2 * i + uh].x * (unsigned)PU_ROWB + uoff), 0, 0); } while (0)
#define U_DOTB(X, S, C, BH) do { float pd_[4]; \
                _Pragma("unroll") for (int k = 0; k < 4; ++k) { const u32x4 w_ = X##r[4 * (BH) + k]; int d1_ = 0, d0_ = 0; \
                    _Pragma("unroll") for (int d = 0; d < 4; ++d) { d1_ = __builtin_amdgcn_sdot8((int)w_[d], (int)h1_##S[d], d1_, false); d0_ = __builtin_amdgcn_sdot8((int)w_[d], (int)h0_##S[d], d0_, false); } \
                    pd_[k] = (float)(16 * d1_ + d0_); } \
                const auto sa_ = __builtin_amdgcn_permlane16_swap(__float_as_uint(pd_[0]), __float_as_uint(pd_[1]), false, false); const float q0_ = __uint_as_float(sa_[0]) + __uint_as_float(sa_[1]); \
                const auto sb_ = __builtin_amdgcn_permlane16_swap(__float_as_uint(pd_[2]), __float_as_uint(pd_[3]), false, false); const float q1_ = __uint_as_float(sb_[0]) + __uint_as_float(sb_[1]); \
                const bool hi8_ = (lane & 8) != 0; const float dsum_ = sum8((hi8_ ? q1_ : q0_) + dpp<DPP_ROR8>(hi8_ ? q0_ : q1_)); \
                const int rr_ = lane >> 4; const int pi_ = 8 * (BH) + 2 * ((rr_ & 1) + (hi8_ ? 2 : 0)) + (rr_ >> 1); \
                LAS u32x2* le_ = (LAS u32x2*)(lst + (S) * 1024) + 16 * (C); \
                const float wvec_ = gelu_erf(dsum_ * c1_##S) * __uint_as_float(le_[pi_].y); \
                LDS_WAIT(); if ((lane & 7) == 0) le_[pi_].y = __float_as_uint(wvec_); } while (0)
#if UBUF4
            u32x4 Cr[8], Dr[8];
            U_LOAD16(A, 0, 0); U_LOAD16(B, 1, 0); U_LOAD16(C, 2, 0);
#pragma unroll 1
            for (int c = 0; c < 7; ++c) {
                U_LOAD16(D, 3, c); U_DOTB(A, 0, c, 0); U_DOTB(A, 0, c, 1); __builtin_amdgcn_sched_barrier(0);
                U_LOAD16(A, 0, c + 1); U_DOTB(B, 1, c, 0); U_DOTB(B, 1, c, 1); __builtin_amdgcn_sched_barrier(0);
                U_LOAD16(B, 1, c + 1); U_DOTB(C, 2, c, 0); U_DOTB(C, 2, c, 1); __builtin_amdgcn_sched_barrier(0);
                U_LOAD16(C, 2, c + 1); U_DOTB(D, 3, c, 0); U_DOTB(D, 3, c, 1); __builtin_amdgcn_sched_barrier(0);
            }
            {
                U_LOAD16(D, 3, 7); U_DOTB(A, 0, 7, 0); U_DOTB(A, 0, 7, 1); __builtin_amdgcn_sched_barrier(0);
                U_DOTB(B, 1, 7, 0); U_DOTB(B, 1, 7, 1); __builtin_amdgcn_sched_barrier(0);
                U_DOTB(C, 2, 7, 0); U_DOTB(C, 2, 7, 1); __builtin_amdgcn_sched_barrier(0);
                U_DOTB(D, 3, 7, 0); U_DOTB(D, 3, 7, 1); __builtin_amdgcn_sched_barrier(0);
            }
#else
            U_LOAD16(A, 0, 0);
#pragma unroll 1
            for (int c = 0; c < 8; ++c) {
                U_LOAD16(B, 1, c); U_DOTB(A, 0, c, 0); U_DOTB(A, 0, c, 1); __builtin_amdgcn_sched_barrier(0);
                U_LOAD16(A, 2, c); U_DOTB(B, 1, c, 0); U_DOTB(B, 1, c, 1); __builtin_amdgcn_sched_barrier(0);
                U_LOAD16(B, 3, c); U_DOTB(A, 2, c, 0); U_DOTB(A, 2, c, 1); __builtin_amdgcn_sched_barrier(0);
                if (c < 7) U_LOAD16(A, 0, c + 1);
                U_DOTB(B, 3, c, 0); U_DOTB(B, 3, c, 1); __builtin_amdgcn_sched_barrier(0);
            }
#endif
#undef U_HQ
#undef U_HROW
#undef U_LOAD16
#undef U_DOTB
#else
        {   u32x4 Ar[8], Br[8];
#define U_LOAD2(X, S0, C) do { _Pragma("unroll") for (int i = 0; i < 8; ++i) { const size_t e_ = (size_t)(unsigned)__builtin_amdgcn_readfirstlane((int)((const LAS u32x2*)(lst + ((S0) + (i >> 2)) * 1024))[4 * (C) + (i & 3)].x); \
                X##r[i] = *(const u32x4*)(PU + e_ * D_MODEL + 16 * lane); } } while (0)
#define U_HX2(S) f32x2 h2_##S[8]; { const u32x4 xa = *(const LAS u32x4*)(hxl + S * 2048), xb = *(const LAS u32x4*)(hxl + S * 2048 + 16); \
                _Pragma("unroll") for (int q = 0; q < 4; ++q) { h2_##S[q] = (f32x2){bf_lo(xa[q]), bf_hi(xa[q])}; h2_##S[4 + q] = (f32x2){bf_lo(xb[q]), bf_hi(xb[q])}; } }
            U_HX2(0); U_HX2(1); U_HX2(2); U_HX2(3);
#define U_LOAD8(X, S, C2) do { _Pragma("unroll") for (int i = 0; i < 8; ++i) { const size_t e_ = (size_t)(unsigned)__builtin_amdgcn_readfirstlane((int)((const LAS u32x2*)(lst + (S) * 1024))[8 * (C2) + i].x); \
                X##r[i] = *(const u32x4*)(PU + e_ * D_MODEL + 16 * lane); } } while (0)
#define U_DOTS8(X, S, C2) do { float pd_[8]; \
                _Pragma("unroll") for (int i = 0; i < 8; ++i) { const u32x4 w_ = X##r[i]; f32x2 d_ = __builtin_amdgcn_cvt_pk_f32_fp8((int)w_[0], false) * h2_##S[0]; \
                    d_ = __builtin_elementwise_fma(__builtin_amdgcn_cvt_pk_f32_fp8((int)w_[0], true), h2_##S[1], d_); \
                    _Pragma("unroll") for (int q = 1; q < 4; ++q) { d_ = __builtin_elementwise_fma(__builtin_amdgcn_cvt_pk_f32_fp8((int)w_[q], false), h2_##S[2 * q], d_); \
                        d_ = __builtin_elementwise_fma(__builtin_amdgcn_cvt_pk_f32_fp8((int)w_[q], true), h2_##S[2 * q + 1], d_); } pd_[i] = d_.x + d_.y; } \
                float r_[4]; _Pragma("unroll") for (int i = 0; i < 4; ++i) { const auto s_ = __builtin_amdgcn_permlane32_swap(__float_as_uint(pd_[2 * i]), __float_as_uint(pd_[2 * i + 1]), false, false); r_[i] = __uint_as_float(s_[0]) + __uint_as_float(s_[1]); } \
                const auto sa_ = __builtin_amdgcn_permlane16_swap(__float_as_uint(r_[0]), __float_as_uint(r_[1]), false, false); const float q0_ = __uint_as_float(sa_[0]) + __uint_as_float(sa_[1]); \
                const auto sb_ = __builtin_amdgcn_permlane16_swap(__float_as_uint(r_[2]), __float_as_uint(r_[3]), false, false); const float q1_ = __uint_as_float(sb_[0]) + __uint_as_float(sb_[1]); \
                const bool hi8_ = (lane & 8) != 0; const float dsum_ = sum8((hi8_ ? q1_ : q0_) + dpp<DPP_ROR8>(hi8_ ? q0_ : q1_)); \
                LAS u32x2* le_ = (LAS u32x2*)(lst + (S) * 1024) + 8 * (C2); \
                const int pi_ = (lane < 16 ? 0 : (lane < 32 ? 2 : (lane < 48 ? 1 : 3))) + (hi8_ ? 4 : 0); \
                const float wvec_ = gelu_erf(dsum_ * c1_##S) * __uint_as_float(le_[pi_].y); \
                LDS_WAIT(); if ((lane & 7) == 0) le_[pi_].y = __float_as_uint(wvec_); } while (0)
            U_LOAD8(A, 0, 0);
#pragma unroll 1
            for (int c = 0; c < 16; ++c) {
                U_LOAD8(B, 1, c); U_DOTS8(A, 0, c); __builtin_amdgcn_sched_barrier(0);
                U_LOAD8(A, 2, c); U_DOTS8(B, 1, c); __builtin_amdgcn_sched_barrier(0);
                U_LOAD8(B, 3, c); U_DOTS8(A, 2, c); __builtin_amdgcn_sched_barrier(0);
                if (c < 15) U_LOAD8(A, 0, c + 1);
                U_DOTS8(B, 3, c); __builtin_amdgcn_sched_barrier(0);
            }
#undef U_LOAD8
#undef U_DOTS8
#if GATHER_PROBE2
            {
                unsigned x_ = 0u; const int pm_ = lane & 31, pg_ = lane >> 5;
#define P2_BATCH(S, BT, KH) do { const unsigned char* rp_ = PU + (size_t)((const LAS u32x2*)(lst + (S) * 1024))[32 * (BT) + pm_].x * D_MODEL + 16 * pg_ + 512 * (KH); u32x4 t_[16]; \
                    _Pragma("unroll") for (int i = 0; i < 16; ++i) t_[i] = *(const u32x4*)(rp_ + 32 * i); \
                    _Pragma("unroll") for (int i = 0; i < 16; ++i) x_ |= (t_[i].x ^ t_[i].y) & (t_[i].z ^ t_[i].w); } while (0)
#pragma unroll 1
                for (int bt = 0; bt < 4; ++bt) { P2_BATCH(0, bt, 0); P2_BATCH(0, bt, 1); P2_BATCH(1, bt, 0); P2_BATCH(1, bt, 1); P2_BATCH(2, bt, 0); P2_BATCH(2, bt, 1); P2_BATCH(3, bt, 0); P2_BATCH(3, bt, 1); }
                asm volatile("" :: "v"(x_));
#undef P2_BATCH
            }
#endif
#undef U_LOAD2
#undef U_HX2
#endif
            LDS_WAIT();
#if GATHER_VMMA == 2
            f32x16 vc0, vc1, vc2, vc3;
#pragma unroll
            for (int t = 0; t < 16; ++t) { vc0[t] = 0.f; vc1[t] = 0.f; vc2[t] = 0.f; vc3[t] = 0.f; }
            const int vn = lane & 31, vg = lane >> 5;
            const unsigned char* PVl = PV + 16 * vn; const unsigned char* PVh = PV + 512 + 8 * vn; (void)PVl; (void)PVh;
            const auto rsV = __builtin_amdgcn_make_buffer_rsrc((void*)PV, 0, N_EXPERTS * PV_ROWB, 0x00020000); const unsigned voff1 = 16u * (unsigned)vn, voff2 = 512u + 8u * (unsigned)vn;
            const int vsel = vn >> 2, vsh = 8 * (vn & 3); const int d6 = (6 * vn) >> 5, sh6 = (6 * vn) & 31;
#if V6_DIAG_FP8
#define V6_BOP(X, S) const u32x4 d_ = X##r[i], d2_ = X##r2[i]; const i32x8g b_ = {(int)d_.x, (int)d_.y, (int)d_.z, (int)d_.w, (int)d2_.x, (int)d2_.y, (int)d2_.z, (int)d2_.w}; \
                vc##S = __builtin_amdgcn_mfma_scale_f32_32x32x64_f8f6f4(a_, b_, vc##S, 0, 0, 0, 0, 0, 0)
#else
#define V6_BOP(X, S) const u32x4 d_ = X##r[i]; const u32x2 e2_ = X##q[i]; const i32x8g b_ = {(int)d_.x, (int)d_.y, (int)d_.z, (int)d_.w, (int)e2_.x, (int)e2_.y, 0, 0}; \
                vc##S = __builtin_amdgcn_mfma_scale_f32_32x32x64_f8f6f4(a_, b_, vc##S, 0, 2, 0, 0x7f7f7f7f, 0, 0x7f7f7f7f)
#endif
            { u32x4 Ar[VSET], Br[VSET]; u32x2 Aq[VSET], Bq[VSET]; u32x4 Ar2[V6_DIAG_FP8 ? VSET : 1], Br2[V6_DIAG_FP8 ? VSET : 1];
#if VBUF4
              u32x4 Cr[VSET], Dr[VSET]; u32x2 Cq[VSET], Dq[VSET];
#endif
#if V6_DIAG_FP8
#define V_LOAD6(X, S, C) do { _Pragma("unroll") for (int i = 0; i < VSET; ++i) { const size_t ro_ = (size_t)((const LAS u32x2*)(lst + (S) * 1024))[2 * VSET * (C) + 2 * i + vg].x * 1024; \
                X##r[i] = *(const u32x4*)(PV + 32 * vn + ro_); X##r2[i] = *(const u32x4*)(PV + 32 * vn + 16 + ro_); } } while (0)
#else
#define V_LOAD6(X, S, C) do { _Pragma("unroll") for (int i = 0; i < VSET; ++i) { const unsigned ro_ = ((const LAS u32x2*)(lst + (S) * 1024))[2 * VSET * (C) + 2 * i + vg].x * (unsigned)PV_ROWB; \
                X##r[i] = __builtin_amdgcn_raw_buffer_load_b128(rsV, (int)(ro_ + voff1), 0, 0); X##q[i] = __builtin_amdgcn_raw_buffer_load_b64(rsV, (int)(ro_ + voff2), 0, 0); } } while (0)
#endif
#if V6_DIAG_FP8
#define V_MMA6(X, S, C) do { _Pragma("unroll") for (int i = 0; i < VSET; ++i) { const float w64_ = fminf(__uint_as_float(((const LAS u32x2*)(lst + (S) * 1024))[2 * VSET * (C) + 2 * i + vg].y) * (64.f * PV_SCALE), 440.f); \
                const unsigned sh_ = (unsigned)(__builtin_amdgcn_cvt_pk_fp8_f32(w64_, 0.f, 0, false) & 0xff) << vsh; \
                const i32x8g a_ = {(int)(vsel == 0 ? sh_ : 0u), (int)(vsel == 1 ? sh_ : 0u), (int)(vsel == 2 ? sh_ : 0u), (int)(vsel == 3 ? sh_ : 0u), (int)(vsel == 4 ? sh_ : 0u), (int)(vsel == 5 ? sh_ : 0u), (int)(vsel == 6 ? sh_ : 0u), (int)(vsel == 7 ? sh_ : 0u)}; \
                V6_BOP(X, S); } } while (0)
#else
#define V_MMA6(X, S, C) do { _Pragma("unroll") for (int i = 0; i < VSET; ++i) { const unsigned t_ = ((const LAS u32x2*)(lst + (S) * 1024))[2 * VSET * (C) + 2 * i + vg].y + 0x00080000u; \
                const unsigned code_ = ((t_ >> 26) & 0x20u) | 0x8u | ((t_ >> 20) & 7u); const int sc_ = (int)((t_ >> 23) & 0xffu); \
                const unsigned long long v_ = (unsigned long long)code_ << sh6; const unsigned lo_ = (unsigned)v_, hi_ = (unsigned)(v_ >> 32); \
                const i32x8g a_ = {(int)(d6 == 0 ? lo_ : 0u), (int)((d6 == 1 ? lo_ : 0u) | (d6 == 0 ? hi_ : 0u)), (int)((d6 == 2 ? lo_ : 0u) | (d6 == 1 ? hi_ : 0u)), (int)((d6 == 3 ? lo_ : 0u) | (d6 == 2 ? hi_ : 0u)), \
                                   (int)((d6 == 4 ? lo_ : 0u) | (d6 == 3 ? hi_ : 0u)), (int)((d6 == 5 ? lo_ : 0u) | (d6 == 4 ? hi_ : 0u)), 0, 0}; \
                const u32x4 d_ = X##r[i]; const u32x2 e2_ = X##q[i]; const i32x8g b_ = {(int)d_.x, (int)d_.y, (int)d_.z, (int)d_.w, (int)e2_.x, (int)e2_.y, 0, 0}; \
                vc##S = __builtin_amdgcn_mfma_scale_f32_32x32x64_f8f6f4(a_, b_, vc##S, 2, 2, 0, sc_, 0, 0x7f); } } while (0)
#endif
#if VBUF4
            V_LOAD6(A, 0, 0); V_LOAD6(B, 1, 0); V_LOAD6(C, 2, 0);
#pragma unroll 1
            for (int c = 0; c < 64 / VSET; ++c) { const int cn = c + 1 < 64 / VSET ? c + 1 : c;
                V_LOAD6(D, 3, c); V_MMA6(A, 0, c); __builtin_amdgcn_sched_barrier(0);
                V_LOAD6(A, 0, cn); V_MMA6(B, 1, c); __builtin_amdgcn_sched_barrier(0);
                V_LOAD6(B, 1, cn); V_MMA6(C, 2, c); __builtin_amdgcn_sched_barrier(0);
                V_LOAD6(C, 2, cn); V_MMA6(D, 3, c); __builtin_amdgcn_sched_barrier(0);
            }
#else
            V_LOAD6(A, 0, 0);
#pragma unroll 1
            for (int c = 0; c < 64 / VSET; ++c) {
                V_LOAD6(B, 1, c); V_MMA6(A, 0, c); __builtin_amdgcn_sched_barrier(0);
                V_LOAD6(A, 2, c); V_MMA6(B, 1, c); __builtin_amdgcn_sched_barrier(0);
                V_LOAD6(B, 3, c); V_MMA6(A, 2, c); __builtin_amdgcn_sched_barrier(0);
                if (c < 64 / VSET - 1) V_LOAD6(A, 0, c + 1);
                V_MMA6(B, 3, c); __builtin_amdgcn_sched_barrier(0);
            }
#endif
#undef V_LOAD6
#undef V_MMA6
#undef V6_BOP
            }
#if PEER_FUSED
#define V6_HB(S, Q) (*(const u32x2*)(H + (size_t)(tok0 + S < T_TOK ? tok0 + S : T_TOK - 1) * D_MODEL + cb_ + 8 * (Q)))
#else
#define V6_HB(S, Q) (*(const LAS u32x2*)(wb + 512 + 4096 + S * 2048 + 2 * (cb_ + 8 * (Q))))
#endif
#define V_FIN6(S) do { const int cb_ = 32 * vn + 4 * vg; float s3_ = 0.f; f32x4 h3_[4]; \
                _Pragma("unroll") for (int q = 0; q < 4; ++q) { const u32x2 hb_ = V6_HB(S, q); \
                    const f32x4 a_ = {vc##S[4 * q], vc##S[4 * q + 1], vc##S[4 * q + 2], vc##S[4 * q + 3]}; \
                    h3_[q] = (f32x4){bf_lo(hb_.x), bf_hi(hb_.x), bf_lo(hb_.y), bf_hi(hb_.y)} + a_ * (amp * (V6_DIAG_FP8 ? 1.f / (64.f * PV_SCALE) : 1.f)); \
                    s3_ += h3_[q][0] * h3_[q][0] + h3_[q][1] * h3_[q][1] + h3_[q][2] * h3_[q][2] + h3_[q][3] * h3_[q][3]; } \
                const float r3_ = 1.f / sqrtf(wave_sum(s3_) * (1.f / D_MODEL) + RMS_EPS); \
                if (tok0 + S < T_TOK) { _Pragma("unroll") for (int q = 0; q < 4; ++q) { const f32x4 gq_ = *(const f32x4*)(p.in[29] + cb_ + 8 * q); \
                    *(f32x4*)(p.out + (size_t)(tok0 + S) * D_MODEL + cb_ + 8 * q) = h3_[q] * r3_ * gq_; } } } while (0)
            V_FIN6(0); V_FIN6(1); V_FIN6(2); V_FIN6(3);
#undef V_FIN6
#undef V6_HB
        }
#elif GATHER_VMMA
            f32x4 vc0[8], vc1[8], vc2[8], vc3[8];
#pragma unroll
            for (int t = 0; t < 8; ++t) { vc0[t] = (f32x4){0.f, 0.f, 0.f, 0.f}; vc1[t] = vc0[t]; vc2[t] = vc0[t]; vc3[t] = vc0[t]; }
            const int vn = lane & 15, vg = lane >> 4;
            const unsigned char* PVl = PV + 16 * vn;
            { u32x4 Ar[8], Br[8]; unsigned Aw[2], Bw[2];
#define V_LOAD4(X, O, S, C) do { const u32x2 ew_ = ((const LAS u32x2*)(lst + (S) * 1024))[4 * (C) + vg]; X##w[(O) >> 2] = ew_.y; const unsigned char* rp_ = PVl + (size_t)ew_.x * D_MODEL; \
                _Pragma("unroll") for (int s2 = 0; s2 < 4; ++s2) X##r[(O) + s2] = *(const u32x4*)(rp_ + 256 * s2); } while (0)
#define V_MMA(X, O, S) do { const float w64_ = fminf(__uint_as_float(X##w[(O) >> 2]) * 4096.f, 440.f); \
                const int hi8_ = __builtin_amdgcn_cvt_pk_fp8_f32(w64_, 0.f, 0, false); const float hif_ = __builtin_amdgcn_cvt_pk_f32_fp8(hi8_, false)[0]; \
                const int lo8_ = __builtin_amdgcn_cvt_pk_fp8_f32((w64_ - hif_) * 16.f, 0.f, 0, false); \
                const unsigned sh_ = (unsigned)((vn < 8 ? hi8_ : lo8_) & 0xff) << (8 * (vn & 3)); \
                const long a_ = (long)(((unsigned long long)((vn & 4) ? sh_ : 0u) << 32) | (unsigned long long)((vn & 4) ? 0u : sh_)); \
                _Pragma("unroll") for (int s2 = 0; s2 < 4; ++s2) { const u32x4 d_ = X##r[(O) + s2]; \
                    vc##S[2 * s2] = __builtin_amdgcn_mfma_f32_16x16x32_fp8_fp8(a_, (long)(((unsigned long long)d_.y << 32) | d_.x), vc##S[2 * s2], 0, 0, 0); \
                    vc##S[2 * s2 + 1] = __builtin_amdgcn_mfma_f32_16x16x32_fp8_fp8(a_, (long)(((unsigned long long)d_.w << 32) | d_.z), vc##S[2 * s2 + 1], 0, 0, 0); } } while (0)
            V_LOAD4(A, 0, 0, 0); V_LOAD4(A, 4, 1, 0);
#pragma unroll 1
            for (int c = 0; c < 32; ++c) {
                V_LOAD4(B, 0, 2, c); V_LOAD4(B, 4, 3, c); V_MMA(A, 0, 0); V_MMA(A, 4, 1); __builtin_amdgcn_sched_barrier(0);
                if (c < 31) { V_LOAD4(A, 0, 0, c + 1); V_LOAD4(A, 4, 1, c + 1); }
                V_MMA(B, 0, 2); V_MMA(B, 4, 3); __builtin_amdgcn_sched_barrier(0);
            }
#undef V_LOAD4
#undef V_MMA
            }
#define V_FIN(S) do { const float sc_ = vg < 2 ? (1.f / 4096.f) : (1.f / 65536.f); const int cb_ = 16 * vn + 8 * (vg >> 1) + 4 * (vg & 1); float s3_ = 0.f; f32x4 h3_[4]; \
                _Pragma("unroll") for (int s2 = 0; s2 < 4; ++s2) { f32x4 a_; \
                    _Pragma("unroll") for (int r = 0; r < 4; ++r) { const float x0_ = vc##S[2 * s2][r] * sc_, x1_ = vc##S[2 * s2 + 1][r] * sc_; \
                        const auto p0_ = __builtin_amdgcn_permlane32_swap(__float_as_uint(x0_), __float_as_uint(x0_), false, false); const auto p1_ = __builtin_amdgcn_permlane32_swap(__float_as_uint(x1_), __float_as_uint(x1_), false, false); \
                        const float y0_ = __uint_as_float(p0_[0]) + __uint_as_float(p0_[1]), y1_ = __uint_as_float(p1_[0]) + __uint_as_float(p1_[1]); a_[r] = (vg >> 1) ? y1_ : y0_; } \
                    const u32x2 hb_ = *(const LAS u32x2*)(wb + 512 + 4096 + S * 2048 + 2 * (256 * s2 + cb_)); \
                    h3_[s2] = (f32x4){bf_lo(hb_.x), bf_hi(hb_.x), bf_lo(hb_.y), bf_hi(hb_.y)} + a_ * amp; \
                    s3_ += h3_[s2][0] * h3_[s2][0] + h3_[s2][1] * h3_[s2][1] + h3_[s2][2] * h3_[s2][2] + h3_[s2][3] * h3_[s2][3]; } \
                const float r3_ = 1.f / sqrtf(wave_sum(s3_) * (1.f / D_MODEL) + RMS_EPS); \
                if (tok0 + S < T_TOK) { _Pragma("unroll") for (int s2 = 0; s2 < 4; ++s2) { const f32x4 gq_ = *(const f32x4*)(p.in[29] + 256 * s2 + cb_); \
                    *(f32x4*)(p.out + (size_t)(tok0 + S) * D_MODEL + 256 * s2 + cb_) = h3_[s2] * r3_ * gq_; } } } while (0)
            V_FIN(0); V_FIN(1); V_FIN(2); V_FIN(3);
#undef V_FIN
        }
#else
#pragma unroll
            for (int j = 0; j < 16; ++j) { ac0[j] = 0.f; ac1[j] = 0.f; ac2[j] = 0.f; ac3[j] = 0.f; }
#define V_LOAD2(X, S0, C) do { _Pragma("unroll") for (int i = 0; i < 8; ++i) { const size_t e_ = (size_t)(unsigned)__builtin_amdgcn_readfirstlane((int)((const LAS u32x2*)(lst + ((S0) + (i >> 2)) * 1024))[4 * (C) + (i & 3)].x); \
                X##r[i] = *(const u32x4*)(PV + e_ * D_MODEL + 16 * lane); } } while (0)
#define V_ACC(X, O, S, C) do { LAS const u32x2* le_ = (const LAS u32x2*)(lst + S * 1024) + 4 * (C); \
                _Pragma("unroll") for (int i = 0; i < 4; ++i) { const float w_ = __builtin_bit_cast(float, __builtin_amdgcn_readfirstlane((int)le_[i].y)); float vf[16]; unpack_fp8x16(X##r[(O) + i], vf); \
                    _Pragma("unroll") for (int j = 0; j < 16; ++j) ac##S[j] = fmaf(w_, vf[j], ac##S[j]); } } while (0)
            V_LOAD2(A, 0, 0);
#pragma unroll 1
            for (int c = 0; c < 32; ++c) {
                V_LOAD2(B, 2, c); V_ACC(A, 0, 0, c); V_ACC(A, 4, 1, c); __builtin_amdgcn_sched_barrier(0);
                if (c < 31) V_LOAD2(A, 0, c + 1);
                V_ACC(B, 0, 2, c); V_ACC(B, 4, 3, c); __builtin_amdgcn_sched_barrier(0);
            }
#undef V_LOAD2
#undef V_ACC
        }
        GS_FIN(0); GS_FIN(1); GS_FIN(2); GS_FIN(3);
#endif
#elif GNT == 4
        GS_DECL(0); GS_DECL(1); GS_DECL(2); GS_DECL(3); GS_SETUP(0); GS_SETUP(1); GS_SETUP(2); GS_SETUP(3);
        G_LOAD(A, 0, 0);
#pragma unroll 1
        for (int c = 0; c < 32; ++c) {
            G_LOAD(B, 1, c); G_PROC(A, 0, c); __builtin_amdgcn_sched_barrier(0);
            G_LOAD(A, 2, c); G_PROC(B, 1, c); __builtin_amdgcn_sched_barrier(0);
            G_LOAD(B, 3, c); G_PROC(A, 2, c); __builtin_amdgcn_sched_barrier(0);
            if (c < 31) G_LOAD(A, 0, c + 1);
            G_PROC(B, 3, c); __builtin_amdgcn_sched_barrier(0);
        }
        GS_FIN(0); GS_FIN(1); GS_FIN(2); GS_FIN(3);
#else
        GS_DECL(0); GS_SETUP(0);
        G_LOAD(A, 0, 0);
#pragma unroll 1
        for (int c = 0; c < 32; c += 2) {
            G_LOAD(B, 0, c + 1); G_PROC(A, 0, c);
            if (c < 30) G_LOAD(A, 0, c + 2);
            G_PROC(B, 0, c + 1);
        }
        GS_FIN(0);
#endif
#undef GS_DECL
#undef GS_AMAX
#undef GS_KEEP
#undef GS_HX
#undef GS_SETUP
#undef GS_FIN
#undef G_LOAD
#undef G_PROC
    }
}
#define XB_TMO      128
#define XB_XCNT(j)  (256  + 64 * (j))
#define XB_XSUB(j)  (1280 + 64 * (j))
#define XB_XGEN(j)  (2304 + 64 * (j))
#define XB_TOP      3328
#define XB_TOPGEN   3392
#define XCD_BAR_WORDS 3456
#define XB_SPIN_CAP (1u << 18)

__device__ __forceinline__ unsigned xb_ld(unsigned* p)              { return __hip_atomic_load(p, __ATOMIC_RELAXED, __HIP_MEMORY_SCOPE_AGENT); }
__device__ __forceinline__ unsigned xb_add(unsigned* p, unsigned v) { return __hip_atomic_fetch_add(p, v, __ATOMIC_RELAXED, __HIP_MEMORY_SCOPE_AGENT); }
__device__ __forceinline__ unsigned xb_xcc_id() { return (unsigned)__builtin_amdgcn_s_getreg((3 << 11) | 20) & 0xFu; }
#define XB_SPIN(cond, bar) do { unsigned _sp = 0; while (cond) { __builtin_amdgcn_s_sleep(1); \
    if ((++_sp & 255u) == 0u) { if (xb_ld(&(bar)[XB_TMO])) break; if (_sp > XB_SPIN_CAP) { atomicAdd(&(bar)[XB_TMO], 1u); break; } } } } while (0)

struct XcdBarrier {
    unsigned* bar; unsigned x;
    volatile LAS unsigned* st;
};

__device__ __forceinline__ XcdBarrier xcd_barrier_post(unsigned* bar, volatile LAS unsigned* st) {
    XcdBarrier b; b.bar = bar; b.x = xb_xcc_id(); b.st = st;
    if (threadIdx.x == 0) (void)xb_add(&bar[XB_XCNT(b.x)], 1u);
    return b;
}
__device__ __forceinline__ void xcd_barrier_complete(unsigned* bar, unsigned x, unsigned& nloc, unsigned& nx) {
    const unsigned G = gridDim.x * gridDim.y * gridDim.z;
    unsigned sum, cnt, mine, sp = 0u;
    for (;;) {
        sum = 0u; cnt = 0u; mine = 0u;
#pragma unroll
        for (unsigned j = 0; j < 16; ++j) { const unsigned c = xb_ld(&bar[XB_XCNT(j)]); sum += c; cnt += (c > 0u) ? 1u : 0u; mine = (j == x) ? c : mine; }
        if (sum == G) break;
        __builtin_amdgcn_s_sleep(1);
        if ((++sp & 255u) == 0u) { if (xb_ld(&bar[XB_TMO])) break; if (sp > XB_SPIN_CAP) { atomicAdd(&bar[XB_TMO], 1u); break; } }
    }
    nloc = mine > 0u ? mine : 1u; nx = cnt > 0u ? cnt : 1u;
}

__device__ __forceinline__ void xcd_barrier(const XcdBarrier& b) {
    asm volatile("s_waitcnt vmcnt(0)" ::: "memory");
    __syncthreads();
    if (threadIdx.x == 0) {
        unsigned* bar = b.bar;
        __builtin_amdgcn_s_waitcnt(0);
        unsigned nloc = b.st[0], nx = b.st[1];
        if (nloc == 0u) { xcd_barrier_complete(bar, b.x, nloc, nx); b.st[0] = nloc; b.st[1] = nx; }
        const unsigned old = xb_add(&bar[XB_XSUB(b.x)], 1u);
        const unsigned gen = old / nloc;
        if (old + 1u == (gen + 1u) * nloc) {
            __builtin_amdgcn_fence(__ATOMIC_RELEASE, "agent");
            asm volatile("s_waitcnt vmcnt(0)" ::: "memory");
            const unsigned og = xb_add(&bar[XB_TOP], 1u);
            const unsigned tg = og / nx;
            if (og + 1u == (tg + 1u) * nx) xb_add(&bar[XB_TOPGEN], 1u);
            else XB_SPIN(xb_ld(&bar[XB_TOPGEN]) == tg, bar);
            __builtin_amdgcn_fence(__ATOMIC_ACQUIRE, "agent");
            xb_add(&bar[XB_XGEN(b.x)], 1u);
            asm volatile("s_waitcnt vmcnt(0)" ::: "memory");
        } else {
            XB_SPIN(xb_ld(&bar[XB_XGEN(b.x)]) == gen, bar);
            __builtin_amdgcn_fence(__ATOMIC_ACQUIRE, "agent");
            asm volatile("s_waitcnt vmcnt(0)" ::: "memory");
        }
    }
    __syncthreads();
}
template <> __device__ __forceinline__ void bar_sync<XcdBarrier>(const XcdBarrier& b) { xcd_barrier(b); }
#ifndef STAGE_MIX
#define STAGE_MIX 0
#endif
#ifndef STAGE_CROSS
#define STAGE_CROSS 1
#endif
#ifndef USE_A
#define USE_A 1
#endif
#ifndef USE_B
#define USE_B 1
#endif
#ifndef AMP_MIX
#define AMP_MIX 1.f
#endif
#ifndef DUP_EMASK
#define DUP_EMASK 0xffffffffu
#endif
#ifndef GATHER_SYNC
#define GATHER_SYNC 0
#endif
#ifndef DUP_PHASE
#define DUP_PHASE 0
#endif
#ifndef AMP_PEER
#define AMP_PEER 1.f
#endif
#ifndef AMP_CROSS
#define AMP_CROSS 1.f
#endif
#ifndef STAGE_PEER
#define STAGE_PEER 0
#endif
__device__ __forceinline__ void h_from_x(const Params& p, int wave, int lane) {
    const int gw = blockIdx.x * NWAVES + wave, NGW = gridDim.x * NWAVES;
    for (int m = gw; m < T_TOK; m += NGW) {
        const f32x4* xr = (const f32x4*)(p.in[0] + (size_t)m * D_MODEL) + lane; u32x2* o8 = (u32x2*)((bf16_t*)(p.ws + WS_H) + (size_t)m * D_MODEL) + lane; float s = 0.f;
#pragma unroll
        for (int j = 0; j < 4; ++j) { const f32x4 v = xr[64 * j]; s += (v.x * v.x + v.y * v.y) + (v.z * v.z + v.w * v.w); u32x2 w; w.x = pk_bf16(v.x, v.y); w.y = pk_bf16(v.z, v.w); o8[64 * j] = w; }
        s = wave_sum(s);
        if (lane < 16) ((float*)(p.ws + WS_SSQ1))[(size_t)m * 16 + lane] = lane == 0 ? s : 0.f;
    }
}
__global__ void __launch_bounds__(NTHREADS, 2) fwd_megakernel(Params p) {
    extern __shared__ __attribute__((aligned(16))) unsigned char lds_raw[];
    LAS unsigned char* lds = (LAS unsigned char*)lds_raw;
    cg::grid_group grid = cg::this_grid();
    const int wave = __builtin_amdgcn_readfirstlane((int)threadIdx.x >> 6);
#define FRESH_TID() int tid = threadIdx.x; asm volatile("" : "+v"(tid)); const int lane = tid & 63
    unsigned char* ws = p.ws;
    const int G = gridDim.x, bx = blockIdx.x;
    volatile LAS unsigned* bst = (volatile LAS unsigned*)(lds + LDS_BYTES - 16);
    if (threadIdx.x < 4) bst[threadIdx.x] = 0u;
    __syncthreads();
    const XcdBarrier bar = xcd_barrier_post((unsigned*)(ws + WS_CTL), bst);
#define GRID_BAR() xcd_barrier(bar)
    { FRESH_TID(); p0_prologue(p, lds, wave, lane); }
#if DUP_PHASE == 5
    { FRESH_TID(); __syncthreads(); p0_prologue(p, lds, wave, lane); }
#endif
    grid.sync();
#if STAGE_MIX
    {
        pg8::Gemm g{(const bf16_t*)(ws + WS_XN), (const bf16_t*)(ws + WS_WINA), T_TOK, N_PROJA, 1024}; pg8::StaticOrder S; S.init(T_TOK, N_PROJA, G, bx);
#if DUP_PHASE == 8
        { pg8::EpiProj E0{(bf16_t*)(ws + WS_Q), (bf16_t*)(ws + WS_K), (bf16_t*)(ws + WS_V), (bf16_t*)(ws + WS_RW), (const bf16_t*)(ws + WS_ROPE_C), 0.125f * LOG2E, 1};
          pg8::gemm_phase<pg8::EpiProj, pg8::StaticOrder, true, true>(lds, g, S, E0); }
#endif
        pg8::EpiProj E{(bf16_t*)(ws + WS_Q), (bf16_t*)(ws + WS_K), (bf16_t*)(ws + WS_V), (bf16_t*)(ws + WS_RW), (const bf16_t*)(ws + WS_ROPE_C), 0.125f * LOG2E, 0};
        pg8::gemm_phase<pg8::EpiProj, pg8::StaticOrder, true, true>(lds, g, S, E);
#if DUP_PHASE == 4
        pg8::gemm_phase<pg8::EpiProj, pg8::StaticOrder, true, true>(lds, g, S, E);
#endif
    }
    GRID_BAR();
#if USE_B
    { FRESH_TID(); rwkv_act_phase(p, wave, lane); }
#endif
#if USE_A
    { FRESH_TID(); swa_phase(p, lds, tid, wave, lane); }
#endif
#if USE_B
    GRID_BAR();
    { FRESH_TID(); rwkv_phase(p, lds, tid, wave, lane); }
#if DUP_PHASE == 3
    { FRESH_TID(); rwkv_phase(p, lds, tid, wave, lane); }
#endif
#endif
    GRID_BAR();
    {
#if GATE_FP8
        pg8::Gemm g{(const bf16_t*)p.out, (const bf16_t*)(ws + WS_WING), T_TOK, 2048, 512}; pg8::StaticOrder S; S.init(T_TOK, 2048, G, bx);
        pg8::EpiGate E{(bf16_t*)(ws + WS_Q), (const bf16_t*)(ws + WS_Y), USE_A, USE_B, -LOG2E / GATE_WSCALE};
        pg8::gemm_phase<pg8::EpiGate, pg8::StaticOrder, true, true, true>(lds, g, S, E);
#else
        pg8::Gemm g{(const bf16_t*)(ws + WS_XN), (const bf16_t*)(ws + WS_WING), T_TOK, 2048, 1024}; pg8::StaticOrder S; S.init(T_TOK, 2048, G, bx);
        pg8::EpiGate E{(bf16_t*)(ws + WS_Q), (const bf16_t*)(ws + WS_Y), USE_A, USE_B, -LOG2E};
        pg8::gemm_phase<pg8::EpiGate, pg8::StaticOrder, true, true>(lds, g, S, E);
#endif
    }
    GRID_BAR();
    {
        pg8::Gemm g{(const bf16_t*)(ws + WS_Q), (const bf16_t*)(ws + WS_WOUT), T_TOK, 1024, 1024}; pg8::StaticOrder S; S.init(T_TOK, 1024, G, bx);
        pg8::EpiRes<true> E{p.in[0], (bf16_t*)(ws + WS_H), (float*)(ws + WS_SSQ1), AMP_MIX};
        pg8::gemm_phase<pg8::EpiRes<true>, pg8::StaticOrder, true, true>(lds, g, S, E);
    }
    GRID_BAR();
#else
    { FRESH_TID(); h_from_x(p, wave, lane); }
#endif
#if STAGE_CROSS
    {
        pg8::Gemm g{(const bf16_t*)(ws + WS_H), (const bf16_t*)(ws + WS_WQC), T_TOK, 512, 1024}; pg8::StaticOrder S; S.init(T_TOK, 512, G, bx);
        pg8::EpiScaled E{(bf16_t*)(ws + WS_QC), 512, (const float*)(ws + WS_SSQ1), 0.08838834764831845f * LOG2E};
        pg8::gemm_phase<pg8::EpiScaled, pg8::StaticOrder, true, true>(lds, g, S, E);
    }
    {
        pg8::Gemm g{(const bf16_t*)(ws + WS_MEMN), (const bf16_t*)(ws + WS_WKVC), MEM_ROWS, 1024, 1024}; pg8::StaticOrder S; S.init(MEM_ROWS, 1024, G, (bx + G / 2) % G);
        pg8::EpiPlain E{(bf16_t*)(ws + WS_KVC), 1024};
        pg8::gemm_phase<pg8::EpiPlain, pg8::StaticOrder, true, true>(lds, g, S, E);
    }
    GRID_BAR();
    { FRESH_TID(); cross_phase(p, lds, tid, wave, lane); }
    GRID_BAR();
    {
#if CROSS_FP8
        pg8::Gemm g{(const bf16_t*)(ws + WS_QC8), (const bf16_t*)(ws + WS_WOC), T_TOK, 1024, 256}; pg8::StaticOrder S; S.init(T_TOK, 1024, G, bx);
        pg8::EpiRes<false> E{nullptr, (bf16_t*)(ws + WS_H), (float*)(ws + WS_SSQ2), AMP_CROSS / (CROSS_OSCALE * CROSS_WSCALE)};
        pg8::gemm_phase<pg8::EpiRes<false>, pg8::StaticOrder, true, true, true>(lds, g, S, E);
#else
        pg8::Gemm g{(const bf16_t*)(ws + WS_QC), (const bf16_t*)(ws + WS_WOC), T_TOK, 1024, 512}; pg8::StaticOrder S; S.init(T_TOK, 1024, G, bx);
        pg8::EpiRes<false> E{nullptr, (bf16_t*)(ws + WS_H), (float*)(ws + WS_SSQ2), AMP_CROSS};
        pg8::gemm_phase<pg8::EpiRes<false>, pg8::StaticOrder, true, true>(lds, g, S, E);
#endif
    }
    GRID_BAR();
#endif
#if STAGE_PEER
    {
        pg8::Gemm g{(const bf16_t*)(ws + WS_H), (const bf16_t*)(ws + WS_WPQ), T_TOK, 2048, 1024}; pg8::StaticOrder S; S.init(T_TOK, 2048, G, bx);
        pg8::EpiScaled E{(bf16_t*)(ws + WS_PQ), 2048, (const float*)(ws + (STAGE_CROSS ? WS_SSQ2 : WS_SSQ1)), 1.f};
        pg8::gemm_phase<pg8::EpiScaled, pg8::StaticOrder, true, true>(lds, g, S, E);
#if DUP_PHASE == 6
        pg8::gemm_phase<pg8::EpiScaled, pg8::StaticOrder, true, true>(lds, g, S, E);
#endif
    }
    GRID_BAR();
#if !PEER_FUSED
    { FRESH_TID(); peer_route_phase(p, lds, tid, wave, lane); }
#if DUP_PHASE == 2
    { FRESH_TID(); peer_route_phase(p, lds, tid, wave, lane); }
#endif
    GRID_BAR();
#endif
    { FRESH_TID(); peer_gather_phase(p, lds, wave, lane, AMP_PEER, bar); }
#if DUP_PHASE == 1
    { FRESH_TID(); peer_gather_phase(p, lds, wave, lane, AMP_PEER, bar); }
#endif
#else
    { FRESH_TID(); final_norm_rows((const bf16_t*)(ws + WS_H), p.in[29], p.out, wave, lane); }
#endif
}

extern "C" void kernel_launch(void* const* d_in, const int* in_sizes, int n_in, void* d_out, int out_size, void* d_ws, size_t ws_size, hipStream_t stream) {
    static int grid_blocks = 0;
    if (grid_blocks == 0) {
        if (n_in != 30 || in_sizes[0] != T_TOK * D_MODEL || out_size != T_TOK * D_MODEL || ws_size < WS_END) {
            fprintf(stderr, "kernel_launch: unexpected shapes: n_in %d in0 %d out %d ws %zu (need %zu)\n", n_in, n_in > 0 ? in_sizes[0] : -1, out_size, ws_size, (size_t)WS_END); grid_blocks = -1; return; }
        int dev = 0, cus = 0, per_cu = 0;
        (void)hipGetDevice(&dev);
        (void)hipDeviceGetAttribute(&cus, hipDeviceAttributeMultiprocessorCount, dev);
        (void)hipFuncSetAttribute((const void*)fwd_megakernel, hipFuncAttributeMaxDynamicSharedMemorySize, LDS_BYTES);
        (void)hipOccupancyMaxActiveBlocksPerMultiprocessor(&per_cu, (const void*)fwd_megakernel, NTHREADS, LDS_BYTES);
        if (per_cu < 1) { fprintf(stderr, "kernel_launch: occupancy query says %d blocks per CU\n", per_cu); per_cu = 1; }
        if (per_cu > 1) per_cu = 1;
        grid_blocks = cus * per_cu;
    }
    if (grid_blocks < 0) return;
    (void)hipMemsetAsync((char*)d_ws + WS_CTL, 0, 65536, stream);
    Params p{};
    for (int i = 0; i < 30; ++i) p.in[i] = (const float*)d_in[i];
    p.out = (float*)d_out; p.ws = (unsigned char*)d_ws;
    void* args[] = {&p};
    hipError_t e = hipLaunchCooperativeKernel((const void*)fwd_megakernel, dim3(grid_blocks), dim3(NTHREADS), args, LDS_BYTES, stream);
    if (e != hipSuccess) fprintf(stderr, "cooperative launch failed: %s (grid %d)\n", hipGetErrorString(e), grid_blocks);
}
```

```cpp
#include <hip/hip_runtime.h>
#include <hip/hip_cooperative_groups.h>
#include <cstdio>
#include <cstdint>
namespace cg = cooperative_groups;

constexpr int D_MODEL = 1024, BATCH = 32, SEQ = 2048, T_TOK = BATCH * SEQ;
constexpr int IN_WIDTH = 6912, N_PROJA = 4864, RW_W = 3328;
constexpr int MEM_LEN = 256, MEM_ROWS = BATCH * MEM_LEN;
constexpr int N_EXPERTS = 16384;
constexpr float RMS_EPS = 1e-5f, LOG2E = 1.4426950408889634f;
constexpr int NTHREADS = 512, NWAVES = 8;
constexpr int LDS_BYTES = 160 * 1024;

constexpr size_t MiB = 1u << 20;
constexpr size_t WS_CTL = 0;
constexpr size_t WS_ROPE_C = 1 * MiB, WS_ROPE_S = 3 * MiB;
constexpr size_t WS_W2T = 5 * MiB, WS_A2T = WS_W2T + 131072, WS_G2T = WS_A2T + 131072;
constexpr size_t WS_PK1 = 6 * MiB, WS_PK2 = WS_PK1 + 32768;
constexpr size_t WS_WINA = 8 * MiB;
constexpr size_t WS_WING = 18 * MiB;
constexpr size_t WS_WOUT = 22 * MiB;
constexpr size_t WS_WQC = 24 * MiB;
constexpr size_t WS_WOC = 25 * MiB;
constexpr size_t WS_WKVC = 26 * MiB;
constexpr size_t WS_WPQ = 28 * MiB;
constexpr size_t WS_PU = 32 * MiB;
constexpr size_t WS_PV = 64 * MiB;
constexpr size_t WS_ACT0 = 48 * MiB, WS_ACT1 = 80 * MiB;
constexpr size_t WS_MEMN = 96 * MiB;
constexpr size_t WS_KVC = 112 * MiB;
constexpr size_t WS_XN = 128 * MiB;
constexpr size_t WS_H = WS_XN;
constexpr size_t WS_Q = 256 * MiB;
constexpr size_t WS_K = 384 * MiB;
constexpr size_t WS_V = 416 * MiB;
constexpr size_t WS_RW = 448 * MiB;
constexpr size_t WS_Y = 864 * MiB;
constexpr size_t WS_SSQ1 = 992 * MiB, WS_SSQ2 = 996 * MiB;
constexpr size_t WS_QC8 = 256 * MiB;
constexpr size_t WS_QC = 384 * MiB;
constexpr size_t WS_PQ = 448 * MiB;
constexpr size_t WS_RE = 704 * MiB;
constexpr size_t WS_RS = 736 * MiB;
constexpr size_t WS_END = 1024 * MiB;

#ifndef GATE_FP8
#define GATE_FP8 1
#endif
constexpr float GATE_WSCALE = 32.f;
#ifndef CROSS_FP8
#define CROSS_FP8 0
#endif
constexpr float CROSS_OSCALE = 16.f, CROSS_WSCALE = 16.f;
#define LAS __attribute__((address_space(3)))
typedef unsigned short bf16_t;
typedef short bf16x8 __attribute__((ext_vector_type(8)));
typedef float f32x4 __attribute__((ext_vector_type(4)));
typedef float f32x2 __attribute__((ext_vector_type(2)));
typedef float f32x16 __attribute__((ext_vector_type(16)));
typedef unsigned u32x4 __attribute__((ext_vector_type(4)));
typedef unsigned u32x2 __attribute__((ext_vector_type(2)));
typedef __bf16 bf16x2_t __attribute__((ext_vector_type(2)));
typedef __bf16 bf16x32_t __attribute__((ext_vector_type(32)));
typedef unsigned u32x6 __attribute__((ext_vector_type(6)));
typedef unsigned u32x16 __attribute__((ext_vector_type(16)));
typedef int i32x8g __attribute__((ext_vector_type(8)));
typedef int i32x6g __attribute__((ext_vector_type(6)));

__device__ __forceinline__ unsigned pk_bf16(float lo, float hi) { f32x2 v = {lo, hi}; bf16x2_t b = __builtin_convertvector(v, bf16x2_t); return __builtin_bit_cast(unsigned, b); }
__device__ __forceinline__ float bf_lo(unsigned u) { return __uint_as_float(u << 16); }
__device__ __forceinline__ float bf_hi(unsigned u) { return __uint_as_float(u & 0xffff0000u); }
__device__ __forceinline__ float bf1(bf16_t h) { return __uint_as_float((unsigned)h << 16); }
__device__ __forceinline__ float fast_exp2(float x) { return __builtin_amdgcn_exp2f(x); }
__device__ __forceinline__ float fast_rcp(float x) { return __builtin_amdgcn_rcpf(x); }
__device__ __forceinline__ float sigmoidf_(float x) { return fast_rcp(1.f + fast_exp2(-LOG2E * x)); }
template <int CTRL> __device__ __forceinline__ float dpp(float x) { return __builtin_bit_cast(float, __builtin_amdgcn_mov_dpp(__builtin_bit_cast(int, x), CTRL, 0xf, 0xf, true)); }
constexpr int DPP_XOR1 = 0xB1, DPP_XOR2 = 0x4E, DPP_HMIRROR = 0x141, DPP_ROR8 = 0x128;
__device__ __forceinline__ float sum8(float x) { x += dpp<DPP_XOR1>(x); x += dpp<DPP_XOR2>(x); x += dpp<DPP_HMIRROR>(x); return x; }
__device__ __forceinline__ float sum16(float x) { x = sum8(x); x += dpp<DPP_ROR8>(x); return x; }
__device__ __forceinline__ float max16(float x) { x = fmaxf(x, dpp<DPP_XOR1>(x)); x = fmaxf(x, dpp<DPP_XOR2>(x)); x = fmaxf(x, dpp<DPP_HMIRROR>(x)); x = fmaxf(x, dpp<DPP_ROR8>(x)); return x; }
__device__ __forceinline__ float xrow_sum(float x) {
    auto s = __builtin_amdgcn_permlane16_swap(__float_as_uint(x), __float_as_uint(x), false, false); x = __uint_as_float(s[0]) + __uint_as_float(s[1]);
    auto t = __builtin_amdgcn_permlane32_swap(__float_as_uint(x), __float_as_uint(x), false, false); return __uint_as_float(t[0]) + __uint_as_float(t[1]); }
__device__ __forceinline__ float xrow_max(float x) {
    auto s = __builtin_amdgcn_permlane16_swap(__float_as_uint(x), __float_as_uint(x), false, false); x = fmaxf(__uint_as_float(s[0]), __uint_as_float(s[1]));
    auto t = __builtin_amdgcn_permlane32_swap(__float_as_uint(x), __float_as_uint(x), false, false); return fmaxf(__uint_as_float(t[0]), __uint_as_float(t[1])); }
__device__ __forceinline__ float wave_sum(float x) { return xrow_sum(sum16(x)); }
#define GAS __attribute__((address_space(1)))
typedef GAS unsigned gu32;
#define RLX_AGENT __ATOMIC_RELAXED, __HIP_MEMORY_SCOPE_AGENT
#define LDS_WAIT() asm volatile("s_waitcnt lgkmcnt(0)" ::: "memory")

struct Params {
    const float* in[30];
    float* out;
    unsigned char* ws;
};
#define STAGE_MIX 1
#define STAGE_CROSS 1
#define STAGE_PEER 1
#define GATHER_SYNC 0
#define GNT 4
#define GATHER_SPLIT 1
#define GATHER_VMMA 2
#define GATHER_UI4 1
#define VBUF4 1
#define UBUF4 1
#ifndef PG8_WGM
#define PG8_WGM 8
#endif
namespace pg8 {
#define PG8_LAS __attribute__((address_space(3)))
typedef int i32x8 __attribute__((ext_vector_type(8)));
typedef int i32x4 __attribute__((ext_vector_type(4)));
constexpr int BM = 256, BK = 64, HALF = 128, HTB = HALF * BK * 2  , STAGE_BYTES = 8 * HTB, NXCD = 8, WGM = PG8_WGM;

__host__ __device__ __forceinline__ int lds_byte(int r, int c) { const int st = (r >> 4) * 2 + (c >> 5), rr = r & 15, cc = c & 31, ob = rr * 64 + cc * 2; return st * 1024 + (ob ^ (((ob >> 9) & 1) << 5)); }
__host__ __device__ __forceinline__ void stage_rc(int b, int& R, int& C) { const int st = b / 1024, sb = b % 1024, swz = sb ^ (((sb >> 9) & 1) << 5); R = (st >> 1) * 16 + swz / 64; C = (st & 1) * 32 + (swz % 64) / 2; }
__host__ __device__ __forceinline__ int perm32(int rho) { const int n = rho >> 4, i = rho & 15; return 8 * (i >> 2) + 4 * n + (i & 3); }

struct Unit { int pm, pn; };
struct Gemm { const bf16_t* A; const bf16_t* Bt; int M, N, K; };

struct StaticOrder {
    int nM, nN, nwg, G, c;
    __host__ __device__ void init(int M, int N, int G_, int c_) { nM = M / BM; nN = N / BM; nwg = nM * nN; G = G_; c = c_; }
    __host__ __device__ bool next(int i, Unit& u) const {
        const long L = (long)i * G + c; if (L >= nwg) return false;
        int wgid = (int)L; { const int q = nwg / NXCD, r = nwg % NXCD, xcd = wgid % NXCD, off = wgid / NXCD; wgid = (xcd < r ? xcd * (q + 1) : r * (q + 1) + (xcd - r) * q) + off; }
        const int nig = WGM * nN, gid = wgid / nig, fm = gid * WGM, gsz = (nM - fm) < WGM ? (nM - fm) : WGM;
        u.pm = fm + ((wgid % nig) % gsz); u.pn = (wgid % nig) / gsz; return true;
    }
    __device__ __forceinline__ void a_ready(const Unit&) const {}
    __device__ __forceinline__ void done(const Unit&) const {}
};

__device__ __forceinline__ u32x4 pack8(const f32x4 v0, const f32x4 v1) { u32x4 w; w.x = pk_bf16(v0[0], v0[1]); w.y = pk_bf16(v0[2], v0[3]); w.z = pk_bf16(v1[0], v1[1]); w.w = pk_bf16(v1[2], v1[3]); return w; }
__device__ __forceinline__ f32x4 shfl4(const f32x4 v, int m) { f32x4 r; r[0] = __shfl_xor(v[0], m); r[1] = __shfl_xor(v[1], m); r[2] = __shfl_xor(v[2], m); r[3] = __shfl_xor(v[3], m); return r; }

struct EpiPlain {
    static constexpr bool PERM = true, AFTER_DRAIN = false;
    bf16_t* O; int ldc;
    __device__ __forceinline__ void operator()(const f32x4 (&acc)[2][2][4][2], const Unit& u, int wr, int wc, int fr, int fq) const {
        const int row0 = u.pm * BM + wr * 64 + fr, col0 = u.pn * BM + wc * 32 + 8 * fq;
#pragma unroll
        for (int ai = 0; ai < 2; ++ai)
#pragma unroll
            for (int m = 0; m < 4; ++m) { bf16_t* rowp = O + (size_t)(row0 + ai * HALF + m * 16) * ldc + col0;
#pragma unroll
                for (int bj = 0; bj < 2; ++bj) *(u32x4*)(rowp + bj * HALF) = pack8(acc[ai][bj][m][0], acc[ai][bj][m][1]); }
    }
};
struct EpiProj {
    static constexpr bool PERM = true, AFTER_DRAIN = false;
    bf16_t *Q, *Kb, *Vb, *RW; const bf16_t* rt; float qscale; int norope;
    __device__ __forceinline__ void operator()(const f32x4 (&acc)[2][2][4][2], const Unit& u, int wr, int wc, int fr, int fq) const {
        const int pn = u.pn; bf16_t* base; int ldc, colt; bool rope = false; float sc = 1.f;
        if (pn < 4) { base = Q; ldc = 1024; colt = pn * 256; rope = true; sc = qscale; }
        else if (pn == 4) { base = Kb; ldc = 256; colt = 0; rope = true; }
        else if (pn == 5) { base = Vb; ldc = 256; colt = 0; }
        else { base = RW; ldc = RW_W; colt = (pn - 6) * 256; }
        const int row0 = u.pm * BM + wr * 64 + fr, col0 = colt + wc * 32 + 8 * fq;
        const bool dorope = rope && ((wc & 1) == 0) && !norope;
        if (dorope) {
#pragma unroll
            for (int ai = 0; ai < 2; ++ai) {
                u32x4 tc[4], ts[4];
#pragma unroll
                for (int m = 0; m < 4; ++m) { const bf16_t* tp = rt + (size_t)(row0 + ai * HALF + m * 16) * 16; tc[m] = *(const u32x4*)tp; ts[m] = *(const u32x4*)(tp + 8); }
#pragma unroll
                for (int m = 0; m < 4; ++m) { const int row = row0 + ai * HALF + m * 16; bf16_t* rowp = base + (size_t)row * ldc + col0; const u32x4 cw = tc[m], sw = ts[m];
                    const f32x4 c0 = {bf_lo(cw.x), bf_hi(cw.x), bf_lo(cw.y), bf_hi(cw.y)}, c1 = {bf_lo(cw.z), bf_hi(cw.z), bf_lo(cw.w), bf_hi(cw.w)};
                    const f32x4 s0 = {bf_lo(sw.x), bf_hi(sw.x), bf_lo(sw.y), bf_hi(sw.y)}, s1 = {bf_lo(sw.z), bf_hi(sw.z), bf_lo(sw.w), bf_hi(sw.w)};
#pragma unroll
                    for (int bj = 0; bj < 2; ++bj) { f32x4 v0 = acc[ai][bj][m][0], v1 = acc[ai][bj][m][1]; f32x4 p0, p1;
#pragma unroll
                        for (int e = 0; e < 4; ++e) { const auto xa = __builtin_amdgcn_permlane16_swap(__float_as_uint(v0[e]), __float_as_uint(v0[e]), false, false); p0[e] = __uint_as_float((fq & 1) ? xa[0] : xa[1]);
                            const auto xb = __builtin_amdgcn_permlane16_swap(__float_as_uint(v1[e]), __float_as_uint(v1[e]), false, false); p1[e] = __uint_as_float((fq & 1) ? xb[0] : xb[1]); }
                        if (fq == 0) { v0 = v0 * c0 - p0 * s0; v1 = v1 * c1 - p1 * s1; }
                        else if (fq == 1) { v0 = v0 * c0 + p0 * s0; v1 = v1 * c1 + p1 * s1; }
                        *(u32x4*)(rowp + bj * HALF) = pack8(v0 * sc, v1 * sc); } } }
        } else {
#pragma unroll
            for (int ai = 0; ai < 2; ++ai)
#pragma unroll
                for (int m = 0; m < 4; ++m) { bf16_t* rowp = base + (size_t)(row0 + ai * HALF + m * 16) * ldc + col0;
#pragma unroll
                    for (int bj = 0; bj < 2; ++bj) *(u32x4*)(rowp + bj * HALF) = pack8(acc[ai][bj][m][0] * sc, acc[ai][bj][m][1] * sc); }
        }
    }
};
struct EpiGate {
    static constexpr bool PERM = true, AFTER_DRAIN = false;
    bf16_t* MX; const bf16_t* Y; int useA, useB; float nk;
    __device__ __forceinline__ void operator()(const f32x4 (&acc)[2][2][4][2], const Unit& u, int wr, int wc, int fr, int fq) const {
        const int row0 = u.pm * BM + wr * 64 + fr, ch0 = u.pn * HALF + wc * 32 + 8 * fq;
#pragma unroll
        for (int ai = 0; ai < 2; ++ai)
#pragma unroll
            for (int m = 0; m < 4; ++m) { const size_t off = (size_t)(row0 + ai * HALF + m * 16) * D_MODEL + ch0;
                const u32x4 av = useA ? *(const u32x4*)(MX + off) : (u32x4){0u, 0u, 0u, 0u}; const u32x4 yv = useB ? *(const u32x4*)(Y + off) : (u32x4){0u, 0u, 0u, 0u};
                f32x4 o0, o1;
#pragma unroll
                for (int e = 0; e < 4; ++e) {
                    const float a0 = (e & 1) ? bf_hi(av[e >> 1]) : bf_lo(av[e >> 1]), a1 = (e & 1) ? bf_hi(av[2 + (e >> 1)]) : bf_lo(av[2 + (e >> 1)]);
                    const float y0 = (e & 1) ? bf_hi(yv[e >> 1]) : bf_lo(yv[e >> 1]), y1 = (e & 1) ? bf_hi(yv[2 + (e >> 1)]) : bf_lo(yv[2 + (e >> 1)]);
                    o0[e] = fast_rcp(1.f + fast_exp2(nk * acc[ai][0][m][0][e])) * a0 + fast_rcp(1.f + fast_exp2(nk * acc[ai][1][m][0][e])) * y0;
                    o1[e] = fast_rcp(1.f + fast_exp2(nk * acc[ai][0][m][1][e])) * a1 + fast_rcp(1.f + fast_exp2(nk * acc[ai][1][m][1][e])) * y1; }
                *(u32x4*)(MX + off) = pack8(o0, o1); }
    }
};
template <bool RES_F32> struct EpiRes {
    static constexpr bool PERM = true, AFTER_DRAIN = false;
    const float* xres; bf16_t* H; float* ssq; float amp;
    __device__ __forceinline__ void operator()(const f32x4 (&acc)[2][2][4][2], const Unit& u, int wr, int wc, int fr, int fq) const {
        const int row0 = u.pm * BM + wr * 64 + fr, col0 = u.pn * BM + wc * 32 + 8 * fq;
#pragma unroll
        for (int ai = 0; ai < 2; ++ai)
#pragma unroll
            for (int m = 0; m < 4; ++m) { const int row = row0 + ai * HALF + m * 16; float ss = 0.f;
#pragma unroll
                for (int bj = 0; bj < 2; ++bj) { const size_t off = (size_t)row * D_MODEL + col0 + bj * HALF; f32x4 r0, r1;
                    if (RES_F32) { r0 = *(const f32x4*)(xres + off); r1 = *(const f32x4*)(xres + off + 4); }
                    else { const u32x4 hv = *(const u32x4*)(H + off); r0 = (f32x4){bf_lo(hv.x), bf_hi(hv.x), bf_lo(hv.y), bf_hi(hv.y)}; r1 = (f32x4){bf_lo(hv.z), bf_hi(hv.z), bf_lo(hv.w), bf_hi(hv.w)}; }
                    const f32x4 v0 = acc[ai][bj][m][0] * amp + r0, v1 = acc[ai][bj][m][1] * amp + r1;
                    ss += (v0[0] * v0[0] + v0[1] * v0[1]) + (v0[2] * v0[2] + v0[3] * v0[3]) + (v1[0] * v1[0] + v1[1] * v1[1]) + (v1[2] * v1[2] + v1[3] * v1[3]);
                    *(u32x4*)(H + off) = pack8(v0, v1); }
                ss += __shfl_xor(ss, 16); ss += __shfl_xor(ss, 32);
                if (fq == 0) ssq[(size_t)row * 16 + u.pn * 4 + wc] = ss; }
    }
};
struct EpiScaled {
    static constexpr bool PERM = true, AFTER_DRAIN = false;
    bf16_t* O; int ldc; const float* ssq; float mul;
    __device__ __forceinline__ void operator()(const f32x4 (&acc)[2][2][4][2], const Unit& u, int wr, int wc, int fr, int fq) const {
        const int row0 = u.pm * BM + wr * 64 + fr, col0 = u.pn * BM + wc * 32 + 8 * fq;
#pragma unroll
        for (int ai = 0; ai < 2; ++ai)
#pragma unroll
            for (int m = 0; m < 4; ++m) { const int row = row0 + ai * HALF + m * 16; const f32x4* sp = (const f32x4*)(ssq + (size_t)row * 16);
                const f32x4 a = sp[0], b = sp[1], c = sp[2], d = sp[3]; const f32x4 t = (a + b) + (c + d);
                const float rstd = mul / sqrtf(((t[0] + t[1]) + (t[2] + t[3])) * (1.f / D_MODEL) + RMS_EPS);
                bf16_t* rowp = O + (size_t)row * ldc + col0;
#pragma unroll
                for (int bj = 0; bj < 2; ++bj) *(u32x4*)(rowp + bj * HALF) = pack8(acc[ai][bj][m][0] * rstd, acc[ai][bj][m][1] * rstd); }
    }
};
template <class Epi, class Sched, bool ALIGN_EPI = false, bool SP2 = false, bool FP8 = false>
__device__ __forceinline__ void gemm_phase(PG8_LAS unsigned char* lds, const Gemm g, const Sched& S, const Epi& E) {
    int tid_ = threadIdx.x; asm volatile("" : "+v"(tid_));
    const int tid = tid_, wid = __builtin_amdgcn_readfirstlane(tid >> 6), lane = tid & 63, wr = wid >> 2, wc = wid & 3, fr = lane & 15, fq = lane >> 4;
    const int K = g.K, nt = K / BK;
    unsigned voffA[2], voffB[2];
#pragma unroll
    for (int i = 0; i < 2; ++i) { int R, C; stage_rc(tid * 16 + i * 8192, R, C); const int Rb = Epi::PERM ? ((R & ~31) + perm32(R & 31)) : R;
        voffA[i] = (unsigned)(R * K + C) * 2u; voffB[i] = (unsigned)(Rb * K + C) * 2u; }
    const size_t kstep = (size_t)(BK * 2);
    const size_t hstep = (size_t)HALF * K * 2;
    const size_t tstep = 2 * hstep;
    const unsigned ldsw = (unsigned)wid * 1024u;
    const int aoff = lds_byte(wr * 64 + fr, fq * 8), boff = lds_byte(wc * 32 + fr, fq * 8);
#define PG8_SA(b, h) (((b) * 2 + (h)) * HTB)
#define PG8_SB(b, h) ((4 + (b) * 2 + (h)) * HTB)
#define PG8_STAGE(bufoff, gbase, voff) do { _Pragma("unroll") for (int _i = 0; _i < 2; ++_i) \
        __builtin_amdgcn_global_load_lds((const unsigned*)((const char*)(gbase) + (voff)[_i]), (PG8_LAS unsigned*)(lds + (bufoff) + ldsw + _i * 8192), 16, 0, 0); } while (0)
#define PG8_LDA(dst, b, h) do { _Pragma("unroll") for (int m = 0; m < 4; ++m) _Pragma("unroll") for (int k = 0; k < 2; ++k) dst[m][k] = *(const PG8_LAS bf16x8*)(lds + PG8_SA(b, h) + aoff + m * 2048 + k * 1024); } while (0)
#define PG8_LDB(dst, b, h) do { _Pragma("unroll") for (int n = 0; n < 2; ++n) _Pragma("unroll") for (int k = 0; k < 2; ++k) dst[n][k] = *(const PG8_LAS bf16x8*)(lds + PG8_SB(b, h) + boff + n * 2048 + k * 1024); } while (0)
#define PG8_MMA(ai, bj, At, Bt) do { __builtin_amdgcn_s_setprio(1); _Pragma("unroll") for (int m = 0; m < 4; ++m) _Pragma("unroll") for (int n = 0; n < 2; ++n) { \
        if constexpr (FP8) { const i32x8 bb_ = __builtin_shufflevector(__builtin_bit_cast(i32x4, Bt[n][0]), __builtin_bit_cast(i32x4, Bt[n][1]), 0, 1, 2, 3, 4, 5, 6, 7), \
                                         aa_ = __builtin_shufflevector(__builtin_bit_cast(i32x4, At[m][0]), __builtin_bit_cast(i32x4, At[m][1]), 0, 1, 2, 3, 4, 5, 6, 7); \
            asm volatile("v_mfma_f32_16x16x128_f8f6f4 %0, %1, %2, %0" : "+v"(acc[ai][bj][m][n]) : "v"(bb_), "v"(aa_)); } \
        else { _Pragma("unroll") for (int k = 0; k < 2; ++k) acc[ai][bj][m][n] = __builtin_amdgcn_mfma_f32_16x16x32_bf16(Bt[n][k], At[m][k], acc[ai][bj][m][n], 0, 0, 0); } } \
        __builtin_amdgcn_s_setprio(0); } while (0)
#define PG8_WAIT_V(n) asm volatile("s_waitcnt vmcnt(" #n ")" ::: "memory")
#define PG8_WAIT_L(n) asm volatile("s_waitcnt lgkmcnt(" #n ")" ::: "memory")
#define PG8_BAR __builtin_amdgcn_s_barrier()
#define PG8_SCHED __builtin_amdgcn_sched_barrier(0)
    Unit cur, nxt; int ui = 0;
    if (!S.next(0, cur)) return;
    f32x4 acc[2][2][4][2];
#pragma unroll
    for (int a = 0; a < 2; ++a)
#pragma unroll
        for (int b = 0; b < 2; ++b)
#pragma unroll
            for (int m = 0; m < 4; ++m)
#pragma unroll
                for (int n = 0; n < 2; ++n) acc[a][b][m][n] = (f32x4){0.f, 0.f, 0.f, 0.f};
    bf16x8 At[4][2], B0[2][2], B1[2][2];
    const char* cA = (const char*)g.A + (size_t)cur.pm * tstep; const char* cB = (const char*)g.Bt + (size_t)cur.pn * tstep;
    S.a_ready(cur);
    if constexpr (SP2) {
        PG8_STAGE(PG8_SB(0, 0), cB, voffB); PG8_STAGE(PG8_SB(0, 1), cB + hstep, voffB); PG8_STAGE(PG8_SA(0, 0), cA, voffA); PG8_STAGE(PG8_SA(0, 1), cA + hstep, voffA);
        if (wr == 1) PG8_BAR;
        PG8_WAIT_V(2); PG8_BAR;
        PG8_STAGE(PG8_SB(1, 0), cB + kstep, voffB); PG8_STAGE(PG8_SA(1, 0), cA + kstep, voffA); PG8_STAGE(PG8_SB(1, 1), cB + hstep + kstep, voffB);
        PG8_WAIT_V(6); PG8_BAR;
    } else {
        PG8_STAGE(PG8_SB(0, 0), cB, voffB); PG8_STAGE(PG8_SA(0, 0), cA, voffA); PG8_STAGE(PG8_SB(0, 1), cB + hstep, voffB); PG8_STAGE(PG8_SA(0, 1), cA + hstep, voffA);
        if (wr == 1) PG8_BAR;
        PG8_WAIT_V(4); PG8_BAR;
        PG8_STAGE(PG8_SB(1, 0), cB + kstep, voffB); PG8_STAGE(PG8_SA(1, 0), cA + kstep, voffA); PG8_STAGE(PG8_SB(1, 1), cB + hstep + kstep, voffB);
        PG8_WAIT_V(6); PG8_BAR;
    }
    for (;;) {
        const bool has_next = S.next(ui + 1, nxt);
        const char* nA = has_next ? (const char*)g.A + (size_t)nxt.pm * tstep : cA; const char* nB = has_next ? (const char*)g.Bt + (size_t)nxt.pn * tstep : cB;
#pragma clang loop unroll(disable)
        for (int t = 0; t < nt; t += 2) {
            const bool last = (t == nt - 2);
            const char* a1 = cA + (size_t)(t + 1) * kstep;
            const char* a2 = last ? nA : cA + (size_t)(t + 2) * kstep; const char* b2 = last ? nB : cB + (size_t)(t + 2) * kstep;
            const char* a3 = a2 + kstep; const char* b3 = b2 + kstep;
            if (last && has_next) S.a_ready(nxt);
            if constexpr (SP2) {
            PG8_LDB(B0, 0, 0); PG8_LDB(B1, 0, 1); PG8_SCHED; PG8_LDA(At, 0, 0); PG8_STAGE(PG8_SA(1, 1), a1 + hstep, voffA);
            PG8_WAIT_V(8); PG8_WAIT_L(0); PG8_BAR; PG8_MMA(0, 0, At, B0); PG8_MMA(0, 1, At, B1); PG8_BAR; PG8_SCHED;
            PG8_LDA(At, 0, 1); PG8_STAGE(PG8_SB(0, 0), b2, voffB); PG8_STAGE(PG8_SB(0, 1), b2 + hstep, voffB); PG8_STAGE(PG8_SA(0, 0), a2, voffA);
            PG8_WAIT_V(8); PG8_WAIT_L(0); PG8_BAR; PG8_MMA(1, 0, At, B0); PG8_MMA(1, 1, At, B1); PG8_BAR; PG8_SCHED;
            PG8_LDB(B0, 1, 0); PG8_LDB(B1, 1, 1); PG8_SCHED; PG8_LDA(At, 1, 0); PG8_STAGE(PG8_SA(0, 1), a2 + hstep, voffA);
            PG8_WAIT_V(8); PG8_WAIT_L(0); PG8_BAR; PG8_MMA(0, 0, At, B0); PG8_MMA(0, 1, At, B1); PG8_BAR; PG8_SCHED;
            PG8_LDA(At, 1, 1); PG8_STAGE(PG8_SB(1, 0), b3, voffB); PG8_STAGE(PG8_SB(1, 1), b3 + hstep, voffB); PG8_STAGE(PG8_SA(1, 0), a3, voffA);
            PG8_WAIT_V(8); PG8_WAIT_L(0); PG8_BAR; PG8_MMA(1, 0, At, B0); PG8_MMA(1, 1, At, B1); PG8_BAR; PG8_SCHED;
            } else {
            PG8_LDB(B0, 0, 0); PG8_SCHED; PG8_LDA(At, 0, 0); PG8_STAGE(PG8_SA(1, 1), a1 + hstep, voffA);
            PG8_WAIT_L(8); PG8_BAR; PG8_WAIT_L(0); PG8_MMA(0, 0, At, B0); PG8_BAR; PG8_SCHED;
            PG8_LDB(B1, 0, 1); PG8_STAGE(PG8_SB(0, 0), b2, voffB);
            PG8_BAR; PG8_WAIT_L(0); PG8_MMA(0, 1, At, B1); PG8_BAR;
            PG8_LDA(At, 0, 1); PG8_STAGE(PG8_SA(0, 0), a2, voffA);
            PG8_BAR; PG8_WAIT_L(0); PG8_MMA(1, 0, At, B0); PG8_BAR; PG8_SCHED;
            PG8_STAGE(PG8_SB(0, 1), b2 + hstep, voffB);
            PG8_WAIT_V(6); PG8_BAR; PG8_MMA(1, 1, At, B1); PG8_BAR;
            PG8_LDB(B0, 1, 0); PG8_SCHED; PG8_LDA(At, 1, 0); PG8_STAGE(PG8_SA(0, 1), a2 + hstep, voffA);
            PG8_WAIT_L(8); PG8_BAR; PG8_WAIT_L(0); PG8_MMA(0, 0, At, B0); PG8_BAR; PG8_SCHED;
            PG8_LDB(B1, 1, 1); PG8_STAGE(PG8_SB(1, 0), b3, voffB);
            PG8_BAR; PG8_WAIT_L(0); PG8_MMA(0, 1, At, B1); PG8_BAR;
            PG8_LDA(At, 1, 1); PG8_STAGE(PG8_SA(1, 0), a3, voffA);
            PG8_BAR; PG8_WAIT_L(0); PG8_MMA(1, 0, At, B0); PG8_BAR; PG8_SCHED;
            PG8_STAGE(PG8_SB(1, 1), b3 + hstep, voffB);
            PG8_WAIT_V(6); PG8_BAR; PG8_MMA(1, 1, At, B1); PG8_BAR;
            }
        }
        if constexpr (ALIGN_EPI) { if (wr == 0) PG8_BAR; }
        if constexpr (!Epi::AFTER_DRAIN) {
            if constexpr (FP8) { int fr_ = fr, fq_ = fq; asm volatile("s_nop 15\n\ts_nop 15" : "+v"(fr_), "+v"(fq_));
                _Pragma("unroll") for (int a = 0; a < 2; ++a) _Pragma("unroll") for (int b = 0; b < 2; ++b) _Pragma("unroll") for (int m = 0; m < 4; ++m) _Pragma("unroll") for (int n = 0; n < 2; ++n) asm volatile("" : "+v"(acc[a][b][m][n]));
                E(acc, cur, wr, wc, fr_, fq_); }
            else E(acc, cur, wr, wc, fr, fq);
            S.done(cur); }
        if (!has_next) break;
#pragma unroll
        for (int a = 0; a < 2; ++a)
#pragma unroll
            for (int b = 0; b < 2; ++b)
#pragma unroll
                for (int m = 0; m < 4; ++m)
#pragma unroll
                    for (int n = 0; n < 2; ++n) acc[a][b][m][n] = (f32x4){0.f, 0.f, 0.f, 0.f};
        cur = nxt; cA = nA; cB = nB; ++ui;
        if constexpr (ALIGN_EPI) { if (wr == 1) PG8_BAR; }
    }
    PG8_WAIT_V(0);
    if constexpr (!ALIGN_EPI) { if (wr == 0) PG8_BAR; }
    PG8_BAR;
    if constexpr (Epi::AFTER_DRAIN) { E.fused(acc, cur, wr, wc, fr, fq, lds, wid, lane); S.done(cur); }
#undef PG8_SA
#undef PG8_SB
#undef PG8_STAGE
#undef PG8_LDA
#undef PG8_LDB
#undef PG8_MMA
#undef PG8_WAIT_V
#undef PG8_WAIT_L
#undef PG8_BAR
#undef PG8_SCHED
}
}
#ifndef GATHER_VMMA
#define GATHER_VMMA 0
#endif
#ifndef GATHER_UI4
#define GATHER_UI4 0
#endif
constexpr int PU_ROWB = GATHER_UI4 ? 512 : 1024; constexpr float PU_QS = 91.2f;
#ifndef V6_DIAG_FP8
#define V6_DIAG_FP8 0
#endif
constexpr int PV_ROWB = (GATHER_VMMA == 2 && !V6_DIAG_FP8) ? 768 : 1024; constexpr float PV_SCALE = (GATHER_VMMA == 2 && !V6_DIAG_FP8) ? 5.5f : 64.f;
template <int MODE  >
__device__ __forceinline__ void transpose_item(const float* W, int ldw, int c0, int K, int N, bf16_t* WT, const float* gain, LAS float* scr, int item, int lane) {
    const int nblk = N / 32, kb = item / nblk, nb = item % nblk, k0 = 64 * kb, n0 = 32 * nb;
#pragma unroll 8
    for (int i = 0; i < 32; ++i) { const int kk = 2 * i + (lane >> 5); float v = W[(size_t)(k0 + kk) * ldw + c0 + n0 + (lane & 31)]; if (gain) v *= gain[k0 + kk]; scr[kk * 33 + (lane & 31)] = v; }
    LDS_WAIT(); asm volatile("" ::: "memory");
    const int c = lane & 7;
    int rbase = n0;
    if (MODE == 1 || MODE == 2) { const int isB = n0 >> 10, ch = n0 & 1023; rbase = 256 * (ch >> 7) + 128 * isB + (ch & 127); }
#pragma unroll
    for (int j = 0; j < 4; ++j) { const int n = (lane >> 3) + 8 * j; const LAS float* s = scr + (8 * c) * 33 + n;
        if (MODE >= 2) { constexpr float WS8 = MODE == 2 ? GATE_WSCALE : CROSS_WSCALE; int w0 = __builtin_amdgcn_cvt_pk_fp8_f32(s[0 * 33] * WS8, s[1 * 33] * WS8, 0, false); w0 = __builtin_amdgcn_cvt_pk_fp8_f32(s[2 * 33] * WS8, s[3 * 33] * WS8, w0, true);
            int w1 = __builtin_amdgcn_cvt_pk_fp8_f32(s[4 * 33] * WS8, s[5 * 33] * WS8, 0, false); w1 = __builtin_amdgcn_cvt_pk_fp8_f32(s[6 * 33] * WS8, s[7 * 33] * WS8, w1, true);
            *(u32x2*)((unsigned char*)WT + (size_t)(rbase + n) * K + k0 + 8 * c) = (u32x2){(unsigned)w0, (unsigned)w1}; }
        else { u32x4 o; o.x = pk_bf16(s[0 * 33], s[1 * 33]); o.y = pk_bf16(s[2 * 33], s[3 * 33]); o.z = pk_bf16(s[4 * 33], s[5 * 33]); o.w = pk_bf16(s[6 * 33], s[7 * 33]);
            *(u32x4*)(WT + (size_t)(rbase + n) * K + k0 + 8 * c) = o; } }
    LDS_WAIT(); asm volatile("" ::: "memory");
}
__device__ __forceinline__ void rms_row_to_bf16(const float* xrow, const float* gain, bf16_t* orow, int lane) {
    const f32x4* xr = (const f32x4*)xrow + lane; const f32x4* gr = (const f32x4*)gain + lane;
    f32x4 v[4]; float s = 0.f;
#pragma unroll
    for (int j = 0; j < 4; ++j) { v[j] = xr[64 * j]; s += (v[j].x * v[j].x + v[j].y * v[j].y) + (v[j].z * v[j].z + v[j].w * v[j].w); }
    const float rstd = 1.f / sqrtf(wave_sum(s) * (1.f / D_MODEL) + RMS_EPS);
    u32x2* o8 = (u32x2*)orow + lane;
#pragma unroll
    for (int j = 0; j < 4; ++j) { const f32x4 g = gr[64 * j]; u32x2 w; w.x = pk_bf16(v[j].x * rstd * g.x, v[j].y * rstd * g.y); w.y = pk_bf16(v[j].z * rstd * g.z, v[j].w * rstd * g.w); o8[64 * j] = w; }
}
__device__ __forceinline__ void cvt_row_to_bf16(const float* xrow, const float* gain, bf16_t* orow, int lane) {
    const f32x4* xr = (const f32x4*)xrow + lane; u32x2* o8 = (u32x2*)orow + lane;
#pragma unroll
    for (int j = 0; j < 4; ++j) { f32x4 v = xr[64 * j]; if (gain) v = v * ((const f32x4*)gain + lane)[64 * j]; u32x2 w; w.x = pk_bf16(v.x, v.y); w.y = pk_bf16(v.z, v.w); o8[64 * j] = w; }
}
__device__ __forceinline__ bf16_t bf16_of_(float v) { return (bf16_t)(pk_bf16(v, 0.f) & 0xffffu); }
__device__ __forceinline__ void cvt_row_to_fp8(const float* xrow, const float* gain, float scale, unsigned char* orow, int lane) {
    const f32x4* xr = (const f32x4*)(xrow + 16 * lane); u32x4 o;
#pragma unroll
    for (int q = 0; q < 4; ++q) { f32x4 v = xr[q] * scale; if (gain) v = v * ((const f32x4*)(gain + 16 * lane))[q];
        int w = __builtin_amdgcn_cvt_pk_fp8_f32(v.x, v.y, 0, false); w = __builtin_amdgcn_cvt_pk_fp8_f32(v.z, v.w, w, true); o[q] = (unsigned)w; }
    *(u32x4*)(orow + 16 * lane) = o;
}
__device__ __forceinline__ void cvt_row_to_fp6_planes(const float* xrow, float scale, unsigned char* orow, int n) {
    const f32x4* xr = (const f32x4*)(xrow + 32 * n); u32x16 w;
#pragma unroll
    for (int q = 0; q < 8; ++q) { const f32x4 v = xr[q] * scale; w[2 * q] = pk_bf16(v.x, v.y); w[2 * q + 1] = pk_bf16(v.z, v.w); }
    const u32x6 r = __builtin_amdgcn_cvt_scalef32_pk32_fp6_bf16(__builtin_bit_cast(bf16x32_t, w), 1.0f);
    *(u32x4*)(orow + 16 * n) = (u32x4){r[0], r[1], r[2], r[3]}; *(u32x2*)(orow + 512 + 8 * n) = (u32x2){r[4], r[5]};
}
__device__ __forceinline__ void cvt_row_to_i4(const float* xrow, const float* gain, float scale, unsigned char* orow, int n) {
    const f32x4* xr = (const f32x4*)(xrow + 32 * n); const f32x4* gr = (const f32x4*)(gain + 32 * n); u32x4 o;
#pragma unroll
    for (int d = 0; d < 4; ++d) { const f32x4 a = xr[2 * d] * gr[2 * d] * scale, b = xr[2 * d + 1] * gr[2 * d + 1] * scale; unsigned w = 0u;
#pragma unroll
        for (int k = 0; k < 4; ++k) { const int qa = (int)fminf(fmaxf(rintf(a[k]), -7.f), 7.f), qb = (int)fminf(fmaxf(rintf(b[k]), -7.f), 7.f);
            w |= ((unsigned)qa & 15u) << (8 * k) | ((unsigned)qb & 15u) << (8 * k + 4); }
        o[d] = w; }
    *(u32x4*)(orow + 16 * n) = o;
}
#ifndef TABLES_LATE
#define TABLES_LATE 0
#endif
__device__ __forceinline__ void peer_tables_lowp(const Params& p, int wave, int lane) {
    unsigned char* ws = p.ws; const int gw = blockIdx.x * NWAVES + wave, NGW = gridDim.x * NWAVES; (void)ws; (void)gw; (void)NGW;
#if GATHER_UI4
    for (int m0 = 2 * gw; m0 < N_EXPERTS; m0 += 2 * NGW) { const int m = m0 + (lane >> 5);
        cvt_row_to_i4(p.in[27] + (size_t)m * D_MODEL, p.in[23], PU_QS, ws + WS_PU + (size_t)m * PU_ROWB, lane & 31); }
#endif
#if GATHER_VMMA == 2 && !V6_DIAG_FP8
    for (int m0 = 2 * gw; m0 < N_EXPERTS; m0 += 2 * NGW) { const int m = m0 + (lane >> 5);
        cvt_row_to_fp6_planes(p.in[28] + (size_t)m * D_MODEL, PV_SCALE, ws + WS_PV + (size_t)m * PV_ROWB, lane & 31); }
#endif
}
__device__ __forceinline__ void p0_prologue(const Params& p, LAS unsigned char* lds, int wave, int lane) {
    LAS float* scr = (LAS float*)(lds + wave * 16384);
    const int gw = blockIdx.x * NWAVES + wave, NGW = gridDim.x * NWAVES;
    unsigned char* ws = p.ws;
    int base = 0;
#define TJOB(MODE, W, LDW, C0, KK, NN, WT, GAIN) do { const int nitems_ = ((KK) / 64) * ((NN) / 32); const int first_ = (gw - base % NGW + NGW) % NGW; \
        for (int it = first_; it < nitems_; it += NGW) transpose_item<MODE>((W), (LDW), (C0), (KK), (NN), (bf16_t*)(ws + (WT)), (GAIN), scr, it, lane); base += nitems_; } while (0)
    TJOB(0, p.in[4], IN_WIDTH, 0, 1024, N_PROJA, WS_WINA, nullptr);
    TJOB(GATE_FP8 ? 2 : 1, p.in[4], IN_WIDTH, N_PROJA, 1024, 2048, WS_WING, nullptr);
    TJOB(0, p.in[17], 1024, 0, 1024, 1024, WS_WOUT, nullptr);
    TJOB(0, p.in[20], 512, 0, 1024, 512, WS_WQC, p.in[18]);
    TJOB(0, p.in[21], 1024, 0, 1024, 1024, WS_WKVC, nullptr);
    TJOB(CROSS_FP8 ? 3 : 0, p.in[22], 1024, 0, 512, 1024, WS_WOC, nullptr);
    TJOB(0, p.in[24], 2048, 0, 1024, 2048, WS_WPQ, p.in[23]);
    TJOB(0, p.in[8], 1024, 0, 64, 1024, WS_W2T, nullptr);
    TJOB(0, p.in[10], 1024, 0, 64, 1024, WS_A2T, nullptr);
    TJOB(0, p.in[11], 1024, 0, 128, 1024, WS_G2T, nullptr);
#undef TJOB
    {
        const f32x4* gr = (const f32x4*)p.in[3] + lane; const f32x4 gq0 = gr[0], gq1 = gr[64], gq2 = gr[128], gq3 = gr[192];
        for (int m0 = gw * 4; m0 < T_TOK; m0 += NGW * 4) {
            f32x4 v[4][4];
#pragma unroll
            for (int r = 0; r < 4; ++r) { const f32x4* xr = (const f32x4*)(p.in[0] + (size_t)(m0 + r) * D_MODEL) + lane;
#pragma unroll
                for (int j = 0; j < 4; ++j) v[r][j] = xr[64 * j]; }
#pragma unroll
            for (int r = 0; r < 4; ++r) { float s_ = 0.f;
#pragma unroll
                for (int j = 0; j < 4; ++j) s_ += (v[r][j].x * v[r][j].x + v[r][j].y * v[r][j].y) + (v[r][j].z * v[r][j].z + v[r][j].w * v[r][j].w);
                const float rstd = 1.f / sqrtf(wave_sum(s_) * (1.f / D_MODEL) + RMS_EPS);
                u32x2* o8 = (u32x2*)((bf16_t*)(ws + WS_XN) + (size_t)(m0 + r) * D_MODEL) + lane;
#pragma unroll
                for (int j = 0; j < 4; ++j) { const f32x4 gq = j == 0 ? gq0 : (j == 1 ? gq1 : (j == 2 ? gq2 : gq3)); u32x2 w; w.x = pk_bf16(v[r][j].x * rstd * gq.x, v[r][j].y * rstd * gq.y); w.y = pk_bf16(v[r][j].z * rstd * gq.z, v[r][j].w * rstd * gq.w); o8[64 * j] = w;
#if GATE_FP8
                    { int q8 = __builtin_amdgcn_cvt_pk_fp8_f32(v[r][j].x * rstd * gq.x, v[r][j].y * rstd * gq.y, 0, false); q8 = __builtin_amdgcn_cvt_pk_fp8_f32(v[r][j].z * rstd * gq.z, v[r][j].w * rstd * gq.w, q8, true);
                      ((unsigned*)((unsigned char*)p.out + (size_t)(m0 + r) * D_MODEL))[lane + 64 * j] = (unsigned)q8; }
#endif
                } }
        }
    }
    for (int m = gw; m < MEM_ROWS; m += NGW) rms_row_to_bf16(p.in[1] + (size_t)m * D_MODEL, p.in[19], (bf16_t*)(ws + WS_MEMN) + (size_t)m * D_MODEL, lane);
    for (int m = gw; m < N_EXPERTS; m += NGW) {
#if !GATHER_UI4
        cvt_row_to_fp8(p.in[27] + (size_t)m * D_MODEL, p.in[23], 512.f, ws + WS_PU + (size_t)m * D_MODEL, lane);
#endif
#if GATHER_VMMA != 2 || V6_DIAG_FP8
        cvt_row_to_fp8(p.in[28] + (size_t)m * D_MODEL, nullptr, 64.f, ws + WS_PV + (size_t)m * D_MODEL, lane);
#endif
    }
#if !TABLES_LATE
    peer_tables_lowp(p, wave, lane);
#endif
    { const int gt = blockIdx.x * NTHREADS + threadIdx.x, NGT = gridDim.x * NTHREADS;
      for (int i = gt; i < 2 * 128 * 128 / 4; i += NGT) { const int which = i / 4096, j = i % 4096; const f32x4 v = which ? ((const f32x4*)p.in[26])[j] : ((const f32x4*)p.in[25])[j];
          u32x2 w; w.x = pk_bf16(v.x, v.y); w.y = pk_bf16(v.z, v.w); ((u32x2*)(ws + (which ? WS_PK2 : WS_PK1)))[j] = w; }
      const int* pos = (const int*)p.in[2];
      for (int i = gt; i < T_TOK * 8; i += NGT) { const int t = i >> 3, f = i & 7;
          const double inv = f == 0 ? 1.0 : f == 1 ? 0.19392274474868576 : f == 2 ? 0.03760603093086393 : f == 3 ? 0.007292664737217109 : f == 4 ? 0.001414213562373095 : f == 5 ? 0.0002742481756762073 : f == 6 ? 5.318295896944988e-05 : 1.031338537721246e-05;
          const double rev = (double)pos[t] * inv * 0.15915494309189535; const float fr = (float)(rev - floor(rev));
          bf16_t* rt = (bf16_t*)(ws + WS_ROPE_C) + (size_t)t * 16; rt[f] = bf16_of_(__builtin_amdgcn_cosf(fr)); rt[8 + f] = bf16_of_(__builtin_amdgcn_sinf(fr)); }
    }
}
__device__ __forceinline__ void final_norm_rows(const bf16_t* H, const float* gain, float* out, int wave, int lane) {
    const int gw = blockIdx.x * NWAVES + wave, NGW = gridDim.x * NWAVES;
    for (int m = gw; m < T_TOK; m += NGW) {
        const u32x2* hr = (const u32x2*)(H + (size_t)m * D_MODEL) + lane; const f32x4* gr = (const f32x4*)gain + lane;
        f32x4 v[4]; float s = 0.f;
#pragma unroll
        for (int j = 0; j < 4; ++j) { const u32x2 w = hr[64 * j]; v[j] = (f32x4){bf_lo(w.x), bf_hi(w.x), bf_lo(w.y), bf_hi(w.y)}; s += (v[j].x * v[j].x + v[j].y * v[j].y) + (v[j].z * v[j].z + v[j].w * v[j].w); }
        const float rstd = 1.f / sqrtf(wave_sum(s) * (1.f / D_MODEL) + RMS_EPS);
        f32x4* orow = (f32x4*)(out + (size_t)m * D_MODEL) + lane;
#pragma unroll
        for (int j = 0; j < 4; ++j) orow[64 * j] = v[j] * rstd * gr[64 * j];
    }
}
#define MFMA16(a, b, c) __builtin_amdgcn_mfma_f32_16x16x32_bf16((a), (b), (c), 0, 0, 0)
template <int HD, int NT, bool SWA, bool OUT8 = false>
__device__ __forceinline__ void attn_group(const bf16_t* qp, LAS const unsigned char* Kimg, int kstr, LAS const unsigned char* VTimg, int vstr, bf16_t* op, int lane,
                                           int i0, int jmin, int jt0, float sink2, unsigned char* op8 = nullptr) {
    const int fr = lane & 15, g = lane >> 4;
    constexpr int KS = HD / 32, DT = HD / 16, NP = NT / 2;
    bf16x8 qf[KS];
#pragma unroll
    for (int ks = 0; ks < KS; ++ks) qf[ks] = *(const bf16x8*)(qp + 32 * ks);
    f32x4 s[NT];
#pragma unroll
    for (int kt = 0; kt < NT; ++kt) { s[kt] = (f32x4){0.f, 0.f, 0.f, 0.f};
#pragma unroll
        for (int ks = 0; ks < KS; ++ks) { const bf16x8 kf = *(const LAS bf16x8*)(Kimg + (16 * kt + fr) * kstr + 16 * g + 64 * ks); s[kt] = MFMA16(kf, qf[ks], s[kt]); }
        if ((kt & 1) == 1) __builtin_amdgcn_sched_barrier(0); }
    if (SWA) { const int i = i0 + fr;
#pragma unroll
        for (int kt = 0; kt < NT; ++kt)
#pragma unroll
            for (int r = 0; r < 4; ++r) { const int j = 16 * (jt0 + kt) + 4 * g + r; const bool valid = (j > i) && (j <= i + 128) && (j >= jmin); s[kt][r] = valid ? s[kt][r] : -1e30f; } }
    float m = -1e30f;
#pragma unroll
    for (int kt = 0; kt < NT; ++kt) m = fmaxf(fmaxf(m, fmaxf(s[kt][0], s[kt][1])), fmaxf(s[kt][2], s[kt][3]));
    m = xrow_max(m);
    if (SWA) m = fmaxf(m, sink2);
    float l = 0.f;
#pragma unroll
    for (int kt = 0; kt < NT; ++kt)
#pragma unroll
        for (int r = 0; r < 4; ++r) { const float pe = fast_exp2(s[kt][r] - m); s[kt][r] = pe; l += pe; }
    l = xrow_sum(l);
    if (SWA) l += fast_exp2(sink2 - m);
    const float rl = 1.f / l;
    bf16x8 pf[NP];
#pragma unroll
    for (int sp = 0; sp < NP; ++sp) { u32x4 w; w.x = pk_bf16(s[2 * sp][0], s[2 * sp][1]); w.y = pk_bf16(s[2 * sp][2], s[2 * sp][3]); w.z = pk_bf16(s[2 * sp + 1][0], s[2 * sp + 1][1]); w.w = pk_bf16(s[2 * sp + 1][2], s[2 * sp + 1][3]);
        pf[sp] = __builtin_bit_cast(bf16x8, w); }
#pragma unroll
    for (int dt = 0; dt < DT; ++dt) { f32x4 o = (f32x4){0.f, 0.f, 0.f, 0.f};
#pragma unroll
        for (int sp = 0; sp < NP; ++sp) { LAS const unsigned char* vp = VTimg + (16 * dt + fr) * vstr + (32 * sp + 4 * g) * 2;
            const u32x2 lo = *(const LAS u32x2*)vp, hi = *(const LAS u32x2*)(vp + 32); const u32x4 w = {lo.x, lo.y, hi.x, hi.y};
            o = MFMA16(__builtin_bit_cast(bf16x8, w), pf[sp], o); }
        if constexpr (OUT8) { const float r8 = rl * CROSS_OSCALE; int w8 = __builtin_amdgcn_cvt_pk_fp8_f32(o[0] * r8, o[1] * r8, 0, false); w8 = __builtin_amdgcn_cvt_pk_fp8_f32(o[2] * r8, o[3] * r8, w8, true); *(unsigned*)(op8 + 16 * dt) = (unsigned)w8; }
        else { u32x2 ow; ow.x = pk_bf16(o[0] * rl, o[1] * rl); ow.y = pk_bf16(o[2] * rl, o[3] * rl); *(u32x2*)(op + 16 * dt) = ow; }
        __builtin_amdgcn_sched_barrier(0); }
}
constexpr int SWA_KSTR = 144, SWA_VSTR = 560, SWA_VT_OFF = 40960, SWA_NT = 10;
__device__ __forceinline__ void swa_phase(const Params& p, LAS unsigned char* lds, int tid, int wave, int lane) {
    unsigned char* ws = p.ws; bf16_t* Q = (bf16_t*)(ws + WS_Q); const bf16_t* Kb = (const bf16_t*)(ws + WS_K); const bf16_t* Vb = (const bf16_t*)(ws + WS_V);
    LAS unsigned char* Kimg = lds; LAS unsigned char* VTimg = lds + SWA_VT_OFF;
    for (int i = tid; i < 16 * SWA_KSTR / 4; i += NTHREADS) ((LAS unsigned*)(Kimg + 256 * SWA_KSTR))[i] = 0u;
    for (int i = tid; i < 64 * 8; i += NTHREADS) ((LAS unsigned*)(VTimg + (i >> 3) * SWA_VSTR + 512))[i & 7] = 0u;
    const int fr = lane & 15, g = lane >> 4;
    for (int unit = blockIdx.x; unit < BATCH * 4 * 16; unit += gridDim.x) {
        const int b = unit >> 6, kvh = (unit >> 4) & 3, qb = unit & 15;
        const bf16_t* Kg = Kb + (size_t)b * SEQ * 256 + kvh * 64; const bf16_t* Vg = Vb + (size_t)b * SEQ * 256 + kvh * 64;
        __syncthreads();
        u32x4 kvr[4], vvr[4];
#pragma unroll
        for (int it = 0; it < 4; ++it) { const int idx = tid + NTHREADS * it, key = idx & 255, c = idx >> 8, t = qb * 128 - 128 + key, tc = t >= 0 ? t : 0;
            kvr[it] = *(const u32x4*)(Kg + (size_t)tc * 256 + 8 * c); vvr[it] = *(const u32x4*)(Vg + (size_t)tc * 256 + 8 * c); }
#pragma unroll
        for (int it = 0; it < 4; ++it) { const int idx = tid + NTHREADS * it, key = idx & 255, c = idx >> 8, t = qb * 128 - 128 + key;
            const u32x4 z = {0u, 0u, 0u, 0u}; const u32x4 kv = t >= 0 ? kvr[it] : z, vv = t >= 0 ? vvr[it] : z;
            *(LAS u32x4*)(Kimg + key * SWA_KSTR + 16 * c) = kv;
#pragma unroll
            for (int i = 0; i < 8; ++i) *(LAS bf16_t*)(VTimg + (8 * c + i) * SWA_VSTR + key * 2) = (bf16_t)((vv[i >> 1] >> (16 * (i & 1))) & 0xffffu); }
        __syncthreads();
        const int head = kvh * 4 + (wave >> 1); const float sink2 = p.in[5][head] * LOG2E;
#pragma unroll 1
        for (int gi = 0; gi < 4; ++gi) { const int i0 = (wave & 1) * 64 + 16 * gi, jt0 = i0 >> 4; const size_t tok = (size_t)b * SEQ + qb * 128 + i0 + fr;
            attn_group<64, SWA_NT, true>(Q + tok * D_MODEL + head * 64 + 8 * g, Kimg + jt0 * 16 * SWA_KSTR, SWA_KSTR, VTimg + jt0 * 32, SWA_VSTR,
                                        Q + tok * D_MODEL + head * 64 + 4 * g, lane, i0, qb == 0 ? 128 : 0, jt0, sink2); }
    }
    __syncthreads();
}
constexpr int CR_KSTR = 272, CR_VSTR = 528, CR_VT_OFF = 69632;
__device__ __forceinline__ void cross_phase(const Params& p, LAS unsigned char* lds, int tid, int wave, int lane) {
    unsigned char* ws = p.ws; bf16_t* QC = (bf16_t*)(ws + WS_QC); const bf16_t* KVC = (const bf16_t*)(ws + WS_KVC);
    LAS unsigned char* Kimg = lds; LAS unsigned char* VTimg = lds + CR_VT_OFF;
    const int fr = lane & 15, g = lane >> 4;
    for (int unit = blockIdx.x; unit < BATCH * 4 * 2; unit += gridDim.x) {
        const int b = unit >> 3, h = (unit >> 1) & 3, half = unit & 1;
        const bf16_t* src = KVC + (size_t)b * MEM_LEN * 1024 + h * 128;
        __syncthreads();
        u32x4 kvr[8], vvr[8];
#pragma unroll
        for (int it = 0; it < 8; ++it) { const int idx = tid + NTHREADS * it, key = idx & 255, c = idx >> 8;
            kvr[it] = *(const u32x4*)(src + (size_t)key * 1024 + 8 * c); vvr[it] = *(const u32x4*)(src + (size_t)key * 1024 + 512 + 8 * c); }
#pragma unroll
        for (int it = 0; it < 8; ++it) { const int idx = tid + NTHREADS * it, key = idx & 255, c = idx >> 8; const u32x4 vv = vvr[it];
            *(LAS u32x4*)(Kimg + key * CR_KSTR + 16 * c) = kvr[it];
#pragma unroll
            for (int i = 0; i < 8; ++i) *(LAS bf16_t*)(VTimg + (8 * c + i) * CR_VSTR + key * 2) = (bf16_t)((vv[i >> 1] >> (16 * (i & 1))) & 0xffffu); }
        __syncthreads();
#pragma unroll 1
        for (int gi = 0; gi < 8; ++gi) { const size_t tok = (size_t)b * SEQ + half * 1024 + (wave * 8 + gi) * 16 + fr;
#if CROSS_FP8
            attn_group<128, 16, false, true>(QC + tok * 512 + h * 128 + 8 * g, Kimg, CR_KSTR, VTimg, CR_VSTR, nullptr, lane, 0, 0, 0, 0.f, ws + WS_QC8 + tok * 512 + h * 128 + 4 * g); }
#else
            attn_group<128, 16, false>(QC + tok * 512 + h * 128 + 8 * g, Kimg, CR_KSTR, VTimg, CR_VSTR, QC + tok * 512 + h * 128 + 4 * g, lane, 0, 0, 0, 0.f); }
#endif
    }
    __syncthreads();
}
constexpr int CK_STR = 144, CK_TSTR = 80;
constexpr int RW_LAM = 0, RW_A = 4096, RW_G = 8192, RW_V = 16384, RW_O = 24576;
constexpr int RW_AT = 28672, RW_RT = RW_AT + 16 * CK_STR, RW_BT = RW_RT + 16 * CK_STR, RW_KT = RW_BT + 16 * CK_STR;
constexpr int CK_VSTR = 40;
constexpr int RW_BKT = RW_KT + 16 * CK_STR, RW_VT = RW_BKT + 64 * CK_TSTR, RW_GA = RW_VT + 64 * CK_VSTR;
constexpr int RW_NN = RW_GA + 2 * 16 * CK_TSTR, RW_GC = RW_NN + 1024, RW_BON = RW_GC + 256, RW_C = RW_BON + 128, RWG_BYTES = RW_C + 2560;
constexpr int RW_MU = 2 * RWG_BYTES;
static_assert(RW_MU + 1024 <= LDS_BYTES - 16, "rwkv LDS map");
#define LBAR() do { asm volatile("s_waitcnt lgkmcnt(0)" ::: "memory"); __builtin_amdgcn_s_barrier(); asm volatile("" ::: "memory"); } while (0)
__device__ __forceinline__ f32x4 lds4(LAS const unsigned char* p) { return *(const LAS f32x4*)p; }
__device__ __forceinline__ void unpack8(const u32x4 w, float (&o)[8]) { o[0] = bf_lo(w.x); o[1] = bf_hi(w.x); o[2] = bf_lo(w.y); o[3] = bf_hi(w.y); o[4] = bf_lo(w.z); o[5] = bf_hi(w.z); o[6] = bf_lo(w.w); o[7] = bf_hi(w.w); }
__device__ __forceinline__ f32x4 unpack4(const u32x2 w) { return (f32x4){bf_lo(w.x), bf_hi(w.x), bf_lo(w.y), bf_hi(w.y)}; }
__device__ __forceinline__ u32x2 pack4(const f32x4 v) { u32x2 w; w.x = pk_bf16(v[0], v[1]); w.y = pk_bf16(v[2], v[3]); return w; }
__device__ __forceinline__ bf16_t bf16_of(float v) { return (bf16_t)(pk_bf16(v, 0.f) & 0xffffu); }
__device__ __forceinline__ float prefix16(float x) {
    x += dpp<0x111>(x); x += dpp<0x112>(x); x += dpp<0x114>(x); x += dpp<0x118>(x); return x; }
__device__ __forceinline__ bf16x8 frag2(LAS const unsigned char* p, int d) { const u32x2 lo = *(const LAS u32x2*)p, hi = *(const LAS u32x2*)(p + d); const u32x4 w = {lo.x, lo.y, hi.x, hi.y}; return __builtin_bit_cast(bf16x8, w); }
__device__ __forceinline__ bf16_t* act_row(unsigned char* ws, size_t row) { return (bf16_t*)(ws + (row < (size_t)T_TOK / 2 ? WS_ACT0 : WS_ACT1)) + (row & ((size_t)T_TOK / 2 - 1)) * 256; }
__device__ __forceinline__ void rwkv_act_phase(const Params& p, int wave, int lane) {
    unsigned char* ws = p.ws; const bf16_t* RW = (const bf16_t*)(ws + WS_RW);
    const int gw = blockIdx.x * NWAVES + wave, NGW = gridDim.x * NWAVES;
    const f32x4 mu4 = *(const f32x4*)(p.in[6] + 3072 + 4 * lane);
    for (int row = gw; row < T_TOK; row += NGW) {
        const f32x4 cu = unpack4(*(const u32x2*)(RW + (size_t)row * RW_W + 3072 + 4 * lane));
        const f32x4 z4 = {0.f, 0.f, 0.f, 0.f};
        const f32x4 pv = (row & (SEQ - 1)) ? unpack4(*(const u32x2*)(RW + (size_t)(row - 1) * RW_W + 3072 + 4 * lane)) : z4;
        f32x4 x = cu + (pv - cu) * mu4;
#pragma unroll
        for (int e = 0; e < 4; ++e) { const float th = 1.f - 2.f * fast_rcp(1.f + fast_exp2(2.f * LOG2E * x[e])), sg = sigmoidf_(x[e]); x[e] = lane < 16 ? th : (lane < 32 ? x[e] : sg); }
        *(u32x2*)(act_row(ws, (size_t)row) + 4 * lane) = pack4(x);
    }
}
__device__ __forceinline__ void rwkv_phase(const Params& p, LAS unsigned char* lds, int tid, int wave, int lane) {
    unsigned char* ws = p.ws;
    const bf16_t* RW = (const bf16_t*)(ws + WS_RW); bf16_t* Y = (bf16_t*)(ws + WS_Y);
    const int gidx = wave >> 2, wv = wave & 3, L = wv * 64 + lane;
    LAS unsigned char* gb = lds + gidx * RWG_BYTES;
    const int fr = lane & 15, g = lane >> 4;
    const int tk = L >> 4, cg = L & 15;
    const float* mu = p.in[6];
#if TABLES_LATE
    peer_tables_lowp(p, wave, lane);
#endif
#pragma unroll 1
    for (int pp = blockIdx.x; pp < BATCH * 16 / 2; pp += gridDim.x) {
        const int pair = pp * 2 + gidx, b = pair >> 4, h = pair & 15;
        __syncthreads();
        if (L < 64) { LAS float* C = (LAS float*)(gb + RW_C); const int c = h * 64 + L;
            C[0 * 64 + L] = mu[c]; C[1 * 64 + L] = mu[1024 + c]; C[2 * 64 + L] = mu[2048 + c]; C[3 * 64 + L] = p.in[12][c]; C[4 * 64 + L] = p.in[13][c];
            C[5 * 64 + L] = p.in[14][c]; C[6 * 64 + L] = p.in[15][c]; C[7 * 64 + L] = p.in[16][c]; C[8 * 64 + L] = p.in[7][c]; C[9 * 64 + L] = p.in[9][c]; }
        for (int i = L; i < 2 * 16 * CK_TSTR / 4; i += 256) ((LAS unsigned*)(gb + RW_GA))[i] = 0u;
        bf16x8 wf[8];
        {   const bf16_t* W2 = (const bf16_t*)(ws + WS_W2T) + (size_t)(h * 64 + 16 * wv + fr) * 64 + 8 * g; const bf16_t* A2 = (const bf16_t*)(ws + WS_A2T) + (size_t)(h * 64 + 16 * wv + fr) * 64 + 8 * g;
            const bf16_t* G2 = (const bf16_t*)(ws + WS_G2T) + (size_t)(h * 64 + 16 * wv + fr) * 128 + 8 * g;
#pragma unroll
            for (int ks = 0; ks < 2; ++ks) { wf[ks] = *(const bf16x8*)(W2 + 32 * ks); wf[2 + ks] = *(const bf16x8*)(A2 + 32 * ks); }
#pragma unroll
            for (int ks = 0; ks < 4; ++ks) wf[4 + ks] = *(const bf16x8*)(G2 + 32 * ks); }
        f32x4 M[4];
#pragma unroll
        for (int kt = 0; kt < 4; ++kt) M[kt] = (f32x4){0.f, 0.f, 0.f, 0.f};
        const bf16_t* rwb = RW + (size_t)b * SEQ * RW_W;
        u32x4 p1c[8]; u32x2 p2c[3], p2p[3];
#define RW_PREF1(T0) do { const int tq_ = (T0) + fr < SEQ ? (T0) + fr : SEQ - 1; const bf16_t* ar_ = act_row(ws, (size_t)b * SEQ + tq_) + 8 * g; \
            _Pragma("unroll") for (int ks = 0; ks < 8; ++ks) p1c[ks] = *(const u32x4*)(ar_ + 32 * ks); } while (0)
#define RW_PREF2(T0) do { const int u_ = (T0) + tk < SEQ ? (T0) + tk : SEQ - 1, up_ = u_ > 0 ? u_ - 1 : 0; \
            _Pragma("unroll") for (int q = 0; q < 3; ++q) { p2c[q] = *(const u32x2*)(rwb + (size_t)u_ * RW_W + 1024 * q + h * 64 + 4 * cg); p2p[q] = *(const u32x2*)(rwb + (size_t)up_ * RW_W + 1024 * q + h * 64 + 4 * cg); } } while (0)
        RW_PREF1(0); RW_PREF2(0);
        LBAR();
#pragma unroll 1
        for (int ci = -1; ci < SEQ / 16; ++ci) {
            const int cn = ci + 1; const bool has_n = cn < SEQ / 16, has_c = ci >= 0;
            if (has_n) {
            {   f32x4 aw = lds4(gb + RW_C + 8 * 256 + (16 * wv + 4 * g) * 4), aa = lds4(gb + RW_C + 9 * 256 + (16 * wv + 4 * g) * 4), ag = (f32x4){0.f, 0.f, 0.f, 0.f};
#pragma unroll
                for (int ks = 0; ks < 2; ++ks) { aw = MFMA16(wf[ks], __builtin_bit_cast(bf16x8, p1c[ks]), aw); aa = MFMA16(wf[2 + ks], __builtin_bit_cast(bf16x8, p1c[2 + ks]), aa); }
#pragma unroll
                for (int ks = 0; ks < 4; ++ks) ag = MFMA16(wf[4 + ks], __builtin_bit_cast(bf16x8, p1c[4 + ks]), ag);
                f32x4 ow, oa;
#pragma unroll
                for (int r = 0; r < 4; ++r) { ow[r] = prefix16(-0.8750387749145276f * sigmoidf_(aw[r])); oa[r] = sigmoidf_(aa[r]); }
                const int o_ = fr * 256 + (16 * wv + 4 * g) * 4;
                *(LAS f32x4*)(gb + RW_LAM + o_) = ow; *(LAS f32x4*)(gb + RW_A + o_) = oa; *(LAS f32x4*)(gb + RW_G + (cn & 1) * 4096 + o_) = ag;
            }
            }
            RW_PREF1(16 * cn + 16);
            if (has_c) {
            {   bf16x8 mf[2];
#pragma unroll
                for (int ks = 0; ks < 2; ++ks) { u32x4 w; w.x = pk_bf16(M[2 * ks][0], M[2 * ks][1]); w.y = pk_bf16(M[2 * ks][2], M[2 * ks][3]); w.z = pk_bf16(M[2 * ks + 1][0], M[2 * ks + 1][1]); w.w = pk_bf16(M[2 * ks + 1][2], M[2 * ks + 1][3]);
                    mf[ks] = __builtin_bit_cast(bf16x8, w); }
                f32x4 x1 = (f32x4){0.f, 0.f, 0.f, 0.f}, x2 = x1;
#pragma unroll
                for (int ks = 0; ks < 2; ++ks) { x1 = MFMA16(frag2(gb + RW_AT + fr * CK_STR + (32 * ks + 4 * g) * 2, 32), mf[ks], x1); x2 = MFMA16(frag2(gb + RW_RT + fr * CK_STR + (32 * ks + 4 * g) * 2, 32), mf[ks], x2); }
                const u32x2 vfr = *(const LAS u32x2*)(gb + RW_VT + (16 * wv + fr) * CK_VSTR + 8 * g);
                f32x4 nt[15];
#pragma unroll
                for (int sc = 0; sc < 15; ++sc) nt[sc] = lds4(gb + RW_NN + sc * 64 + g * 16);
                const bf16x8 ga_r = *(const LAS bf16x8*)(gb + RW_GA + fr * CK_TSTR + 16 * g), ga_o = *(const LAS bf16x8*)(gb + RW_GA + 16 * CK_TSTR + fr * CK_TSTR + 16 * g);
                { const u32x4 w = {0u, 0u, vfr.x, vfr.y}; x1 = MFMA16(ga_r, __builtin_bit_cast(bf16x8, w), x1); }
                float u[4] = {x1[0], x1[1], x1[2], x1[3]};
#pragma unroll
                for (int sc = 0; sc < 15; ++sc) {
                    const auto a_ = __builtin_amdgcn_permlane32_swap(__float_as_uint(u[sc & 3]), __float_as_uint(u[sc & 3]), false, false); const unsigned y_ = (sc >> 2) >= 2 ? a_[1] : a_[0];
                    const auto b_ = __builtin_amdgcn_permlane16_swap(y_, y_, false, false); const float ub = __uint_as_float(((sc >> 2) & 1) ? b_[1] : b_[0]);
#pragma unroll
                    for (int r = 0; r < 4; ++r) u[r] = fmaf(nt[sc][r], ub, u[r]); }
                const u32x4 uvw = {pk_bf16(u[0], u[1]), pk_bf16(u[2], u[3]), vfr.x, vfr.y}; const bf16x8 uv1 = __builtin_bit_cast(bf16x8, uvw);
                x2 = MFMA16(ga_o, uv1, x2);
#pragma unroll
                for (int r = 0; r < 4; ++r) *(LAS float*)(gb + RW_O + (4 * g + r) * 256 + (16 * wv + fr) * 4) = x2[r];
#pragma unroll
                for (int kt = 0; kt < 4; ++kt) { M[kt] = MFMA16(*(const LAS bf16x8*)(gb + RW_BKT + (16 * kt + fr) * CK_TSTR + 16 * g), uv1, M[kt]); M[kt] = M[kt] * lds4(gb + RW_GC + (16 * kt + 4 * g) * 4); }
            }
            }
            LBAR();
            if (has_n) {
            {   LAS const unsigned char* C = gb + RW_C + cg * 16; const bool first = (16 * cn + tk) == 0;
                const f32x4 rc = unpack4(p2c[0]), kc = unpack4(p2c[1]), vc = unpack4(p2c[2]);
                const f32x4 z4 = {0.f, 0.f, 0.f, 0.f};
                const f32x4 rp = first ? z4 : unpack4(p2p[0]), kp_ = first ? z4 : unpack4(p2p[1]), vp = first ? z4 : unpack4(p2p[2]);
                const f32x4 rs = rc + (rp - rc) * lds4(C), ksh = kc + (kp_ - kc) * lds4(C + 256), vs = vc + (vp - vc) * lds4(C + 512);
                const f32x4 a = lds4(gb + RW_A + tk * 256 + cg * 16);
                f32x4 kk = ksh * lds4(C + 768);
                const float ss = sum16((kk[0] * kk[0] + kk[1] * kk[1]) + (kk[2] * kk[2] + kk[3] * kk[3]));
                kk = kk * (1.f / fmaxf(sqrtf(ss), 1e-12f));
                const f32x4 kpv = ksh * (1.f + (a - 1.f) * lds4(C + 1024));
                const f32x4 rkk = rs * kpv * lds4(C + 1280);
                const float bon = sum16((rkk[0] + rkk[1]) + (rkk[2] + rkk[3]));
                const f32x4 lam = lds4(gb + RW_LAM + tk * 256 + cg * 16), lamp = tk > 0 ? lds4(gb + RW_LAM + (tk - 1) * 256 + cg * 16) : z4;
                f32x4 gm, gp, gi;
#pragma unroll
                for (int e = 0; e < 4; ++e) { gm[e] = fast_exp2(lam[e]); gp[e] = fast_exp2(lamp[e]); gi[e] = fast_exp2(-lam[e]); }
                const f32x4 At = -kk * gp, Rt = rs * gm, Bt = kk * a * gi, Kt = kpv * gi;
                const int ro = tk * CK_STR + cg * 8;
                *(LAS u32x2*)(gb + RW_AT + ro) = pack4(At); *(LAS u32x2*)(gb + RW_RT + ro) = pack4(Rt); *(LAS u32x2*)(gb + RW_BT + ro) = pack4(Bt); *(LAS u32x2*)(gb + RW_KT + ro) = pack4(Kt);
#pragma unroll
                for (int e = 0; e < 4; ++e) { LAS unsigned char* q = gb + RW_BKT + (4 * cg + e) * CK_TSTR + (8 * (tk >> 2) + (tk & 3)) * 2;
                    *(LAS bf16_t*)q = bf16_of(Bt[e]); *(LAS bf16_t*)(q + 8) = bf16_of(Kt[e]); *(LAS bf16_t*)(gb + RW_VT + (4 * cg + e) * CK_VSTR + tk * 2) = bf16_of(vs[e]); }
                *(LAS f32x4*)(gb + RW_V + (cn & 1) * 4096 + tk * 256 + cg * 16) = vs;
                if (tk == 15) *(LAS f32x4*)(gb + RW_GC + cg * 16) = gm;
                if (cg == 0) *(LAS float*)(gb + RW_BON + (cn & 1) * 64 + tk * 4) = bon; }
            }
            RW_PREF2(16 * cn + 16);
            if (has_c) {
            {   LAS const unsigned char* C = gb + RW_C + cg * 16; const int o_ = tk * 256 + cg * 16;
                const f32x4 o = lds4(gb + RW_O + o_);
                const float mean = sum16((o[0] + o[1]) + (o[2] + o[3])) * (1.f / 64.f);
                const f32x4 d = o - mean;
                const float var = sum16((d[0] * d[0] + d[1] * d[1]) + (d[2] * d[2] + d[3] * d[3])) * (1.f / 64.f);
                const f32x4 on = d * (1.f / sqrtf(var + 64e-5f)) * lds4(C + 1536) + lds4(C + 1792);
                const f32x4 vs = lds4(gb + RW_V + (ci & 1) * 4096 + o_); const float bon = *(const LAS float*)(gb + RW_BON + (ci & 1) * 64 + tk * 4);
                const f32x4 gg = lds4(gb + RW_G + (ci & 1) * 4096 + o_);
                const f32x4 y = (on + vs * bon) * gg;
                *(u32x2*)(Y + ((size_t)b * SEQ + 16 * ci + tk) * D_MODEL + h * 64 + 4 * cg) = pack4(y); }
            }
            LBAR();
            if (has_n) {
            {   LAS const unsigned char* Xa = gb + (wv < 2 ? RW_AT : RW_RT) + fr * CK_STR + 16 * g; LAS const unsigned char* Yb = gb + ((wv & 1) ? RW_KT : RW_BT) + fr * CK_STR + 16 * g;
                f32x4 d = (f32x4){0.f, 0.f, 0.f, 0.f};
#pragma unroll
                for (int ks = 0; ks < 2; ++ks) d = MFMA16(*(const LAS bf16x8*)(Xa + 64 * ks), *(const LAS bf16x8*)(Yb + 64 * ks), d);
                f32x4 dm;
#pragma unroll
                for (int r = 0; r < 4; ++r) { const int t = 4 * g + r; const bool keep = wv < 2 ? (fr < t) : (fr <= t); dm[r] = keep ? d[r] : 0.f; }
                if (wv == 0) *(LAS f32x4*)(gb + RW_NN + fr * 64 + g * 16) = dm;
                else {
#pragma unroll
                    for (int r = 0; r < 4; ++r) *(LAS bf16_t*)(gb + RW_GA + (wv == 1 ? 0 : 16 * CK_TSTR) + (4 * g + r) * CK_TSTR + (8 * (fr >> 2) + (fr & 3) + (wv == 2 ? 0 : 4)) * 2) = bf16_of(dm[r]); } }
            }
            LBAR();
        }
#undef RW_PREF1
#undef RW_PREF2
    }
    __syncthreads();
}
#define MFMA32(a, b, c) __builtin_amdgcn_mfma_f32_32x32x16_bf16((a), (b), (c), 0, 0, 0)
constexpr int PK_STR = 272, PK2_OFF = 128 * PK_STR;
__device__ __forceinline__ void ce_(float& a, float& b) { const float hi = fmaxf(a, b), lo = fminf(a, b); a = hi; b = lo; }
template <int LO, int N, int R> __device__ __forceinline__ void oe_merge(float (&v)[16]) {
    constexpr int M = R * 2;
    if constexpr (M < N) { oe_merge<LO, N, M>(v); oe_merge<LO + R, N, M>(v);
#pragma unroll
        for (int i = LO + R; i + R < LO + N; i += M) ce_(v[i], v[i + R]); }
    else ce_(v[LO], v[LO + R]);
}
template <int LO, int N> __device__ __forceinline__ void oe_sort(float (&v)[16]) {
    if constexpr (N > 1) { oe_sort<LO, N / 2>(v); oe_sort<LO + N / 2, N / 2>(v); oe_merge<LO, N, 1>(v); }
}
__device__ __forceinline__ void merge_top16(float (&a)[16], const float (&b)[16]) {
#pragma unroll
    for (int i = 0; i < 16; ++i) a[i] = fmaxf(a[i], b[15 - i]);
#pragma unroll
    for (int st = 8; st >= 1; st >>= 1)
#pragma unroll
        for (int i = 0; i < 16; ++i) if ((i & st) == 0) ce_(a[i], a[i + st]);
}
__device__ __forceinline__ void topk_side(float (&Lst)[16], const bf16_t* qptr, LAS const unsigned char* Kimg, int c, int hh) {
    f32x16 acc[4];
#pragma unroll
    for (int kt = 0; kt < 4; ++kt)
#pragma unroll
        for (int i = 0; i < 16; ++i) acc[kt][i] = 0.f;
#pragma unroll
    for (int ks = 0; ks < 8; ++ks) { const bf16x8 bq = *(const bf16x8*)(qptr + 16 * ks + 8 * hh);
#pragma unroll
        for (int kt = 0; kt < 4; ++kt) { const bf16x8 ak = *(const LAS bf16x8*)(Kimg + (32 * kt + c) * PK_STR + (16 * ks + 8 * hh) * 2); acc[kt] = MFMA32(ak, bq, acc[kt]); } }
    float g1[16], g2[16], g3[16];
#pragma unroll
    for (int i = 0; i < 16; ++i) { const unsigned idx = (unsigned)((i & 3) + 8 * (i >> 2)) + 4u * (unsigned)hh;
        Lst[i] = __uint_as_float((__float_as_uint(acc[0][i]) & 0xFFFFFF80u) | idx); g1[i] = __uint_as_float((__float_as_uint(acc[1][i]) & 0xFFFFFF80u) | (idx + 32u));
        g2[i] = __uint_as_float((__float_as_uint(acc[2][i]) & 0xFFFFFF80u) | (idx + 64u)); g3[i] = __uint_as_float((__float_as_uint(acc[3][i]) & 0xFFFFFF80u) | (idx + 96u)); }
    oe_sort<0, 16>(Lst); oe_sort<0, 16>(g1); oe_sort<0, 16>(g2); oe_sort<0, 16>(g3);
    merge_top16(Lst, g1); merge_top16(g2, g3); merge_top16(Lst, g2);
    float oth[16];
#pragma unroll
    for (int q = 0; q < 16; ++q) { auto r = __builtin_amdgcn_permlane32_swap(__float_as_uint(Lst[q]), __float_as_uint(Lst[q]), false, false); oth[q] = __uint_as_float(hh ? r[0] : r[1]); }
    merge_top16(Lst, oth);
}
__device__ __forceinline__ void peer_route_stage_keys(const Params& p, LAS unsigned char* lds, int tid) {
    unsigned char* ws = p.ws;
    __syncthreads();
    for (int idx = tid; idx < 2 * 128 * 16; idx += NTHREADS) { const int which = idx >> 11, rem = idx & 2047, key = rem >> 4, cc = rem & 15;
        *(LAS u32x4*)(lds + which * PK2_OFF + key * PK_STR + 16 * cc) = ((const u32x4*)(ws + (which ? WS_PK2 : WS_PK1)))[key * 16 + cc]; }
    __syncthreads();
}
__device__ __forceinline__ void peer_route_task(const Params& p, LAS unsigned char* lds, int task, int lane) {
    unsigned char* ws = p.ws; const bf16_t* PQ = (const bf16_t*)(ws + WS_PQ); int* RE = (int*)(ws + WS_RE); float* RS = (float*)(ws + WS_RS);
    const int c = lane & 31, hh = lane >> 5;
    {
        const size_t row = (size_t)task * 32 + c; const bf16_t* qptr = PQ + row * 256;
        float L1[16], L2[16];
        topk_side(L1, qptr, lds, c, hh);
        topk_side(L2, qptr + 128, lds + PK2_OFF, c, hh);
        float v1[16], v2[16];
#pragma unroll
        for (int q = 0; q < 16; ++q) { v1[q] = __uint_as_float(__float_as_uint(L1[q]) & 0xFFFFFF80u); v2[q] = __uint_as_float(__float_as_uint(L2[q]) & 0xFFFFFF80u); }
        float Tt[16], T1[16];
        {   float cand[64]; int nc = 0;
#pragma unroll
            for (int i = 0; i < 16; ++i)
#pragma unroll
                for (int j = 0; j < 16; ++j) if ((i + 1) * (j + 1) <= 16) { cand[nc] = v1[i] + v2[j]; ++nc; }
#pragma unroll
            for (int q = 0; q < 16; ++q) { Tt[q] = hh ? cand[32 + q] : cand[q]; T1[q] = hh ? ((48 + q < 50) ? cand[48 + q] : -3.0e38f) : cand[16 + q]; } }
        oe_sort<0, 16>(Tt); oe_sort<0, 16>(T1);
        merge_top16(Tt, T1);
        {   float oth[16];
#pragma unroll
            for (int q = 0; q < 16; ++q) { auto r = __builtin_amdgcn_permlane32_swap(__float_as_uint(Tt[q]), __float_as_uint(Tt[q]), false, false); oth[q] = __uint_as_float(hh ? r[0] : r[1]); }
            merge_top16(Tt, oth); }
        const float tau = Tt[15];
        int cnt = 0;
#pragma unroll
        for (int i = 0; i < 16; ++i)
#pragma unroll
            for (int j = 0; j < 16; ++j) if ((i + 1) * (j + 1) <= 16) { const float sm = v1[i] + v2[j];
                if (sm >= tau && cnt < 16 && hh == 0) { const int e = (int)((__float_as_uint(L1[i]) & 127u) * 128u + (__float_as_uint(L2[j]) & 127u)); RE[row * 16 + cnt] = e; RS[row * 16 + cnt] = sm; ++cnt; } }
    }
}
__device__ __forceinline__ void peer_route_phase(const Params& p, LAS unsigned char* lds, int tid, int wave, int lane) {
    peer_route_stage_keys(p, lds, tid);
#pragma unroll 1
    for (int task = blockIdx.x * NWAVES + wave; task < T_TOK / 4; task += gridDim.x * NWAVES) peer_route_task(p, lds, task, lane);
}
__device__ __forceinline__ float gelu_erf(float v) {
    const float av = fabsf(v), t = fast_rcp(av * 0.2316418882f + 1.0f);
    float q = t * 0.5307027145f + (-0.7265760135f); q = q * t + 0.7107068705f; q = q * t + (-0.142248368f); q = q * t + 0.127414796f; q = q * t;
    const float e = fast_exp2(v * v * (-0.72134752044f)); const float m = v * (q * e);
    return v < 0.f ? m : v - m;
}
__device__ __forceinline__ void unpack_fp8x16(const u32x4 w, float (&o)[16]) {
#pragma unroll
    for (int q = 0; q < 4; ++q) { const f32x2 lo = __builtin_amdgcn_cvt_pk_f32_fp8((int)w[q], false), hi = __builtin_amdgcn_cvt_pk_f32_fp8((int)w[q], true);
        o[4 * q] = lo.x; o[4 * q + 1] = lo.y; o[4 * q + 2] = hi.x; o[4 * q + 3] = hi.y; }
}
__device__ __forceinline__ float wave_prefix_incl(float x) {
    x = prefix16(x);
    const float t0 = __builtin_bit_cast(float, __builtin_amdgcn_readlane(__builtin_bit_cast(int, x), 15)), t1 = __builtin_bit_cast(float, __builtin_amdgcn_readlane(__builtin_bit_cast(int, x), 31)),
                t2 = __builtin_bit_cast(float, __builtin_amdgcn_readlane(__builtin_bit_cast(int, x), 47));
    const int row = (int)(__builtin_amdgcn_mbcnt_hi(~0u, __builtin_amdgcn_mbcnt_lo(~0u, 0u)) >> 4);
    return x + (row >= 1 ? t0 : 0.f) + (row >= 2 ? t1 : 0.f) + (row >= 3 ? t2 : 0.f);
}
template <class BarT> __device__ __forceinline__ void bar_sync(const BarT& b);
#ifndef GNT
#define GNT 2
#endif
#ifndef GATHER_SPLIT
#define GATHER_SPLIT 0
#endif

#ifndef GATHER_PROBE_LOADS
#define GATHER_PROBE_LOADS 0
#endif
#ifndef GATHER_PROBE2
#define GATHER_PROBE2 0
#endif
#ifndef VSET
#define VSET 4
#endif
#ifndef VBUF4
#define VBUF4 0
#endif
#ifndef UBUF4
#define UBUF4 0
#endif
#ifndef PEER_FUSED
#define PEER_FUSED 0
#endif
template <class BarT> __device__ __forceinline__ void bar_sync(const BarT& b);
template <class BarT> __device__ __forceinline__ void peer_gather_phase(const Params& p, LAS unsigned char* lds, int wave, int lane, float amp, const BarT& bar) {
    unsigned char* ws = p.ws; const bf16_t* H = (const bf16_t*)(ws + WS_H); const unsigned char* PU = ws + WS_PU; const unsigned char* PV = ws + WS_PV;
    const int* RE = (const int*)(ws + WS_RE); const float* RS = (const float*)(ws + WS_RS);
    const int gw = blockIdx.x * NWAVES + wave, NGW = gridDim.x * NWAVES;
    const float* gf = p.in[29] + 16 * lane;
#if PEER_FUSED
    LAS unsigned char* wb = lds + 2 * PK2_OFF + wave * (512 + 4096); LAS unsigned* cnt = (LAS unsigned*)wb; LAS unsigned char* lst = wb + 512;
    peer_route_stage_keys(p, lds, (int)(wave * 64 + lane));
#else
    LAS unsigned char* wb = lds + wave * (512 + 4096 + 8192); LAS unsigned* cnt = (LAS unsigned*)wb; LAS unsigned char* lst = wb + 512; LAS unsigned char* hxl = wb + 512 + 4096 + lane * 32;
#endif
    __syncthreads();
    const f32x4 g0 = *(const f32x4*)(gf), g1 = *(const f32x4*)(gf + 4), g2 = *(const f32x4*)(gf + 8), g3 = *(const f32x4*)(gf + 12);
    const int ngroups = (T_TOK + GNT - 1) / GNT, nrounds = (ngroups + NGW - 1) / NGW;
#pragma unroll 1
    for (int rnd = 0; rnd < nrounds; ++rnd) {
        const int tok0 = (rnd * NGW + gw) * GNT;
#if GATHER_SYNC
        if (rnd > 0 && (rnd % GATHER_SYNC) == 0) bar_sync(bar);
#endif
#if PEER_FUSED
        if (tok0 < T_TOK) peer_route_task(p, lds, tok0 >> 2, lane);
        asm volatile("s_waitcnt vmcnt(0)" ::: "memory");
#endif
#if PEER_FUSED
#define GS_KEEP(S) do { } while (0)
#else
#define GS_KEEP(S) do { *(LAS u32x4*)(hxl + S * 2048) = xa; *(LAS u32x4*)(hxl + S * 2048 + 16) = xb; } while (0)
#endif
#if GATHER_UI4
#define GS_DECL(S) float ac##S[16]; float c1_##S; float hs_##S
#define GS_AMAX(S) do { float am_ = 0.f; _Pragma("unroll") for (int j = 0; j < 16; ++j) am_ = fmaxf(am_, fabsf(hx_[j])); \
            hs_##S = 119.f / fmaxf(xrow_max(max16(am_)), 1e-20f); c1_##S = c1_##S * (512.f / PU_QS) / hs_##S; } while (0)
#else
#define GS_DECL(S) float ac##S[16]; float c1_##S
#define GS_AMAX(S) do { } while (0)
#endif
#define GS_HX(XA, XB) float hx_[16]; hx_[0] = bf_lo(XA.x); hx_[1] = bf_hi(XA.x); hx_[2] = bf_lo(XA.y); hx_[3] = bf_hi(XA.y); hx_[4] = bf_lo(XA.z); hx_[5] = bf_hi(XA.z); hx_[6] = bf_lo(XA.w); hx_[7] = bf_hi(XA.w); \
            hx_[8] = bf_lo(XB.x); hx_[9] = bf_hi(XB.x); hx_[10] = bf_lo(XB.y); hx_[11] = bf_hi(XB.y); hx_[12] = bf_lo(XB.z); hx_[13] = bf_hi(XB.z); hx_[14] = bf_lo(XB.w); hx_[15] = bf_hi(XB.w)
#define GS_SETUP(S) do { const int t_ = tok0 + S < T_TOK ? tok0 + S : T_TOK - 1; \
            const u32x4 xa = *(const u32x4*)(H + (size_t)t_ * D_MODEL + 16 * lane), xb = *(const u32x4*)(H + (size_t)t_ * D_MODEL + 16 * lane + 8); \
            GS_KEEP(S); GS_HX(xa, xb); \
            float ss_ = 0.f; _Pragma("unroll") for (int j = 0; j < 16; ++j) { ss_ = fmaf(hx_[j], hx_[j], ss_); ac##S[j] = 0.f; } \
            c1_##S = (1.f / 512.f) / sqrtf(wave_sum(ss_) * (1.f / D_MODEL) + RMS_EPS); \
            GS_AMAX(S); \
            const int e0_ = RE[(size_t)t_ * 128 + lane], e1_ = RE[(size_t)t_ * 128 + 64 + lane]; const float s0_ = RS[(size_t)t_ * 128 + lane], s1_ = RS[(size_t)t_ * 128 + 64 + lane]; \
            const float p0_ = fast_exp2((s0_ - max16(s0_)) * LOG2E), p1_ = fast_exp2((s1_ - max16(s1_)) * LOG2E); \
            const float gt0_ = p0_ / sum16(p0_) * (1.f / PV_SCALE), gt1_ = p1_ / sum16(p1_) * (1.f / PV_SCALE); \
            cnt[lane] = 0u; LDS_WAIT(); \
            const unsigned r0_ = __hip_atomic_fetch_add(cnt + (e0_ >> 8), 1u, __ATOMIC_RELAXED, __HIP_MEMORY_SCOPE_WAVEFRONT), r1_ = __hip_atomic_fetch_add(cnt + (e1_ >> 8), 1u, __ATOMIC_RELAXED, __HIP_MEMORY_SCOPE_WAVEFRONT); \
            LDS_WAIT(); \
            { const float cf_ = (float)cnt[lane]; const float incl_ = wave_prefix_incl(cf_); LDS_WAIT(); cnt[lane] = (unsigned)(incl_ - cf_); LDS_WAIT(); } \
            { LAS u32x2* list_ = (LAS u32x2*)(lst + S * 1024); list_[cnt[e0_ >> 8] + r0_] = (u32x2){(unsigned)e0_, __float_as_uint(gt0_)}; list_[cnt[e1_ >> 8] + r1_] = (u32x2){(unsigned)e1_, __float_as_uint(gt1_)}; } \
            LDS_WAIT(); } while (0)
#define GS_FIN(S) do { const u32x4 xa = *(const LAS u32x4*)(hxl + S * 2048), xb = *(const LAS u32x4*)(hxl + S * 2048 + 16); GS_HX(xa, xb); float s3_ = 0.f; _Pragma("unroll") for (int j = 0; j < 16; ++j) { hx_[j] = fmaf(amp, ac##S[j], hx_[j]); s3_ = fmaf(hx_[j], hx_[j], s3_); } \
            const float r3_ = 1.f / sqrtf(wave_sum(s3_) * (1.f / D_MODEL) + RMS_EPS); float* orow = p.out + (size_t)(tok0 + S) * D_MODEL + 16 * lane; if (tok0 + S < T_TOK) { \
            *(f32x4*)(orow) = (f32x4){hx_[0], hx_[1], hx_[2], hx_[3]} * r3_ * g0; *(f32x4*)(orow + 4) = (f32x4){hx_[4], hx_[5], hx_[6], hx_[7]} * r3_ * g1; \
            *(f32x4*)(orow + 8) = (f32x4){hx_[8], hx_[9], hx_[10], hx_[11]} * r3_ * g2; *(f32x4*)(orow + 12) = (f32x4){hx_[12], hx_[13], hx_[14], hx_[15]} * r3_ * g3; } } while (0)
#define G_LOAD(X, S, C) do { _Pragma("unroll") for (int i = 0; i < 4; ++i) { const size_t e_ = (size_t)(unsigned)__builtin_amdgcn_readfirstlane((int)((const LAS u32x2*)(lst + S * 1024))[4 * (C) + i].x); \
            X##u[i] = *(const u32x4*)(PU + e_ * D_MODEL + 16 * lane); X##v[i] = *(const u32x4*)(PV + e_ * D_MODEL + 16 * lane); } } while (0)
#define G_PROC(X, S, C) do { float pd_[4]; const u32x4 xa = *(const LAS u32x4*)(hxl + S * 2048), xb = *(const LAS u32x4*)(hxl + S * 2048 + 16); GS_HX(xa, xb); \
            _Pragma("unroll") for (int i = 0; i < 4; ++i) { float uf[16]; unpack_fp8x16(X##u[i], uf); float da = uf[0] * hx_[0], db = uf[1] * hx_[1]; \
                _Pragma("unroll") for (int j = 2; j < 16; j += 2) { da = fmaf(uf[j], hx_[j], da); db = fmaf(uf[j + 1], hx_[j + 1], db); } pd_[i] = da + db; } \
              \
            const auto s01_ = __builtin_amdgcn_permlane32_swap(__float_as_uint(pd_[0]), __float_as_uint(pd_[1]), false, false); const float r01_ = __uint_as_float(s01_[0]) + __uint_as_float(s01_[1]); \
            const auto s23_ = __builtin_amdgcn_permlane32_swap(__float_as_uint(pd_[2]), __float_as_uint(pd_[3]), false, false); const float r23_ = __uint_as_float(s23_[0]) + __uint_as_float(s23_[1]); \
            const auto sq_ = __builtin_amdgcn_permlane16_swap(__float_as_uint(r01_), __float_as_uint(r23_), false, false); const float dsum_ = sum16(__uint_as_float(sq_[0]) + __uint_as_float(sq_[1])); \
            const float q0_ = __uint_as_float(((const LAS u32x2*)(lst + S * 1024))[4 * (C)].y), q1_ = __uint_as_float(((const LAS u32x2*)(lst + S * 1024))[4 * (C) + 1].y), \
                        q2_ = __uint_as_float(((const LAS u32x2*)(lst + S * 1024))[4 * (C) + 2].y), q3_ = __uint_as_float(((const LAS u32x2*)(lst + S * 1024))[4 * (C) + 3].y); \
            const float gsel_ = lane < 16 ? q0_ : (lane < 32 ? q2_ : (lane < 48 ? q1_ : q3_)); \
            const float wvec_ = gelu_erf(dsum_ * c1_##S) * gsel_; float w_[4]; \
            w_[0] = __builtin_bit_cast(float, __builtin_amdgcn_readlane(__builtin_bit_cast(int, wvec_), 0)); w_[2] = __builtin_bit_cast(float, __builtin_amdgcn_readlane(__builtin_bit_cast(int, wvec_), 16)); \
            w_[1] = __builtin_bit_cast(float, __builtin_amdgcn_readlane(__builtin_bit_cast(int, wvec_), 32)); w_[3] = __builtin_bit_cast(float, __builtin_amdgcn_readlane(__builtin_bit_cast(int, wvec_), 48)); \
            _Pragma("unroll") for (int i = 0; i < 4; ++i) { float vf[16]; unpack_fp8x16(X##v[i], vf); _Pragma("unroll") for (int j = 0; j < 16; ++j) ac##S[j] = fmaf(w_[i], vf[j], ac##S[j]); } } while (0)
        u32x4 Au[4], Av[4], Bu[4], Bv[4];
#if GNT == 2
        GS_DECL(0); GS_DECL(1); GS_SETUP(0); GS_SETUP(1);
        G_LOAD(A, 0, 0);
#pragma unroll 1
        for (int c = 0; c < 32; ++c) {
            G_LOAD(B, 1, c); G_PROC(A, 0, c);
            if (c < 31) G_LOAD(A, 0, c + 1);
            G_PROC(B, 1, c);
        }
        GS_FIN(0); GS_FIN(1);
#elif GNT == 3
        GS_DECL(0); GS_DECL(1); GS_DECL(2); GS_SETUP(0); GS_SETUP(1); GS_SETUP(2);
        G_LOAD(A, 0, 0);
#pragma unroll 1
        for (int c = 0; c < 32; c += 2) {
            G_LOAD(B, 1, c); G_PROC(A, 0, c);
            G_LOAD(A, 2, c); G_PROC(B, 1, c);
            G_LOAD(B, 0, c + 1); G_PROC(A, 2, c);
            G_LOAD(A, 1, c + 1); G_PROC(B, 0, c + 1);
            G_LOAD(B, 2, c + 1); G_PROC(A, 1, c + 1);
            if (c < 30) G_LOAD(A, 0, c + 2);
            G_PROC(B, 2, c + 1);
        }
        GS_FIN(0); GS_FIN(1); GS_FIN(2);
#elif GNT == 4 && GATHER_SPLIT
        GS_DECL(0); GS_DECL(1); GS_DECL(2); GS_DECL(3); GS_SETUP(0); GS_SETUP(1); GS_SETUP(2); GS_SETUP(3);
#if GATHER_UI4
        {   u32x4 Ar[8], Br[8];
            const int un = lane & 31, uh = lane >> 5; const auto rsU = __builtin_amdgcn_make_buffer_rsrc((void*)PU, 0, N_EXPERTS * PU_ROWB, 0x00020000); const unsigned uoff = 16u * (unsigned)un;
#if PEER_FUSED
#define U_HROW(S) const u32x4* hr_ = (const u32x4*)(H + (size_t)(tok0 + S < T_TOK ? tok0 + S : T_TOK - 1) * D_MODEL + 32 * un)
#else
#define U_HROW(S) LAS const u32x4* hr_ = (const LAS u32x4*)(wb + 512 + 4096 + S * 2048 + 64 * un)
#endif
#define U_HQ(S) unsigned h0_##S[4], h1_##S[4]; { U_HROW(S); unsigned bb_[8]; \
                _Pragma("unroll") for (int q = 0; q < 4; ++q) { const u32x4 x_ = hr_[q]; unsigned b0_ = 0u, b1_ = 0u; \
                    b0_ = __builtin_amdgcn_cvt_pk_u8_f32(__builtin_rintf(fmaf(bf_lo(x_.x), hs_##S, 136.f)), 0, b0_); b0_ = __builtin_amdgcn_cvt_pk_u8_f32(__builtin_rintf(fmaf(bf_hi(x_.x), hs_##S, 136.f)), 1, b0_); \
                    b0_ = __builtin_amdgcn_cvt_pk_u8_f32(__builtin_rintf(fmaf(bf_lo(x_.y), hs_##S, 136.f)), 2, b0_); b0_ = __builtin_amdgcn_cvt_pk_u8_f32(__builtin_rintf(fmaf(bf_hi(x_.y), hs_##S, 136.f)), 3, b0_); \
                    b1_ = __builtin_amdgcn_cvt_pk_u8_f32(__builtin_rintf(fmaf(bf_lo(x_.z), hs_##S, 136.f)), 0, b1_); b1_ = __builtin_amdgcn_cvt_pk_u8_f32(__builtin_rintf(fmaf(bf_hi(x_.z), hs_##S, 136.f)), 1, b1_); \
                    b1_ = __builtin_amdgcn_cvt_pk_u8_f32(__builtin_rintf(fmaf(bf_lo(x_.w), hs_##S, 136.f)), 2, b1_); b1_ = __builtin_amdgcn_cvt_pk_u8_f32(__builtin_rintf(fmaf(bf_hi(x_.w), hs_##S, 136.f)), 3, b1_); \
                    bb_[2 * q] = b0_ ^ 0x88888888u; bb_[2 * q + 1] = b1_ ^ 0x88888888u; } \
                _Pragma("unroll") for (int d = 0; d < 4; ++d) { h0_##S[d] = (bb_[2 * d] & 0x0f0f0f0fu) | ((bb_[2 * d + 1] & 0x0f0f0f0fu) << 4); h1_##S[d] = ((bb_[2 * d] >> 4) & 0x0f0f0f0fu) | (bb_[2 * d + 1] & 0xf0f0f0f0u); } }
            U_HQ(0); U_HQ(1); U_HQ(2); U_HQ(3);
#define U_LOAD16(X, S, C) do { _Pragma("unroll") for (int i = 0; i < 8; ++i) X##r[i] = __builtin_amdgcn_raw_buffer_load_b128(rsU, (int)(((const LAS u32x2*)(lst + (S) * 1024))[16 * (C) + 2 * i + uh].x * (unsigned)PU_ROWB + uoff), 0, 0); } while (0)
#define U_DOTB(X, S, C, BH) do { float pd_[4]; \
                _Pragma("unroll") for (int k = 0; k < 4; ++k) { const u32x4 w_ = X##r[4 * (BH) + k]; int d1_ = 0, d0_ = 0; \
                    _Pragma("unroll") for (int d = 0; d < 4; ++d) { d1_ = __builtin_amdgcn_sdot8((int)w_[d], (int)h1_##S[d], d1_, false); d0_ = __builtin_amdgcn_sdot8((int)w_[d], (int)h0_##S[d], d0_, false); } \
                    pd_[k] = (float)(16 * d1_ + d0_); } \
                const auto sa_ = __builtin_amdgcn_permlane16_swap(__float_as_uint(pd_[0]), __float_as_uint(pd_[1]), false, false); const float q0_ = __uint_as_float(sa_[0]) + __uint_as_float(sa_[1]); \
                const auto sb_ = __builtin_amdgcn_permlane16_swap(__float_as_uint(pd_[2]), __float_as_uint(pd_[3]), false, false); const float q1_ = __uint_as_float(sb_[0]) + __uint_as_float(sb_[1]); \
                const bool hi8_ = (lane & 8) != 0; const float dsum_ = sum8((hi8_ ? q1_ : q0_) + dpp<DPP_ROR8>(hi8_ ? q0_ : q1_)); \
                const int rr_ = lane >> 4; const int pi_ = 8 * (BH) + 2 * ((rr_ & 1) + (hi8_ ? 2 : 0)) + (rr_ >> 1); \
                LAS u32x2* le_ = (LAS u32x2*)(lst + (S) * 1024) + 16 * (C); \
                const float wvec_ = gelu_erf(dsum_ * c1_##S) * __uint_as_float(le_[pi_].y); \
                LDS_WAIT(); if ((lane & 7) == 0) le_[pi_].y = __float_as_uint(wvec_); } while (0)
#if UBUF4
            u32x4 Cr[8], Dr[8];
            U_LOAD16(A, 0, 0); U_LOAD16(B, 1, 0); U_LOAD16(C, 2, 0);
#pragma unroll 1
            for (int c = 0; c < 7; ++c) {
                U_LOAD16(D, 3, c); U_DOTB(A, 0, c, 0); U_DOTB(A, 0, c, 1); __builtin_amdgcn_sched_barrier(0);
                U_LOAD16(A, 0, c + 1); U_DOTB(B, 1, c, 0); U_DOTB(B, 1, c, 1); __builtin_amdgcn_sched_barrier(0);
                U_LOAD16(B, 1, c + 1); U_DOTB(C, 2, c, 0); U_DOTB(C, 2, c, 1); __builtin_amdgcn_sched_barrier(0);
                U_LOAD16(C, 2, c + 1); U_DOTB(D, 3, c, 0); U_DOTB(D, 3, c, 1); __builtin_amdgcn_sched_barrier(0);
            }
            {
                U_LOAD16(D, 3, 7); U_DOTB(A, 0, 7, 0); U_DOTB(A, 0, 7, 1); __builtin_amdgcn_sched_barrier(0);
                U_DOTB(B, 1, 7, 0); U_DOTB(B, 1, 7, 1); __builtin_amdgcn_sched_barrier(0);
                U_DOTB(C, 2, 7, 0); U_DOTB(C, 2, 7, 1); __builtin_amdgcn_sched_barrier(0);
                U_DOTB(D, 3, 7, 0); U_DOTB(D, 3, 7, 1); __builtin_amdgcn_sched_barrier(0);
            }
#else
            U_LOAD16(A, 0, 0);
#pragma unroll 1
            for (int c = 0; c < 8; ++c) {
                U_LOAD16(B, 1, c); U_DOTB(A, 0, c, 0); U_DOTB(A, 0, c, 1); __builtin_amdgcn_sched_barrier(0);
                U_LOAD16(A, 2, c); U_DOTB(B, 1, c, 0); U_DOTB(B, 1, c, 1); __builtin_amdgcn_sched_barrier(0);
                U_LOAD16(B, 3, c); U_DOTB(A, 2, c, 0); U_DOTB(A, 2, c, 1); __builtin_amdgcn_sched_barrier(0);
                if (c < 7) U_LOAD16(A, 0, c + 1);
                U_DOTB(B, 3, c, 0); U_DOTB(B, 3, c, 1); __builtin_amdgcn_sched_barrier(0);
            }
#endif
#undef U_HQ
#undef U_HROW
#undef U_LOAD16
#undef U_DOTB
#else
        {   u32x4 Ar[8], Br[8];
#define U_LOAD2(X, S0, C) do { _Pragma("unroll") for (int i = 0; i < 8; ++i) { const size_t e_ = (size_t)(unsigned)__builtin_amdgcn_readfirstlane((int)((const LAS u32x2*)(lst + ((S0) + (i >> 2)) * 1024))[4 * (C) + (i & 3)].x); \
                X##r[i] = *(const u32x4*)(PU + e_ * D_MODEL + 16 * lane); } } while (0)
#define U_HX2(S) f32x2 h2_##S[8]; { const u32x4 xa = *(const LAS u32x4*)(hxl + S * 2048), xb = *(const LAS u32x4*)(hxl + S * 2048 + 16); \
                _Pragma("unroll") for (int q = 0; q < 4; ++q) { h2_##S[q] = (f32x2){bf_lo(xa[q]), bf_hi(xa[q])}; h2_##S[4 + q] = (f32x2){bf_lo(xb[q]), bf_hi(xb[q])}; } }
            U_HX2(0); U_HX2(1); U_HX2(2); U_HX2(3);
#define U_LOAD8(X, S, C2) do { _Pragma("unroll") for (int i = 0; i < 8; ++i) { const size_t e_ = (size_t)(unsigned)__builtin_amdgcn_readfirstlane((int)((const LAS u32x2*)(lst + (S) * 1024))[8 * (C2) + i].x); \
                X##r[i] = *(const u32x4*)(PU + e_ * D_MODEL + 16 * lane); } } while (0)
#define U_DOTS8(X, S, C2) do { float pd_[8]; \
                _Pragma("unroll") for (int i = 0; i < 8; ++i) { const u32x4 w_ = X##r[i]; f32x2 d_ = __builtin_amdgcn_cvt_pk_f32_fp8((int)w_[0], false) * h2_##S[0]; \
                    d_ = __builtin_elementwise_fma(__builtin_amdgcn_cvt_pk_f32_fp8((int)w_[0], true), h2_##S[1], d_); \
                    _Pragma("unroll") for (int q = 1; q < 4; ++q) { d_ = __builtin_elementwise_fma(__builtin_amdgcn_cvt_pk_f32_fp8((int)w_[q], false), h2_##S[2 * q], d_); \
                        d_ = __builtin_elementwise_fma(__builtin_amdgcn_cvt_pk_f32_fp8((int)w_[q], true), h2_##S[2 * q + 1], d_); } pd_[i] = d_.x + d_.y; } \
                float r_[4]; _Pragma("unroll") for (int i = 0; i < 4; ++i) { const auto s_ = __builtin_amdgcn_permlane32_swap(__float_as_uint(pd_[2 * i]), __float_as_uint(pd_[2 * i + 1]), false, false); r_[i] = __uint_as_float(s_[0]) + __uint_as_float(s_[1]); } \
                const auto sa_ = __builtin_amdgcn_permlane16_swap(__float_as_uint(r_[0]), __float_as_uint(r_[1]), false, false); const float q0_ = __uint_as_float(sa_[0]) + __uint_as_float(sa_[1]); \
                const auto sb_ = __builtin_amdgcn_permlane16_swap(__float_as_uint(r_[2]), __float_as_uint(r_[3]), false, false); const float q1_ = __uint_as_float(sb_[0]) + __uint_as_float(sb_[1]); \
                const bool hi8_ = (lane & 8) != 0; const float dsum_ = sum8((hi8_ ? q1_ : q0_) + dpp<DPP_ROR8>(hi8_ ? q0_ : q1_)); \
                LAS u32x2* le_ = (LAS u32x2*)(lst + (S) * 1024) + 8 * (C2); \
                const int pi_ = (lane < 16 ? 0 : (lane < 32 ? 2 : (lane < 48 ? 1 : 3))) + (hi8_ ? 4 : 0); \
                const float wvec_ = gelu_erf(dsum_ * c1_##S) * __uint_as_float(le_[pi_].y); \
                LDS_WAIT(); if ((lane & 7) == 0) le_[pi_].y = __float_as_uint(wvec_); } while (0)
            U_LOAD8(A, 0, 0);
#pragma unroll 1
            for (int c = 0; c < 16; ++c) {
                U_LOAD8(B, 1, c); U_DOTS8(A, 0, c); __builtin_amdgcn_sched_barrier(0);
                U_LOAD8(A, 2, c); U_DOTS8(B, 1, c); __builtin_amdgcn_sched_barrier(0);
                U_LOAD8(B, 3, c); U_DOTS8(A, 2, c); __builtin_amdgcn_sched_barrier(0);
                if (c < 15) U_LOAD8(A, 0, c + 1);
                U_DOTS8(B, 3, c); __builtin_amdgcn_sched_barrier(0);
            }
#undef U_LOAD8
#undef U_DOTS8
#if GATHER_PROBE2
            {
                unsigned x_ = 0u; const int pm_ = lane & 31, pg_ = lane >> 5;
#define P2_BATCH(S, BT, KH) do { const unsigned char* rp_ = PU + (size_t)((const LAS u32x2*)(lst + (S) * 1024))[32 * (BT) + pm_].x * D_MODEL + 16 * pg_ + 512 * (KH); u32x4 t_[16]; \
                    _Pragma("unroll") for (int i = 0; i < 16; ++i) t_[i] = *(const u32x4*)(rp_ + 32 * i); \
                    _Pragma("unroll") for (int i = 0; i < 16; ++i) x_ |= (t_[i].x ^ t_[i].y) & (t_[i].z ^ t_[i].w); } while (0)
#pragma unroll 1
                for (int bt = 0; bt < 4; ++bt) { P2_BATCH(0, bt, 0); P2_BATCH(0, bt, 1); P2_BATCH(1, bt, 0); P2_BATCH(1, bt, 1); P2_BATCH(2, bt, 0); P2_BATCH(2, bt, 1); P2_BATCH(3, bt, 0); P2_BATCH(3, bt, 1); }
                asm volatile("" :: "v"(x_));
#undef P2_BATCH
            }
#endif
#undef U_LOAD2
#undef U_HX2
#endif
            LDS_WAIT();
#if GATHER_VMMA == 2
            f32x16 vc0, vc1, vc2, vc3;
#pragma unroll
            for (int t = 0; t < 16; ++t) { vc0[t] = 0.f; vc1[t] = 0.f; vc2[t] = 0.f; vc3[t] = 0.f; }
            const int vn = lane & 31, vg = lane >> 5;
            const unsigned char* PVl = PV + 16 * vn; const unsigned char* PVh = PV + 512 + 8 * vn; (void)PVl; (void)PVh;
            const auto rsV = __builtin_amdgcn_make_buffer_rsrc((void*)PV, 0, N_EXPERTS * PV_ROWB, 0x00020000); const unsigned voff1 = 16u * (unsigned)vn, voff2 = 512u + 8u * (unsigned)vn;
            const int vsel = vn >> 2, vsh = 8 * (vn & 3); const int d6 = (6 * vn) >> 5, sh6 = (6 * vn) & 31;
#if V6_DIAG_FP8
#define V6_BOP(X, S) const u32x4 d_ = X##r[i], d2_ = X##r2[i]; const i32x8g b_ = {(int)d_.x, (int)d_.y, (int)d_.z, (int)d_.w, (int)d2_.x, (int)d2_.y, (int)d2_.z, (int)d2_.w}; \
                vc##S = __builtin_amdgcn_mfma_scale_f32_32x32x64_f8f6f4(a_, b_, vc##S, 0, 0, 0, 0, 0, 0)
#else
#define V6_BOP(X, S) const u32x4 d_ = X##r[i]; const u32x2 e2_ = X##q[i]; const i32x8g b_ = {(int)d_.x, (int)d_.y, (int)d_.z, (int)d_.w, (int)e2_.x, (int)e2_.y, 0, 0}; \
                vc##S = __builtin_amdgcn_mfma_scale_f32_32x32x64_f8f6f4(a_, b_, vc##S, 0, 2, 0, 0x7f7f7f7f, 0, 0x7f7f7f7f)
#endif
            { u32x4 Ar[VSET], Br[VSET]; u32x2 Aq[VSET], Bq[VSET]; u32x4 Ar2[V6_DIAG_FP8 ? VSET : 1], Br2[V6_DIAG_FP8 ? VSET : 1];
#if VBUF4
              u32x4 Cr[VSET], Dr[VSET]; u32x2 Cq[VSET], Dq[VSET];
#endif
#if V6_DIAG_FP8
#define V_LOAD6(X, S, C) do { _Pragma("unroll") for (int i = 0; i < VSET; ++i) { const size_t ro_ = (size_t)((const LAS u32x2*)(lst + (S) * 1024))[2 * VSET * (C) + 2 * i + vg].x * 1024; \
                X##r[i] = *(const u32x4*)(PV + 32 * vn + ro_); X##r2[i] = *(const u32x4*)(PV + 32 * vn + 16 + ro_); } } while (0)
#else
#define V_LOAD6(X, S, C) do { _Pragma("unroll") for (int i = 0; i < VSET; ++i) { const unsigned ro_ = ((const LAS u32x2*)(lst + (S) * 1024))[2 * VSET * (C) + 2 * i + vg].x * (unsigned)PV_ROWB; \
                X##r[i] = __builtin_amdgcn_raw_buffer_load_b128(rsV, (int)(ro_ + voff1), 0, 0); X##q[i] = __builtin_amdgcn_raw_buffer_load_b64(rsV, (int)(ro_ + voff2), 0, 0); } } while (0)
#endif
#if V6_DIAG_FP8
#define V_MMA6(X, S, C) do { _Pragma("unroll") for (int i = 0; i < VSET; ++i) { const float w64_ = fminf(__uint_as_float(((const LAS u32x2*)(lst + (S) * 1024))[2 * VSET * (C) + 2 * i + vg].y) * (64.f * PV_SCALE), 440.f); \
                const unsigned sh_ = (unsigned)(__builtin_amdgcn_cvt_pk_fp8_f32(w64_, 0.f, 0, false) & 0xff) << vsh; \
                const i32x8g a_ = {(int)(vsel == 0 ? sh_ : 0u), (int)(vsel == 1 ? sh_ : 0u), (int)(vsel == 2 ? sh_ : 0u), (int)(vsel == 3 ? sh_ : 0u), (int)(vsel == 4 ? sh_ : 0u), (int)(vsel == 5 ? sh_ : 0u), (int)(vsel == 6 ? sh_ : 0u), (int)(vsel == 7 ? sh_ : 0u)}; \
                V6_BOP(X, S); } } while (0)
#else
#define V_MMA6(X, S, C) do { _Pragma("unroll") for (int i = 0; i < VSET; ++i) { const unsigned t_ = ((const LAS u32x2*)(lst + (S) * 1024))[2 * VSET * (C) + 2 * i + vg].y + 0x00080000u; \
                const unsigned code_ = ((t_ >> 26) & 0x20u) | 0x8u | ((t_ >> 20) & 7u); const int sc_ = (int)((t_ >> 23) & 0xffu); \
                const unsigned long long v_ = (unsigned long long)code_ << sh6; const unsigned lo_ = (unsigned)v_, hi_ = (unsigned)(v_ >> 32); \
                const i32x8g a_ = {(int)(d6 == 0 ? lo_ : 0u), (int)((d6 == 1 ? lo_ : 0u) | (d6 == 0 ? hi_ : 0u)), (int)((d6 == 2 ? lo_ : 0u) | (d6 == 1 ? hi_ : 0u)), (int)((d6 == 3 ? lo_ : 0u) | (d6 == 2 ? hi_ : 0u)), \
                                   (int)((d6 == 4 ? lo_ : 0u) | (d6 == 3 ? hi_ : 0u)), (int)((d6 == 5 ? lo_ : 0u) | (d6 == 4 ? hi_ : 0u)), 0, 0}; \
                const u32x4 d_ = X##r[i]; const u32x2 e2_ = X##q[i]; const i32x8g b_ = {(int)d_.x, (int)d_.y, (int)d_.z, (int)d_.w, (int)e2_.x, (int)e2_.y, 0, 0}; \
                vc##S = __builtin_amdgcn_mfma_scale_f32_32x32x64_f8f6f4(a_, b_, vc##S, 2, 2, 0, sc_, 0, 0x7f); } } while (0)
#endif
#if VBUF4
            V_LOAD6(A, 0, 0); V_LOAD6(B, 1, 0); V_LOAD6(C, 2, 0);
#pragma unroll 1
            for (int c = 0; c < 64 / VSET - 1; ++c) {
                V_LOAD6(D, 3, c); V_MMA6(A, 0, c); __builtin_amdgcn_sched_barrier(0);
                V_LOAD6(A, 0, c + 1); V_MMA6(B, 1, c); __builtin_amdgcn_sched_barrier(0);
                V_LOAD6(B, 1, c + 1); V_MMA6(C, 2, c); __builtin_amdgcn_sched_barrier(0);
                V_LOAD6(C, 2, c + 1); V_MMA6(D, 3, c); __builtin_amdgcn_sched_barrier(0);
            }
            {   constexpr int cl = 64 / VSET - 1;
                V_LOAD6(D, 3, cl); V_MMA6(A, 0, cl); __builtin_amdgcn_sched_barrier(0);
                V_MMA6(B, 1, cl); __builtin_amdgcn_sched_barrier(0);
                V_MMA6(C, 2, cl); __builtin_amdgcn_sched_barrier(0);
                V_MMA6(D, 3, cl); __builtin_amdgcn_sched_barrier(0);
            }
#else
            V_LOAD6(A, 0, 0);
#pragma unroll 1
            for (int c = 0; c < 64 / VSET; ++c) {
                V_LOAD6(B, 1, c); V_MMA6(A, 0, c); __builtin_amdgcn_sched_barrier(0);
                V_LOAD6(A, 2, c); V_MMA6(B, 1, c); __builtin_amdgcn_sched_barrier(0);
                V_LOAD6(B, 3, c); V_MMA6(A, 2, c); __builtin_amdgcn_sched_barrier(0);
                if (c < 64 / VSET - 1) V_LOAD6(A, 0, c + 1);
                V_MMA6(B, 3, c); __builtin_amdgcn_sched_barrier(0);
            }
#endif
#undef V_LOAD6
#undef V_MMA6
#undef V6_BOP
            }
#if PEER_FUSED
#define V6_HB(S, Q) (*(const u32x2*)(H + (size_t)(tok0 + S < T_TOK ? tok0 + S : T_TOK - 1) * D_MODEL + cb_ + 8 * (Q)))
#else
#define V6_HB(S, Q) (*(const LAS u32x2*)(wb + 512 + 4096 + S * 2048 + 2 * (cb_ + 8 * (Q))))
#endif
#define V_FIN6(S) do { int vnl_ = vn; asm volatile("" : "+v"(vnl_)); const int cb_ = 32 * vnl_ + 4 * vg; float s3_ = 0.f; f32x4 h3_[4];     \
                _Pragma("unroll") for (int q = 0; q < 4; ++q) { const u32x2 hb_ = V6_HB(S, q); \
                    const f32x4 a_ = {vc##S[4 * q], vc##S[4 * q + 1], vc##S[4 * q + 2], vc##S[4 * q + 3]}; \
                    h3_[q] = (f32x4){bf_lo(hb_.x), bf_hi(hb_.x), bf_lo(hb_.y), bf_hi(hb_.y)} + a_ * (amp * (V6_DIAG_FP8 ? 1.f / (64.f * PV_SCALE) : 1.f)); \
                    s3_ += h3_[q][0] * h3_[q][0] + h3_[q][1] * h3_[q][1] + h3_[q][2] * h3_[q][2] + h3_[q][3] * h3_[q][3]; } \
                const float r3_ = 1.f / sqrtf(wave_sum(s3_) * (1.f / D_MODEL) + RMS_EPS); \
                if (tok0 + S < T_TOK) { _Pragma("unroll") for (int q = 0; q < 4; ++q) { const f32x4 gq_ = *(const f32x4*)(p.in[29] + cb_ + 8 * q); \
                    *(f32x4*)(p.out + (size_t)(tok0 + S) * D_MODEL + cb_ + 8 * q) = h3_[q] * r3_ * gq_; } } } while (0)
            V_FIN6(0); V_FIN6(1); V_FIN6(2); V_FIN6(3);
#undef V_FIN6
#undef V6_HB
        }
#elif GATHER_VMMA
            f32x4 vc0[8], vc1[8], vc2[8], vc3[8];
#pragma unroll
            for (int t = 0; t < 8; ++t) { vc0[t] = (f32x4){0.f, 0.f, 0.f, 0.f}; vc1[t] = vc0[t]; vc2[t] = vc0[t]; vc3[t] = vc0[t]; }
            const int vn = lane & 15, vg = lane >> 4;
            const unsigned char* PVl = PV + 16 * vn;
            { u32x4 Ar[8], Br[8]; unsigned Aw[2], Bw[2];
#define V_LOAD4(X, O, S, C) do { const u32x2 ew_ = ((const LAS u32x2*)(lst + (S) * 1024))[4 * (C) + vg]; X##w[(O) >> 2] = ew_.y; const unsigned char* rp_ = PVl + (size_t)ew_.x * D_MODEL; \
                _Pragma("unroll") for (int s2 = 0; s2 < 4; ++s2) X##r[(O) + s2] = *(const u32x4*)(rp_ + 256 * s2); } while (0)
#define V_MMA(X, O, S) do { const float w64_ = fminf(__uint_as_float(X##w[(O) >> 2]) * 4096.f, 440.f); \
                const int hi8_ = __builtin_amdgcn_cvt_pk_fp8_f32(w64_, 0.f, 0, false); const float hif_ = __builtin_amdgcn_cvt_pk_f32_fp8(hi8_, false)[0]; \
                const int lo8_ = __builtin_amdgcn_cvt_pk_fp8_f32((w64_ - hif_) * 16.f, 0.f, 0, false); \
                const unsigned sh_ = (unsigned)((vn < 8 ? hi8_ : lo8_) & 0xff) << (8 * (vn & 3)); \
                const long a_ = (long)(((unsigned long long)((vn & 4) ? sh_ : 0u) << 32) | (unsigned long long)((vn & 4) ? 0u : sh_)); \
                _Pragma("unroll") for (int s2 = 0; s2 < 4; ++s2) { const u32x4 d_ = X##r[(O) + s2]; \
                    vc##S[2 * s2] = __builtin_amdgcn_mfma_f32_16x16x32_fp8_fp8(a_, (long)(((unsigned long long)d_.y << 32) | d_.x), vc##S[2 * s2], 0, 0, 0); \
                    vc##S[2 * s2 + 1] = __builtin_amdgcn_mfma_f32_16x16x32_fp8_fp8(a_, (long)(((unsigned long long)d_.w << 32) | d_.z), vc##S[2 * s2 + 1], 0, 0, 0); } } while (0)
            V_LOAD4(A, 0, 0, 0); V_LOAD4(A, 4, 1, 0);
#pragma unroll 1
            for (int c = 0; c < 32; ++c) {
                V_LOAD4(B, 0, 2, c); V_LOAD4(B, 4, 3, c); V_MMA(A, 0, 0); V_MMA(A, 4, 1); __builtin_amdgcn_sched_barrier(0);
                if (c < 31) { V_LOAD4(A, 0, 0, c + 1); V_LOAD4(A, 4, 1, c + 1); }
                V_MMA(B, 0, 2); V_MMA(B, 4, 3); __builtin_amdgcn_sched_barrier(0);
            }
#undef V_LOAD4
#undef V_MMA
            }
#define V_FIN(S) do { const float sc_ = vg < 2 ? (1.f / 4096.f) : (1.f / 65536.f); const int cb_ = 16 * vn + 8 * (vg >> 1) + 4 * (vg & 1); float s3_ = 0.f; f32x4 h3_[4]; \
                _Pragma("unroll") for (int s2 = 0; s2 < 4; ++s2) { f32x4 a_; \
                    _Pragma("unroll") for (int r = 0; r < 4; ++r) { const float x0_ = vc##S[2 * s2][r] * sc_, x1_ = vc##S[2 * s2 + 1][r] * sc_; \
                        const auto p0_ = __builtin_amdgcn_permlane32_swap(__float_as_uint(x0_), __float_as_uint(x0_), false, false); const auto p1_ = __builtin_amdgcn_permlane32_swap(__float_as_uint(x1_), __float_as_uint(x1_), false, false); \
                        const float y0_ = __uint_as_float(p0_[0]) + __uint_as_float(p0_[1]), y1_ = __uint_as_float(p1_[0]) + __uint_as_float(p1_[1]); a_[r] = (vg >> 1) ? y1_ : y0_; } \
                    const u32x2 hb_ = *(const LAS u32x2*)(wb + 512 + 4096 + S * 2048 + 2 * (256 * s2 + cb_)); \
                    h3_[s2] = (f32x4){bf_lo(hb_.x), bf_hi(hb_.x), bf_lo(hb_.y), bf_hi(hb_.y)} + a_ * amp; \
                    s3_ += h3_[s2][0] * h3_[s2][0] + h3_[s2][1] * h3_[s2][1] + h3_[s2][2] * h3_[s2][2] + h3_[s2][3] * h3_[s2][3]; } \
                const float r3_ = 1.f / sqrtf(wave_sum(s3_) * (1.f / D_MODEL) + RMS_EPS); \
                if (tok0 + S < T_TOK) { _Pragma("unroll") for (int s2 = 0; s2 < 4; ++s2) { const f32x4 gq_ = *(const f32x4*)(p.in[29] + 256 * s2 + cb_); \
                    *(f32x4*)(p.out + (size_t)(tok0 + S) * D_MODEL + 256 * s2 + cb_) = h3_[s2] * r3_ * gq_; } } } while (0)
            V_FIN(0); V_FIN(1); V_FIN(2); V_FIN(3);
#undef V_FIN
        }
#else
#pragma unroll
            for (int j = 0; j < 16; ++j) { ac0[j] = 0.f; ac1[j] = 0.f; ac2[j] = 0.f; ac3[j] = 0.f; }
#define V_LOAD2(X, S0, C) do { _Pragma("unroll") for (int i = 0; i < 8; ++i) { const size_t e_ = (size_t)(unsigned)__builtin_amdgcn_readfirstlane((int)((const LAS u32x2*)(lst + ((S0) + (i >> 2)) * 1024))[4 * (C) + (i & 3)].x); \
                X##r[i] = *(const u32x4*)(PV + e_ * D_MODEL + 16 * lane); } } while (0)
#define V_ACC(X, O, S, C) do { LAS const u32x2* le_ = (const LAS u32x2*)(lst + S * 1024) + 4 * (C); \
                _Pragma("unroll") for (int i = 0; i < 4; ++i) { const float w_ = __builtin_bit_cast(float, __builtin_amdgcn_readfirstlane((int)le_[i].y)); float vf[16]; unpack_fp8x16(X##r[(O) + i], vf); \
                    _Pragma("unroll") for (int j = 0; j < 16; ++j) ac##S[j] = fmaf(w_, vf[j], ac##S[j]); } } while (0)
            V_LOAD2(A, 0, 0);
#pragma unroll 1
            for (int c = 0; c < 32; ++c) {
                V_LOAD2(B, 2, c); V_ACC(A, 0, 0, c); V_ACC(A, 4, 1, c); __builtin_amdgcn_sched_barrier(0);
                if (c < 31) V_LOAD2(A, 0, c + 1);
                V_ACC(B, 0, 2, c); V_ACC(B, 4, 3, c); __builtin_amdgcn_sched_barrier(0);
            }
#undef V_LOAD2
#undef V_ACC
        }
        GS_FIN(0); GS_FIN(1); GS_FIN(2); GS_FIN(3);
#endif
#elif GNT == 4
        GS_DECL(0); GS_DECL(1); GS_DECL(2); GS_DECL(3); GS_SETUP(0); GS_SETUP(1); GS_SETUP(2); GS_SETUP(3);
        G_LOAD(A, 0, 0);
#pragma unroll 1
        for (int c = 0; c < 32; ++c) {
            G_LOAD(B, 1, c); G_PROC(A, 0, c); __builtin_amdgcn_sched_barrier(0);
            G_LOAD(A, 2, c); G_PROC(B, 1, c); __builtin_amdgcn_sched_barrier(0);
            G_LOAD(B, 3, c); G_PROC(A, 2, c); __builtin_amdgcn_sched_barrier(0);
            if (c < 31) G_LOAD(A, 0, c + 1);
            G_PROC(B, 3, c); __builtin_amdgcn_sched_barrier(0);
        }
        GS_FIN(0); GS_FIN(1); GS_FIN(2); GS_FIN(3);
#else
        GS_DECL(0); GS_SETUP(0);
        G_LOAD(A, 0, 0);
#pragma unroll 1
        for (int c = 0; c < 32; c += 2) {
            G_LOAD(B, 0, c + 1); G_PROC(A, 0, c);
            if (c < 30) G_LOAD(A, 0, c + 2);
            G_PROC(B, 0, c + 1);
        }
        GS_FIN(0);
#endif
#undef GS_DECL
#undef GS_AMAX
#undef GS_KEEP
#undef GS_HX
#undef GS_SETUP
#undef GS_FIN
#undef G_LOAD
#undef G_PROC
    }
}
#define XB_TMO      128
#define XB_XCNT(j)  (256  + 64 * (j))
#define XB_XSUB(j)  (1280 + 64 * (j))
#define XB_XGEN(j)  (2304 + 64 * (j))
#define XB_TOP      3328
#define XB_TOPGEN   3392
#define XCD_BAR_WORDS 3456
#define XB_SPIN_CAP (1u << 18)

__device__ __forceinline__ unsigned xb_ld(unsigned* p)              { return __hip_atomic_load(p, __ATOMIC_RELAXED, __HIP_MEMORY_SCOPE_AGENT); }
__device__ __forceinline__ unsigned xb_add(unsigned* p, unsigned v) { return __hip_atomic_fetch_add(p, v, __ATOMIC_RELAXED, __HIP_MEMORY_SCOPE_AGENT); }
__device__ __forceinline__ unsigned xb_xcc_id() { return (unsigned)__builtin_amdgcn_s_getreg((3 << 11) | 20) & 0xFu; }
#define XB_SPIN(cond, bar) do { unsigned _sp = 0; while (cond) { __builtin_amdgcn_s_sleep(1); \
    if ((++_sp & 255u) == 0u) { if (xb_ld(&(bar)[XB_TMO])) break; if (_sp > XB_SPIN_CAP) { atomicAdd(&(bar)[XB_TMO], 1u); break; } } } } while (0)

struct XcdBarrier {
    unsigned* bar; unsigned x;
    volatile LAS unsigned* st;
};

__device__ __forceinline__ XcdBarrier xcd_barrier_post(unsigned* bar, volatile LAS unsigned* st) {
    XcdBarrier b; b.bar = bar; b.x = xb_xcc_id(); b.st = st;
    if (threadIdx.x == 0) (void)xb_add(&bar[XB_XCNT(b.x)], 1u);
    return b;
}
__device__ __forceinline__ void xcd_barrier_complete(unsigned* bar, unsigned x, unsigned& nloc, unsigned& nx) {
    const unsigned G = gridDim.x * gridDim.y * gridDim.z;
    unsigned sum, cnt, mine, sp = 0u;
    for (;;) {
        sum = 0u; cnt = 0u; mine = 0u;
#pragma unroll
        for (unsigned j = 0; j < 16; ++j) { const unsigned c = xb_ld(&bar[XB_XCNT(j)]); sum += c; cnt += (c > 0u) ? 1u : 0u; mine = (j == x) ? c : mine; }
        if (sum == G) break;
        __builtin_amdgcn_s_sleep(1);
        if ((++sp & 255u) == 0u) { if (xb_ld(&bar[XB_TMO])) break; if (sp > XB_SPIN_CAP) { atomicAdd(&bar[XB_TMO], 1u); break; } }
    }
    nloc = mine > 0u ? mine : 1u; nx = cnt > 0u ? cnt : 1u;
}

__device__ __forceinline__ void xcd_barrier(const XcdBarrier& b) {
    asm volatile("s_waitcnt vmcnt(0)" ::: "memory");
    __syncthreads();
    if (threadIdx.x == 0) {
        unsigned* bar = b.bar;
        __builtin_amdgcn_s_waitcnt(0);
        unsigned nloc = b.st[0], nx = b.st[1];
        if (nloc == 0u) { xcd_barrier_complete(bar, b.x, nloc, nx); b.st[0] = nloc; b.st[1] = nx; }
        const unsigned old = xb_add(&bar[XB_XSUB(b.x)], 1u);
        const unsigned gen = old / nloc;
        if (old + 1u == (gen + 1u) * nloc) {
            __builtin_amdgcn_fence(__ATOMIC_RELEASE, "agent");
            asm volatile("s_waitcnt vmcnt(0)" ::: "memory");
            const unsigned og = xb_add(&bar[XB_TOP], 1u);
            const unsigned tg = og / nx;
            if (og + 1u == (tg + 1u) * nx) xb_add(&bar[XB_TOPGEN], 1u);
            else XB_SPIN(xb_ld(&bar[XB_TOPGEN]) == tg, bar);
            __builtin_amdgcn_fence(__ATOMIC_ACQUIRE, "agent");
            xb_add(&bar[XB_XGEN(b.x)], 1u);
            asm volatile("s_waitcnt vmcnt(0)" ::: "memory");
        } else {
            XB_SPIN(xb_ld(&bar[XB_XGEN(b.x)]) == gen, bar);
            __builtin_amdgcn_fence(__ATOMIC_ACQUIRE, "agent");
            asm volatile("s_waitcnt vmcnt(0)" ::: "memory");
        }
    }
    __syncthreads();
}
template <> __device__ __forceinline__ void bar_sync<XcdBarrier>(const XcdBarrier& b) { xcd_barrier(b); }
#ifndef STAGE_MIX
#define STAGE_MIX 0
#endif
#ifndef STAGE_CROSS
#define STAGE_CROSS 1
#endif
#ifndef USE_A
#define USE_A 1
#endif
#ifndef USE_B
#define USE_B 1
#endif
#ifndef AMP_MIX
#define AMP_MIX 1.f
#endif
#ifndef DUP_EMASK
#define DUP_EMASK 0xffffffffu
#endif
#ifndef GATHER_SYNC
#define GATHER_SYNC 0
#endif
#ifndef DUP_PHASE
#define DUP_PHASE 0
#endif
#ifndef AMP_PEER
#define AMP_PEER 1.f
#endif
#ifndef AMP_CROSS
#define AMP_CROSS 1.f
#endif
#ifndef STAGE_PEER
#define STAGE_PEER 0
#endif
__device__ __forceinline__ void h_from_x(const Params& p, int wave, int lane) {
    const int gw = blockIdx.x * NWAVES + wave, NGW = gridDim.x * NWAVES;
    for (int m = gw; m < T_TOK; m += NGW) {
        const f32x4* xr = (const f32x4*)(p.in[0] + (size_t)m * D_MODEL) + lane; u32x2* o8 = (u32x2*)((bf16_t*)(p.ws + WS_H) + (size_t)m * D_MODEL) + lane; float s = 0.f;
#pragma unroll
        for (int j = 0; j < 4; ++j) { const f32x4 v = xr[64 * j]; s += (v.x * v.x + v.y * v.y) + (v.z * v.z + v.w * v.w); u32x2 w; w.x = pk_bf16(v.x, v.y); w.y = pk_bf16(v.z, v.w); o8[64 * j] = w; }
        s = wave_sum(s);
        if (lane < 16) ((float*)(p.ws + WS_SSQ1))[(size_t)m * 16 + lane] = lane == 0 ? s : 0.f;
    }
}
__global__ void __launch_bounds__(NTHREADS, 2) fwd_megakernel(Params p) {
    extern __shared__ __attribute__((aligned(16))) unsigned char lds_raw[];
    LAS unsigned char* lds = (LAS unsigned char*)lds_raw;
    cg::grid_group grid = cg::this_grid();
    const int wave = __builtin_amdgcn_readfirstlane((int)threadIdx.x >> 6);
#define FRESH_TID() int tid = threadIdx.x; asm volatile("" : "+v"(tid)); const int lane = tid & 63
    unsigned char* ws = p.ws;
    const int G = gridDim.x, bx = blockIdx.x;
    volatile LAS unsigned* bst = (volatile LAS unsigned*)(lds + LDS_BYTES - 16);
    if (threadIdx.x < 4) bst[threadIdx.x] = 0u;
    __syncthreads();
    const XcdBarrier bar = xcd_barrier_post((unsigned*)(ws + WS_CTL), bst);
#define GRID_BAR() xcd_barrier(bar)
    { FRESH_TID(); p0_prologue(p, lds, wave, lane); }
#if DUP_PHASE == 5
    { FRESH_TID(); __syncthreads(); p0_prologue(p, lds, wave, lane); }
#endif
    grid.sync();
#if STAGE_MIX
    {
        pg8::Gemm g{(const bf16_t*)(ws + WS_XN), (const bf16_t*)(ws + WS_WINA), T_TOK, N_PROJA, 1024}; pg8::StaticOrder S; S.init(T_TOK, N_PROJA, G, bx);
#if DUP_PHASE == 8
        { pg8::EpiProj E0{(bf16_t*)(ws + WS_Q), (bf16_t*)(ws + WS_K), (bf16_t*)(ws + WS_V), (bf16_t*)(ws + WS_RW), (const bf16_t*)(ws + WS_ROPE_C), 0.125f * LOG2E, 1};
          pg8::gemm_phase<pg8::EpiProj, pg8::StaticOrder, true, true>(lds, g, S, E0); }
#endif
        pg8::EpiProj E{(bf16_t*)(ws + WS_Q), (bf16_t*)(ws + WS_K), (bf16_t*)(ws + WS_V), (bf16_t*)(ws + WS_RW), (const bf16_t*)(ws + WS_ROPE_C), 0.125f * LOG2E, 0};
        pg8::gemm_phase<pg8::EpiProj, pg8::StaticOrder, true, true>(lds, g, S, E);
#if DUP_PHASE == 4
        pg8::gemm_phase<pg8::EpiProj, pg8::StaticOrder, true, true>(lds, g, S, E);
#endif
    }
    GRID_BAR();
#if USE_B
    { FRESH_TID(); rwkv_act_phase(p, wave, lane); }
#endif
#if USE_A
    { FRESH_TID(); swa_phase(p, lds, tid, wave, lane); }
#endif
#if USE_B
    GRID_BAR();
    { FRESH_TID(); rwkv_phase(p, lds, tid, wave, lane); }
#if DUP_PHASE == 3
    { FRESH_TID(); rwkv_phase(p, lds, tid, wave, lane); }
#endif
#endif
    GRID_BAR();
    {
#if GATE_FP8
        pg8::Gemm g{(const bf16_t*)p.out, (const bf16_t*)(ws + WS_WING), T_TOK, 2048, 512}; pg8::StaticOrder S; S.init(T_TOK, 2048, G, bx);
        pg8::EpiGate E{(bf16_t*)(ws + WS_Q), (const bf16_t*)(ws + WS_Y), USE_A, USE_B, -LOG2E / GATE_WSCALE};
        pg8::gemm_phase<pg8::EpiGate, pg8::StaticOrder, true, true, true>(lds, g, S, E);
#else
        pg8::Gemm g{(const bf16_t*)(ws + WS_XN), (const bf16_t*)(ws + WS_WING), T_TOK, 2048, 1024}; pg8::StaticOrder S; S.init(T_TOK, 2048, G, bx);
        pg8::EpiGate E{(bf16_t*)(ws + WS_Q), (const bf16_t*)(ws + WS_Y), USE_A, USE_B, -LOG2E};
        pg8::gemm_phase<pg8::EpiGate, pg8::StaticOrder, true, true>(lds, g, S, E);
#endif
    }
    GRID_BAR();
    {
        pg8::Gemm g{(const bf16_t*)(ws + WS_Q), (const bf16_t*)(ws + WS_WOUT), T_TOK, 1024, 1024}; pg8::StaticOrder S; S.init(T_TOK, 1024, G, bx);
        pg8::EpiRes<true> E{p.in[0], (bf16_t*)(ws + WS_H), (float*)(ws + WS_SSQ1), AMP_MIX};
        pg8::gemm_phase<pg8::EpiRes<true>, pg8::StaticOrder, true, true>(lds, g, S, E);
    }
    GRID_BAR();
#else
    { FRESH_TID(); h_from_x(p, wave, lane); }
#endif
#if STAGE_CROSS
    {
        pg8::Gemm g{(const bf16_t*)(ws + WS_H), (const bf16_t*)(ws + WS_WQC), T_TOK, 512, 1024}; pg8::StaticOrder S; S.init(T_TOK, 512, G, bx);
        pg8::EpiScaled E{(bf16_t*)(ws + WS_QC), 512, (const float*)(ws + WS_SSQ1), 0.08838834764831845f * LOG2E};
        pg8::gemm_phase<pg8::EpiScaled, pg8::StaticOrder, true, true>(lds, g, S, E);
    }
    {
        pg8::Gemm g{(const bf16_t*)(ws + WS_MEMN), (const bf16_t*)(ws + WS_WKVC), MEM_ROWS, 1024, 1024}; pg8::StaticOrder S; S.init(MEM_ROWS, 1024, G, (bx + G / 2) % G);
        pg8::EpiPlain E{(bf16_t*)(ws + WS_KVC), 1024};
        pg8::gemm_phase<pg8::EpiPlain, pg8::StaticOrder, true, true>(lds, g, S, E);
    }
    GRID_BAR();
    { FRESH_TID(); cross_phase(p, lds, tid, wave, lane); }
    GRID_BAR();
    {
#if CROSS_FP8
        pg8::Gemm g{(const bf16_t*)(ws + WS_QC8), (const bf16_t*)(ws + WS_WOC), T_TOK, 1024, 256}; pg8::StaticOrder S; S.init(T_TOK, 1024, G, bx);
        pg8::EpiRes<false> E{nullptr, (bf16_t*)(ws + WS_H), (float*)(ws + WS_SSQ2), AMP_CROSS / (CROSS_OSCALE * CROSS_WSCALE)};
        pg8::gemm_phase<pg8::EpiRes<false>, pg8::StaticOrder, true, true, true>(lds, g, S, E);
#else
        pg8::Gemm g{(const bf16_t*)(ws + WS_QC), (const bf16_t*)(ws + WS_WOC), T_TOK, 1024, 512}; pg8::StaticOrder S; S.init(T_TOK, 1024, G, bx);
        pg8::EpiRes<false> E{nullptr, (bf16_t*)(ws + WS_H), (float*)(ws + WS_SSQ2), AMP_CROSS};
        pg8::gemm_phase<pg8::EpiRes<false>, pg8::StaticOrder, true, true>(lds, g, S, E);
#endif
    }
    GRID_BAR();
#endif
#if STAGE_PEER
    {
        pg8::Gemm g{(const bf16_t*)(ws + WS_H), (const bf16_t*)(ws + WS_WPQ), T_TOK, 2048, 1024}; pg8::StaticOrder S; S.init(T_TOK, 2048, G, bx);
        pg8::EpiScaled E{(bf16_t*)(ws + WS_PQ), 2048, (const float*)(ws + (STAGE_CROSS ? WS_SSQ2 : WS_SSQ1)), 1.f};
        pg8::gemm_phase<pg8::EpiScaled, pg8::StaticOrder, true, true>(lds, g, S, E);
#if DUP_PHASE == 6
        pg8::gemm_phase<pg8::EpiScaled, pg8::StaticOrder, true, true>(lds, g, S, E);
#endif
    }
    GRID_BAR();
#if !PEER_FUSED
    { FRESH_TID(); peer_route_phase(p, lds, tid, wave, lane); }
#if DUP_PHASE == 2
    { FRESH_TID(); peer_route_phase(p, lds, tid, wave, lane); }
#endif
    GRID_BAR();
#endif
    { FRESH_TID(); peer_gather_phase(p, lds, wave, lane, AMP_PEER, bar); }
#if DUP_PHASE == 1
    { FRESH_TID(); peer_gather_phase(p, lds, wave, lane, AMP_PEER, bar); }
#endif
#else
    { FRESH_TID(); final_norm_rows((const bf16_t*)(ws + WS_H), p.in[29], p.out, wave, lane); }
#endif
}

extern "C" void kernel_launch(void* const* d_in, const int* in_sizes, int n_in, void* d_out, int out_size, void* d_ws, size_t ws_size, hipStream_t stream) {
    static int grid_blocks = 0;
    if (grid_blocks == 0) {
        if (n_in != 30 || in_sizes[0] != T_TOK * D_MODEL || out_size != T_TOK * D_MODEL || ws_size < WS_END) {
            fprintf(stderr, "kernel_launch: unexpected shapes: n_in %d in0 %d out %d ws %zu (need %zu)\n", n_in, n_in > 0 ? in_sizes[0] : -1, out_size, ws_size, (size_t)WS_END); grid_blocks = -1; return; }
        int dev = 0, cus = 0, per_cu = 0;
        (void)hipGetDevice(&dev);
        (void)hipDeviceGetAttribute(&cus, hipDeviceAttributeMultiprocessorCount, dev);
        (void)hipFuncSetAttribute((const void*)fwd_megakernel, hipFuncAttributeMaxDynamicSharedMemorySize, LDS_BYTES);
        (void)hipOccupancyMaxActiveBlocksPerMultiprocessor(&per_cu, (const void*)fwd_megakernel, NTHREADS, LDS_BYTES);
        if (per_cu < 1) { fprintf(stderr, "kernel_launch: occupancy query says %d blocks per CU\n", per_cu); per_cu = 1; }
        if (per_cu > 1) per_cu = 1;
        grid_blocks = cus * per_cu;
    }
    if (grid_blocks < 0) return;
    (void)hipMemsetAsync((char*)d_ws + WS_CTL, 0, 65536, stream);
    Params p{};
    for (int i = 0; i < 30; ++i) p.in[i] = (const float*)d_in[i];
    p.out = (float*)d_out; p.ws = (unsigned char*)d_ws;
    void* args[] = {&p};
    hipError_t e = hipLaunchCooperativeKernel((const void*)fwd_megakernel, dim3(grid_blocks), dim3(NTHREADS), args, LDS_BYTES, stream);
    if (e != hipSuccess) fprintf(stderr, "cooperative launch failed: %s (grid %d)\n", hipGetErrorString(e), grid_blocks);
}
```

```cpp
#include <hip/hip_runtime.h>
#include <hip/hip_cooperative_groups.h>
#include <cstdio>
#include <cstdint>
namespace cg = cooperative_groups;

constexpr int D_MODEL = 1024, BATCH = 32, SEQ = 2048, T_TOK = BATCH * SEQ;
constexpr int IN_WIDTH = 6912, N_PROJA = 4864, RW_W = 3328;
constexpr int MEM_LEN = 256, MEM_ROWS = BATCH * MEM_LEN;
constexpr int N_EXPERTS = 16384;
constexpr float RMS_EPS = 1e-5f, LOG2E = 1.4426950408889634f;
constexpr int NTHREADS = 512, NWAVES = 8;
constexpr int LDS_BYTES = 160 * 1024;

constexpr size_t MiB = 1u << 20;
constexpr size_t WS_CTL = 0;
constexpr size_t WS_ROPE_C = 1 * MiB, WS_ROPE_S = 3 * MiB;
constexpr size_t WS_W2T = 5 * MiB, WS_A2T = WS_W2T + 131072, WS_G2T = WS_A2T + 131072;
constexpr size_t WS_PK1 = 6 * MiB, WS_PK2 = WS_PK1 + 32768;
constexpr size_t WS_WINA = 8 * MiB;
constexpr size_t WS_WING = 18 * MiB;
constexpr size_t WS_WOUT = 22 * MiB;
constexpr size_t WS_WQC = 24 * MiB;
constexpr size_t WS_WOC = 25 * MiB;
constexpr size_t WS_WKVC = 26 * MiB;
constexpr size_t WS_WPQ = 28 * MiB;
constexpr size_t WS_PU = 32 * MiB;
constexpr size_t WS_PV = 64 * MiB;
constexpr size_t WS_ACT0 = 48 * MiB, WS_ACT1 = 80 * MiB;
constexpr size_t WS_MEMN = 96 * MiB;
constexpr size_t WS_KVC = 112 * MiB;
constexpr size_t WS_XN = 128 * MiB;
constexpr size_t WS_H = WS_XN;
constexpr size_t WS_Q = 256 * MiB;
constexpr size_t WS_K = 384 * MiB;
constexpr size_t WS_V = 416 * MiB;
constexpr size_t WS_RW = 448 * MiB;
constexpr size_t WS_Y = 864 * MiB;
constexpr size_t WS_SSQ1 = 992 * MiB, WS_SSQ2 = 996 * MiB;
constexpr size_t WS_QC8 = 256 * MiB;
constexpr size_t WS_QC = 384 * MiB;
constexpr size_t WS_PQ = 448 * MiB;
constexpr size_t WS_RE = 704 * MiB;
constexpr size_t WS_RS = 736 * MiB;
constexpr size_t WS_END = 1024 * MiB;

#ifndef GATE_FP8
#define GATE_FP8 1
#endif
constexpr float GATE_WSCALE = 32.f;
#ifndef PROJ_I8
#define PROJ_I8 1
#endif
constexpr size_t WS_SX = 1004 * MiB;
constexpr size_t WS_SWA = 1005 * MiB, WS_SWG = WS_SWA + 32768;
constexpr size_t CTL_WAMAX = 16384, CTL_WARRIVE = 49152;
#ifndef PQ_I8
#define PQ_I8 1
#endif
constexpr size_t WS_H8 = 256 * MiB;
constexpr size_t WS_SX2 = WS_SX + 524288, WS_SWP = WS_SWG + 16384;
#ifndef G2_I8
#define G2_I8 1
#endif
constexpr size_t OUT_MIX8 = 64 * MiB;
constexpr size_t WS_SX3 = WS_SX + 786432, WS_SWO = WS_SWP + 8192;
constexpr size_t CTL_WAMAX3 = 60416;
constexpr size_t CTL_WAMAX2 = 52224;
__device__ __forceinline__ float wave_max(float x) {
#pragma unroll
    for (int o = 32; o > 0; o >>= 1) x = fmaxf(x, __shfl_xor(x, o));
    return x; }
__device__ __forceinline__ unsigned pack_i8x4(float a, float b, float c, float d) {
    const int q0 = (int)__builtin_rintf(a), q1 = (int)__builtin_rintf(b), q2 = (int)__builtin_rintf(c), q3 = (int)__builtin_rintf(d);
    return (unsigned)(q0 & 255) | ((unsigned)(q1 & 255) << 8) | ((unsigned)(q2 & 255) << 16) | ((unsigned)q3 << 24); }
#ifndef PROJ_SK_LO
#define PROJ_SK_LO 6
#define PROJ_SK_N 4
#endif
#ifndef PROJ_RUNS
#define PROJ_RUNS(X) X(0, 6, 1); X(6, 19, 0)
#endif
#ifndef PROJ_FP8
#define PROJ_FP8 1
#endif
#ifndef CROSS_FP8
#define CROSS_FP8 0
#endif
constexpr float CROSS_OSCALE = 16.f, CROSS_WSCALE = 16.f;
#define LAS __attribute__((address_space(3)))
typedef unsigned short bf16_t;
typedef short bf16x8 __attribute__((ext_vector_type(8)));
typedef float f32x4 __attribute__((ext_vector_type(4)));
typedef float f32x2 __attribute__((ext_vector_type(2)));
typedef float f32x16 __attribute__((ext_vector_type(16)));
typedef unsigned u32x4 __attribute__((ext_vector_type(4)));
typedef unsigned u32x2 __attribute__((ext_vector_type(2)));
typedef __bf16 bf16x2_t __attribute__((ext_vector_type(2)));
typedef __bf16 bf16x32_t __attribute__((ext_vector_type(32)));
typedef unsigned u32x6 __attribute__((ext_vector_type(6)));
typedef unsigned u32x16 __attribute__((ext_vector_type(16)));
typedef int i32x8g __attribute__((ext_vector_type(8)));
typedef int i32x6g __attribute__((ext_vector_type(6)));

__device__ __forceinline__ unsigned pk_bf16(float lo, float hi) { f32x2 v = {lo, hi}; bf16x2_t b = __builtin_convertvector(v, bf16x2_t); return __builtin_bit_cast(unsigned, b); }
__device__ __forceinline__ float bf_lo(unsigned u) { return __uint_as_float(u << 16); }
__device__ __forceinline__ float bf_hi(unsigned u) { return __uint_as_float(u & 0xffff0000u); }
__device__ __forceinline__ float bf1(bf16_t h) { return __uint_as_float((unsigned)h << 16); }
__device__ __forceinline__ float fast_exp2(float x) { return __builtin_amdgcn_exp2f(x); }
__device__ __forceinline__ float fast_rcp(float x) { return __builtin_amdgcn_rcpf(x); }
__device__ __forceinline__ float sigmoidf_(float x) { return fast_rcp(1.f + fast_exp2(-LOG2E * x)); }
template <int CTRL> __device__ __forceinline__ float dpp(float x) { return __builtin_bit_cast(float, __builtin_amdgcn_mov_dpp(__builtin_bit_cast(int, x), CTRL, 0xf, 0xf, true)); }
constexpr int DPP_XOR1 = 0xB1, DPP_XOR2 = 0x4E, DPP_HMIRROR = 0x141, DPP_ROR8 = 0x128;
__device__ __forceinline__ float sum8(float x) { x += dpp<DPP_XOR1>(x); x += dpp<DPP_XOR2>(x); x += dpp<DPP_HMIRROR>(x); return x; }
__device__ __forceinline__ float sum16(float x) { x = sum8(x); x += dpp<DPP_ROR8>(x); return x; }
__device__ __forceinline__ float max16(float x) { x = fmaxf(x, dpp<DPP_XOR1>(x)); x = fmaxf(x, dpp<DPP_XOR2>(x)); x = fmaxf(x, dpp<DPP_HMIRROR>(x)); x = fmaxf(x, dpp<DPP_ROR8>(x)); return x; }
__device__ __forceinline__ float xrow_sum(float x) {
    auto s = __builtin_amdgcn_permlane16_swap(__float_as_uint(x), __float_as_uint(x), false, false); x = __uint_as_float(s[0]) + __uint_as_float(s[1]);
    auto t = __builtin_amdgcn_permlane32_swap(__float_as_uint(x), __float_as_uint(x), false, false); return __uint_as_float(t[0]) + __uint_as_float(t[1]); }
__device__ __forceinline__ float xrow_max(float x) {
    auto s = __builtin_amdgcn_permlane16_swap(__float_as_uint(x), __float_as_uint(x), false, false); x = fmaxf(__uint_as_float(s[0]), __uint_as_float(s[1]));
    auto t = __builtin_amdgcn_permlane32_swap(__float_as_uint(x), __float_as_uint(x), false, false); return fmaxf(__uint_as_float(t[0]), __uint_as_float(t[1])); }
__device__ __forceinline__ float wave_sum(float x) { return xrow_sum(sum16(x)); }
#define GAS __attribute__((address_space(1)))
typedef GAS unsigned gu32;
#define RLX_AGENT __ATOMIC_RELAXED, __HIP_MEMORY_SCOPE_AGENT
#define LDS_WAIT() asm volatile("s_waitcnt lgkmcnt(0)" ::: "memory")

struct Params {
    const float* in[30];
    float* out;
    unsigned char* ws;
};
#define STAGE_MIX 1
#define STAGE_CROSS 1
#define STAGE_PEER 1
#define GATHER_SYNC 0
#define GNT 4
#define GATHER_SPLIT 1
#define GATHER_VMMA 2
#define GATHER_UI4 1
#define VBUF4 1
#define UBUF4 1
#ifndef PG8_WGM
#define PG8_WGM 8
#endif
namespace pg8 {
#define PG8_LAS __attribute__((address_space(3)))
typedef unsigned short bf16_t;
typedef short bf16x8 __attribute__((ext_vector_type(8)));
typedef float f32x4 __attribute__((ext_vector_type(4)));
typedef unsigned u32x4 __attribute__((ext_vector_type(4)));
typedef int i32x8 __attribute__((ext_vector_type(8)));
typedef int i32x4 __attribute__((ext_vector_type(4)));
constexpr int BM = 256, BK = 64, HALF = 128, HTB = HALF * BK * 2  , STAGE_BYTES = 8 * HTB, NXCD = 8, WGM = PG8_WGM;

__host__ __device__ __forceinline__ int lds_byte(int r, int c) { const int st = (r >> 4) * 2 + (c >> 5), rr = r & 15, cc = c & 31, ob = rr * 64 + cc * 2; return st * 1024 + (ob ^ (((ob >> 9) & 1) << 5)); }
__host__ __device__ __forceinline__ void stage_rc(int b, int& R, int& C) { const int st = b / 1024, sb = b % 1024, swz = sb ^ (((sb >> 9) & 1) << 5); R = (st >> 1) * 16 + swz / 64; C = (st & 1) * 32 + (swz % 64) / 2; }
__host__ __device__ __forceinline__ int perm32(int rho) { const int n = rho >> 4, i = rho & 15; return 8 * (i >> 2) + 4 * n + (i & 3); }

struct Unit { int pm, pn; };
struct Gemm { const bf16_t* A; const bf16_t* Bt; int M, N, K; const float* sa; const float* sb; };

struct RowOrder {
    int nM, nN, G, c;
    __host__ __device__ void init(int M, int N, int G_, int c_) { nM = M / BM; nN = N / BM; G = G_; c = c_; }
    __host__ __device__ bool next(int i, Unit& u) const { const int pm = c + G * (i / nN); if (pm >= nM) return false; u.pm = pm; u.pn = (i + c) % nN; return true; }
    __device__ __forceinline__ void a_ready(const Unit&) const {}
    __device__ __forceinline__ void done(const Unit&) const {}
};
struct StaticOrder {
    int nM, nN, nwg, G, c;
    __host__ __device__ void init(int M, int N, int G_, int c_) { nM = M / BM; nN = N / BM; nwg = nM * nN; G = G_; c = c_; }
    __host__ __device__ bool next(int i, Unit& u) const {
        const long L = (long)i * G + c; if (L >= nwg) return false;
        int wgid = (int)L; { const int q = nwg / NXCD, r = nwg % NXCD, xcd = wgid % NXCD, off = wgid / NXCD; wgid = (xcd < r ? xcd * (q + 1) : r * (q + 1) + (xcd - r) * q) + off; }
        const int nig = WGM * nN, gid = wgid / nig, fm = gid * WGM, gsz = (nM - fm) < WGM ? (nM - fm) : WGM;
        u.pm = fm + ((wgid % nig) % gsz); u.pn = (wgid % nig) / gsz; return true;
    }
    __device__ __forceinline__ void a_ready(const Unit&) const {}
    __device__ __forceinline__ void done(const Unit&) const {}
};

__device__ __forceinline__ u32x4 pack8(const f32x4 v0, const f32x4 v1) { u32x4 w; w.x = pk_bf16(v0[0], v0[1]); w.y = pk_bf16(v0[2], v0[3]); w.z = pk_bf16(v1[0], v1[1]); w.w = pk_bf16(v1[2], v1[3]); return w; }
__device__ __forceinline__ f32x4 shfl4(const f32x4 v, int m) { f32x4 r; r[0] = __shfl_xor(v[0], m); r[1] = __shfl_xor(v[1], m); r[2] = __shfl_xor(v[2], m); r[3] = __shfl_xor(v[3], m); return r; }

struct EpiPlain {
    static constexpr bool PERM = true, AFTER_DRAIN = false;
    bf16_t* O; int ldc;
    __device__ __forceinline__ void operator()(const f32x4 (&acc)[2][2][4][2], const Unit& u, int wr, int wc, int fr, int fq) const {
        const int row0 = u.pm * BM + wr * 64 + fr, col0 = u.pn * BM + wc * 32 + 8 * fq;
#pragma unroll
        for (int ai = 0; ai < 2; ++ai)
#pragma unroll
            for (int m = 0; m < 4; ++m) { bf16_t* rowp = O + (size_t)(row0 + ai * HALF + m * 16) * ldc + col0;
#pragma unroll
                for (int bj = 0; bj < 2; ++bj) *(u32x4*)(rowp + bj * HALF) = pack8(acc[ai][bj][m][0], acc[ai][bj][m][1]); }
    }
};
struct EpiProj {
    static constexpr bool PERM = true, AFTER_DRAIN = false;
    bf16_t *Q, *Kb, *Vb, *RW; const bf16_t* rt; float qscale; int norope; float osc; int pn0, sk_lo, sk_n;
    __device__ __forceinline__ void operator()(const f32x4 (&acc)[2][2][4][2], const Unit& u, int wr, int wc, int fr, int fq) const {
        int pn = u.pn + pn0; if (pn >= sk_lo) pn += sk_n; bf16_t* base; int ldc, colt; bool rope = false; float sc = osc;
        if (pn < 4) { base = Q; ldc = 1024; colt = pn * 256; rope = true; sc = qscale * osc; }
        else if (pn == 4) { base = Kb; ldc = 256; colt = 0; rope = true; }
        else if (pn == 5) { base = Vb; ldc = 256; colt = 0; }
        else { base = RW; ldc = RW_W; colt = (pn - 6) * 256; }
        const int row0 = u.pm * BM + wr * 64 + fr, col0 = colt + wc * 32 + 8 * fq;
        const bool dorope = rope && ((wc & 1) == 0) && !norope;
        if (dorope) {
#pragma unroll
            for (int ai = 0; ai < 2; ++ai) {
                u32x4 tc[4], ts[4];
#pragma unroll
                for (int m = 0; m < 4; ++m) { const bf16_t* tp = rt + (size_t)(row0 + ai * HALF + m * 16) * 16; tc[m] = *(const u32x4*)tp; ts[m] = *(const u32x4*)(tp + 8); }
#pragma unroll
                for (int m = 0; m < 4; ++m) { const int row = row0 + ai * HALF + m * 16; bf16_t* rowp = base + (size_t)row * ldc + col0; const u32x4 cw = tc[m], sw = ts[m];
                    const f32x4 c0 = {bf_lo(cw.x), bf_hi(cw.x), bf_lo(cw.y), bf_hi(cw.y)}, c1 = {bf_lo(cw.z), bf_hi(cw.z), bf_lo(cw.w), bf_hi(cw.w)};
                    const f32x4 s0 = {bf_lo(sw.x), bf_hi(sw.x), bf_lo(sw.y), bf_hi(sw.y)}, s1 = {bf_lo(sw.z), bf_hi(sw.z), bf_lo(sw.w), bf_hi(sw.w)};
#pragma unroll
                    for (int bj = 0; bj < 2; ++bj) { f32x4 v0 = acc[ai][bj][m][0], v1 = acc[ai][bj][m][1]; f32x4 p0, p1;
#pragma unroll
                        for (int e = 0; e < 4; ++e) { const auto xa = __builtin_amdgcn_permlane16_swap(__float_as_uint(v0[e]), __float_as_uint(v0[e]), false, false); p0[e] = __uint_as_float((fq & 1) ? xa[0] : xa[1]);
                            const auto xb = __builtin_amdgcn_permlane16_swap(__float_as_uint(v1[e]), __float_as_uint(v1[e]), false, false); p1[e] = __uint_as_float((fq & 1) ? xb[0] : xb[1]); }
                        if (fq == 0) { v0 = v0 * c0 - p0 * s0; v1 = v1 * c1 - p1 * s1; }
                        else if (fq == 1) { v0 = v0 * c0 + p0 * s0; v1 = v1 * c1 + p1 * s1; }
                        *(u32x4*)(rowp + bj * HALF) = pack8(v0 * sc, v1 * sc); } } }
        } else {
#pragma unroll
            for (int ai = 0; ai < 2; ++ai)
#pragma unroll
                for (int m = 0; m < 4; ++m) { bf16_t* rowp = base + (size_t)(row0 + ai * HALF + m * 16) * ldc + col0;
#pragma unroll
                    for (int bj = 0; bj < 2; ++bj) *(u32x4*)(rowp + bj * HALF) = pack8(acc[ai][bj][m][0] * sc, acc[ai][bj][m][1] * sc); }
        }
    }
};
struct EpiGate {
    static constexpr bool PERM = true, AFTER_DRAIN = false;
    bf16_t* MX; const bf16_t* Y; int useA, useB; float nk;
    __device__ __forceinline__ void operator()(const f32x4 (&acc)[2][2][4][2], const Unit& u, int wr, int wc, int fr, int fq) const {
        const int row0 = u.pm * BM + wr * 64 + fr, ch0 = u.pn * HALF + wc * 32 + 8 * fq;
#pragma unroll
        for (int ai = 0; ai < 2; ++ai)
#pragma unroll
            for (int m = 0; m < 4; ++m) { const size_t off = (size_t)(row0 + ai * HALF + m * 16) * D_MODEL + ch0;
                const u32x4 av = useA ? *(const u32x4*)(MX + off) : (u32x4){0u, 0u, 0u, 0u}; const u32x4 yv = useB ? *(const u32x4*)(Y + off) : (u32x4){0u, 0u, 0u, 0u};
                f32x4 o0, o1;
#pragma unroll
                for (int e = 0; e < 4; ++e) {
                    const float a0 = (e & 1) ? bf_hi(av[e >> 1]) : bf_lo(av[e >> 1]), a1 = (e & 1) ? bf_hi(av[2 + (e >> 1)]) : bf_lo(av[2 + (e >> 1)]);
                    const float y0 = (e & 1) ? bf_hi(yv[e >> 1]) : bf_lo(yv[e >> 1]), y1 = (e & 1) ? bf_hi(yv[2 + (e >> 1)]) : bf_lo(yv[2 + (e >> 1)]);
                    o0[e] = fast_rcp(1.f + fast_exp2(nk * acc[ai][0][m][0][e])) * a0 + fast_rcp(1.f + fast_exp2(nk * acc[ai][1][m][0][e])) * y0;
                    o1[e] = fast_rcp(1.f + fast_exp2(nk * acc[ai][0][m][1][e])) * a1 + fast_rcp(1.f + fast_exp2(nk * acc[ai][1][m][1][e])) * y1; }
                *(u32x4*)(MX + off) = pack8(o0, o1); }
    }
};
template <bool RES_F32> struct EpiRes {
    static constexpr bool PERM = true, AFTER_DRAIN = false;
    const float* xres; bf16_t* H; float* ssq; float amp;
    __device__ __forceinline__ void operator()(const f32x4 (&acc)[2][2][4][2], const Unit& u, int wr, int wc, int fr, int fq) const {
        const int row0 = u.pm * BM + wr * 64 + fr, col0 = u.pn * BM + wc * 32 + 8 * fq;
#pragma unroll
        for (int ai = 0; ai < 2; ++ai)
#pragma unroll
            for (int m = 0; m < 4; ++m) { const int row = row0 + ai * HALF + m * 16; float ss = 0.f;
#pragma unroll
                for (int bj = 0; bj < 2; ++bj) { const size_t off = (size_t)row * D_MODEL + col0 + bj * HALF; f32x4 r0, r1;
                    if (RES_F32) { r0 = *(const f32x4*)(xres + off); r1 = *(const f32x4*)(xres + off + 4); }
                    else { const u32x4 hv = *(const u32x4*)(H + off); r0 = (f32x4){bf_lo(hv.x), bf_hi(hv.x), bf_lo(hv.y), bf_hi(hv.y)}; r1 = (f32x4){bf_lo(hv.z), bf_hi(hv.z), bf_lo(hv.w), bf_hi(hv.w)}; }
                    const f32x4 v0 = acc[ai][bj][m][0] * amp + r0, v1 = acc[ai][bj][m][1] * amp + r1;
                    ss += (v0[0] * v0[0] + v0[1] * v0[1]) + (v0[2] * v0[2] + v0[3] * v0[3]) + (v1[0] * v1[0] + v1[1] * v1[1]) + (v1[2] * v1[2] + v1[3] * v1[3]);
                    *(u32x4*)(H + off) = pack8(v0, v1); }
                ss += __shfl_xor(ss, 16); ss += __shfl_xor(ss, 32);
                if (fq == 0) ssq[(size_t)row * 16 + u.pn * 4 + wc] = ss; }
    }
};
struct EpiScaled {
    static constexpr bool PERM = true, AFTER_DRAIN = false;
    bf16_t* O; int ldc; const float* ssq; float mul;
    __device__ __forceinline__ void operator()(const f32x4 (&acc)[2][2][4][2], const Unit& u, int wr, int wc, int fr, int fq) const {
        const int row0 = u.pm * BM + wr * 64 + fr, col0 = u.pn * BM + wc * 32 + 8 * fq;
#pragma unroll
        for (int ai = 0; ai < 2; ++ai)
#pragma unroll
            for (int m = 0; m < 4; ++m) { const int row = row0 + ai * HALF + m * 16; const f32x4* sp = (const f32x4*)(ssq + (size_t)row * 16);
                const f32x4 a = sp[0], b = sp[1], c = sp[2], d = sp[3]; const f32x4 t = (a + b) + (c + d);
                const float rstd = mul / sqrtf(((t[0] + t[1]) + (t[2] + t[3])) * (1.f / D_MODEL) + RMS_EPS);
                bf16_t* rowp = O + (size_t)row * ldc + col0;
#pragma unroll
                for (int bj = 0; bj < 2; ++bj) *(u32x4*)(rowp + bj * HALF) = pack8(acc[ai][bj][m][0] * rstd, acc[ai][bj][m][1] * rstd); }
    }
};
template <class Epi, class Sched, bool ALIGN_EPI = false, bool SP2 = false, int FP8 = 0>
__device__ __forceinline__ void gemm_phase(PG8_LAS unsigned char* lds, const Gemm g, const Sched& S, const Epi& E) {
    int tid_ = threadIdx.x; asm volatile("" : "+v"(tid_));
    const int tid = tid_, wid = __builtin_amdgcn_readfirstlane(tid >> 6), lane = tid & 63, wr = wid >> 2, wc = wid & 3, fr = lane & 15, fq = lane >> 4;
    const int K = g.K, nt = K / BK;
    unsigned voffA[2], voffB[2];
#pragma unroll
    for (int i = 0; i < 2; ++i) { int R, C; stage_rc(tid * 16 + i * 8192, R, C); const int Rb = Epi::PERM ? ((R & ~31) + perm32(R & 31)) : R;
        voffA[i] = (unsigned)(R * K + C) * 2u; voffB[i] = (unsigned)(Rb * K + C) * 2u; }
    const size_t kstep = (size_t)(BK * 2);
    const size_t hstep = (size_t)HALF * K * 2;
    const size_t tstep = 2 * hstep;
    const unsigned ldsw = (unsigned)wid * 1024u;
    const int aoff = lds_byte(wr * 64 + fr, fq * 8), boff = lds_byte(wc * 32 + fr, fq * 8);
#define PG8_SA(b, h) (((b) * 2 + (h)) * HTB)
#define PG8_SB(b, h) ((4 + (b) * 2 + (h)) * HTB)
#define PG8_STAGE(bufoff, gbase, voff) do { _Pragma("unroll") for (int _i = 0; _i < 2; ++_i) \
        __builtin_amdgcn_global_load_lds((const unsigned*)((const char*)(gbase) + (voff)[_i]), (PG8_LAS unsigned*)(lds + (bufoff) + ldsw + _i * 8192), 16, 0, 0); } while (0)
#define PG8_LDA(dst, b, h) do { _Pragma("unroll") for (int m = 0; m < 4; ++m) _Pragma("unroll") for (int k = 0; k < 2; ++k) dst[m][k] = *(const PG8_LAS bf16x8*)(lds + PG8_SA(b, h) + aoff + m * 2048 + k * 1024); } while (0)
#define PG8_LDB(dst, b, h) do { _Pragma("unroll") for (int n = 0; n < 2; ++n) _Pragma("unroll") for (int k = 0; k < 2; ++k) dst[n][k] = *(const PG8_LAS bf16x8*)(lds + PG8_SB(b, h) + boff + n * 2048 + k * 1024); } while (0)
#define PG8_MMA(ai, bj, At, Bt) do { __builtin_amdgcn_s_setprio(1); _Pragma("unroll") for (int m = 0; m < 4; ++m) _Pragma("unroll") for (int n = 0; n < 2; ++n) { \
        if constexpr (FP8 == 2) { } \
        else if constexpr (FP8 == 1) { const i32x8 bb_ = __builtin_shufflevector(__builtin_bit_cast(i32x4, Bt[n][0]), __builtin_bit_cast(i32x4, Bt[n][1]), 0, 1, 2, 3, 4, 5, 6, 7), \
                                         aa_ = __builtin_shufflevector(__builtin_bit_cast(i32x4, At[m][0]), __builtin_bit_cast(i32x4, At[m][1]), 0, 1, 2, 3, 4, 5, 6, 7); \
            asm volatile("v_mfma_f32_16x16x128_f8f6f4 %0, %1, %2, %0" : "+v"(acc[ai][bj][m][n]) : "v"(bb_), "v"(aa_)); } \
        else { _Pragma("unroll") for (int k = 0; k < 2; ++k) acc[ai][bj][m][n] = __builtin_amdgcn_mfma_f32_16x16x32_bf16(Bt[n][k], At[m][k], acc[ai][bj][m][n], 0, 0, 0); } } \
        if constexpr (FP8 == 2) { _Pragma("unroll") for (int k = 0; k < 2; ++k) _Pragma("unroll") for (int m = 0; m < 4; ++m) _Pragma("unroll") for (int n = 0; n < 2; ++n) \
            asm volatile("v_mfma_i32_16x16x64_i8 %0, %1, %2, %0" : "+v"(acc[ai][bj][m][n]) : "v"(__builtin_bit_cast(i32x4, Bt[n][k])), "v"(__builtin_bit_cast(i32x4, At[m][k]))); } \
        __builtin_amdgcn_s_setprio(0); } while (0)
#define PG8_WAIT_V(n) asm volatile("s_waitcnt vmcnt(" #n ")" ::: "memory")
#define PG8_WAIT_L(n) asm volatile("s_waitcnt lgkmcnt(" #n ")" ::: "memory")
#define PG8_BAR __builtin_amdgcn_s_barrier()
#define PG8_SCHED __builtin_amdgcn_sched_barrier(0)
    Unit cur, nxt; int ui = 0;
    if (!S.next(0, cur)) return;
    f32x4 acc[2][2][4][2];
#pragma unroll
    for (int a = 0; a < 2; ++a)
#pragma unroll
        for (int b = 0; b < 2; ++b)
#pragma unroll
            for (int m = 0; m < 4; ++m)
#pragma unroll
                for (int n = 0; n < 2; ++n) acc[a][b][m][n] = (f32x4){0.f, 0.f, 0.f, 0.f};
    bf16x8 At[4][2], B0[2][2], B1[2][2];
    const char* cA = (const char*)g.A + (size_t)cur.pm * tstep; const char* cB = (const char*)g.Bt + (size_t)cur.pn * tstep;
    S.a_ready(cur);
    if constexpr (SP2) {
        PG8_STAGE(PG8_SB(0, 0), cB, voffB); PG8_STAGE(PG8_SB(0, 1), cB + hstep, voffB); PG8_STAGE(PG8_SA(0, 0), cA, voffA); PG8_STAGE(PG8_SA(0, 1), cA + hstep, voffA);
        if (wr == 1) PG8_BAR;
        PG8_WAIT_V(2); PG8_BAR;
        PG8_STAGE(PG8_SB(1, 0), cB + kstep, voffB); PG8_STAGE(PG8_SA(1, 0), cA + kstep, voffA); PG8_STAGE(PG8_SB(1, 1), cB + hstep + kstep, voffB);
        PG8_WAIT_V(6); PG8_BAR;
    } else {
        PG8_STAGE(PG8_SB(0, 0), cB, voffB); PG8_STAGE(PG8_SA(0, 0), cA, voffA); PG8_STAGE(PG8_SB(0, 1), cB + hstep, voffB); PG8_STAGE(PG8_SA(0, 1), cA + hstep, voffA);
        if (wr == 1) PG8_BAR;
        PG8_WAIT_V(4); PG8_BAR;
        PG8_STAGE(PG8_SB(1, 0), cB + kstep, voffB); PG8_STAGE(PG8_SA(1, 0), cA + kstep, voffA); PG8_STAGE(PG8_SB(1, 1), cB + hstep + kstep, voffB);
        PG8_WAIT_V(6); PG8_BAR;
    }
    for (;;) {
        float ps0 = 0.f, ps1 = 0.f, pc = 0.f;
        if constexpr (FP8 == 2) { const float* sap_ = g.sa + cur.pm * 256 + wr * 64 + lane; ps0 = sap_[0]; ps1 = sap_[128]; pc = g.sb[cur.pn * 256 + (lane >> 5) * 128 + wc * 32 + (lane & 31)]; }
        const bool has_next = S.next(ui + 1, nxt);
        const char* nA = has_next ? (const char*)g.A + (size_t)nxt.pm * tstep : cA; const char* nB = has_next ? (const char*)g.Bt + (size_t)nxt.pn * tstep : cB;
#pragma clang loop unroll(disable)
        for (int t = 0; t < nt; t += 2) {
            const bool last = (t == nt - 2);
            const char* a1 = cA + (size_t)(t + 1) * kstep;
            const char* a2 = last ? nA : cA + (size_t)(t + 2) * kstep; const char* b2 = last ? nB : cB + (size_t)(t + 2) * kstep;
            const char* a3 = a2 + kstep; const char* b3 = b2 + kstep;
            if (last && has_next) S.a_ready(nxt);
            if constexpr (SP2) {
            PG8_LDB(B0, 0, 0); PG8_LDB(B1, 0, 1); PG8_SCHED; PG8_LDA(At, 0, 0); PG8_STAGE(PG8_SA(1, 1), a1 + hstep, voffA);
            PG8_WAIT_V(8); PG8_WAIT_L(0); PG8_BAR; PG8_MMA(0, 0, At, B0); PG8_MMA(0, 1, At, B1); PG8_BAR; PG8_SCHED;
            PG8_LDA(At, 0, 1); PG8_STAGE(PG8_SB(0, 0), b2, voffB); PG8_STAGE(PG8_SB(0, 1), b2 + hstep, voffB); PG8_STAGE(PG8_SA(0, 0), a2, voffA);
            PG8_WAIT_V(8); PG8_WAIT_L(0); PG8_BAR; PG8_MMA(1, 0, At, B0); PG8_MMA(1, 1, At, B1); PG8_BAR; PG8_SCHED;
            PG8_LDB(B0, 1, 0); PG8_LDB(B1, 1, 1); PG8_SCHED; PG8_LDA(At, 1, 0); PG8_STAGE(PG8_SA(0, 1), a2 + hstep, voffA);
            PG8_WAIT_V(8); PG8_WAIT_L(0); PG8_BAR; PG8_MMA(0, 0, At, B0); PG8_MMA(0, 1, At, B1); PG8_BAR; PG8_SCHED;
            PG8_LDA(At, 1, 1); PG8_STAGE(PG8_SB(1, 0), b3, voffB); PG8_STAGE(PG8_SB(1, 1), b3 + hstep, voffB); PG8_STAGE(PG8_SA(1, 0), a3, voffA);
            PG8_WAIT_V(8); PG8_WAIT_L(0); PG8_BAR; PG8_MMA(1, 0, At, B0); PG8_MMA(1, 1, At, B1); PG8_BAR; PG8_SCHED;
            } else {
            PG8_LDB(B0, 0, 0); PG8_SCHED; PG8_LDA(At, 0, 0); PG8_STAGE(PG8_SA(1, 1), a1 + hstep, voffA);
            PG8_WAIT_L(8); PG8_BAR; PG8_WAIT_L(0); PG8_MMA(0, 0, At, B0); PG8_BAR; PG8_SCHED;
            PG8_LDB(B1, 0, 1); PG8_STAGE(PG8_SB(0, 0), b2, voffB);
            PG8_BAR; PG8_WAIT_L(0); PG8_MMA(0, 1, At, B1); PG8_BAR;
            PG8_LDA(At, 0, 1); PG8_STAGE(PG8_SA(0, 0), a2, voffA);
            PG8_BAR; PG8_WAIT_L(0); PG8_MMA(1, 0, At, B0); PG8_BAR; PG8_SCHED;
            PG8_STAGE(PG8_SB(0, 1), b2 + hstep, voffB);
            PG8_WAIT_V(6); PG8_BAR; PG8_MMA(1, 1, At, B1); PG8_BAR;
            PG8_LDB(B0, 1, 0); PG8_SCHED; PG8_LDA(At, 1, 0); PG8_STAGE(PG8_SA(0, 1), a2 + hstep, voffA);
            PG8_WAIT_L(8); PG8_BAR; PG8_WAIT_L(0); PG8_MMA(0, 0, At, B0); PG8_BAR; PG8_SCHED;
            PG8_LDB(B1, 1, 1); PG8_STAGE(PG8_SB(1, 0), b3, voffB);
            PG8_BAR; PG8_WAIT_L(0); PG8_MMA(0, 1, At, B1); PG8_BAR;
            PG8_LDA(At, 1, 1); PG8_STAGE(PG8_SA(1, 0), a3, voffA);
            PG8_BAR; PG8_WAIT_L(0); PG8_MMA(1, 0, At, B0); PG8_BAR; PG8_SCHED;
            PG8_STAGE(PG8_SB(1, 1), b3 + hstep, voffB);
            PG8_WAIT_V(6); PG8_BAR; PG8_MMA(1, 1, At, B1); PG8_BAR;
            }
        }
        if constexpr (ALIGN_EPI) { if (wr == 0) PG8_BAR; }
        if constexpr (!Epi::AFTER_DRAIN) {
            if constexpr (FP8 != 0) { int fr_ = fr, fq_ = fq; asm volatile("s_nop 15\n\ts_nop 15" : "+v"(fr_), "+v"(fq_));
                _Pragma("unroll") for (int a = 0; a < 2; ++a) _Pragma("unroll") for (int b = 0; b < 2; ++b) _Pragma("unroll") for (int m = 0; m < 4; ++m) _Pragma("unroll") for (int n = 0; n < 2; ++n) asm volatile("" : "+v"(acc[a][b][m][n]));
                if constexpr (FP8 == 2) {
                    f32x4 cs[2][2]; float rs[2][4];
                    _Pragma("unroll") for (int b = 0; b < 2; ++b) _Pragma("unroll") for (int n = 0; n < 2; ++n) _Pragma("unroll") for (int e = 0; e < 4; ++e)
                        cs[b][n][e] = __uint_as_float((unsigned)__builtin_amdgcn_ds_bpermute(4 * (b * 32 + 8 * fq_ + 4 * n + e), (int)__float_as_uint(pc)));
                    _Pragma("unroll") for (int a = 0; a < 2; ++a) _Pragma("unroll") for (int m = 0; m < 4; ++m)
                        rs[a][m] = __uint_as_float((unsigned)__builtin_amdgcn_ds_bpermute(4 * (m * 16 + fr_), (int)__float_as_uint(a ? ps1 : ps0)));
                    _Pragma("unroll") for (int a = 0; a < 2; ++a) _Pragma("unroll") for (int b = 0; b < 2; ++b) _Pragma("unroll") for (int m = 0; m < 4; ++m) _Pragma("unroll") for (int n = 0; n < 2; ++n) {
                        const i32x4 ai_ = __builtin_bit_cast(i32x4, acc[a][b][m][n]); const f32x4 t_ = {(float)ai_[0], (float)ai_[1], (float)ai_[2], (float)ai_[3]};
                        acc[a][b][m][n] = (t_ * rs[a][m]) * cs[b][n]; } }
                E(acc, cur, wr, wc, fr_, fq_); }
            else E(acc, cur, wr, wc, fr, fq);
            S.done(cur); }
        if (!has_next) break;
#pragma unroll
        for (int a = 0; a < 2; ++a)
#pragma unroll
            for (int b = 0; b < 2; ++b)
#pragma unroll
                for (int m = 0; m < 4; ++m)
#pragma unroll
                    for (int n = 0; n < 2; ++n) acc[a][b][m][n] = (f32x4){0.f, 0.f, 0.f, 0.f};
        cur = nxt; cA = nA; cB = nB; ++ui;
        if constexpr (ALIGN_EPI) { if (wr == 1) PG8_BAR; }
    }
    PG8_WAIT_V(0);
    if constexpr (!ALIGN_EPI) { if (wr == 0) PG8_BAR; }
    PG8_BAR;
    if constexpr (Epi::AFTER_DRAIN) { E.fused(acc, cur, wr, wc, fr, fq, lds, wid, lane); S.done(cur); }
#undef PG8_SA
#undef PG8_SB
#undef PG8_STAGE
#undef PG8_LDA
#undef PG8_LDB
#undef PG8_MMA
#undef PG8_WAIT_V
#undef PG8_WAIT_L
#undef PG8_BAR
#undef PG8_SCHED
}
}
#ifndef GATHER_VMMA
#define GATHER_VMMA 0
#endif
#ifndef GATHER_UI4
#define GATHER_UI4 0
#endif
constexpr int PU_ROWB = GATHER_UI4 ? 512 : 1024; constexpr float PU_QS = 91.2f;
#ifndef V6_DIAG_FP8
#define V6_DIAG_FP8 0
#endif
constexpr int PV_ROWB = (GATHER_VMMA == 2 && !V6_DIAG_FP8) ? 768 : 1024; constexpr float PV_SCALE = (GATHER_VMMA == 2 && !V6_DIAG_FP8) ? 5.5f : 64.f;
template <int MODE  >
__device__ __forceinline__ void transpose_item(const float* W, int ldw, int c0, int K, int N, bf16_t* WT, const float* gain, LAS float* scr, int item, int lane, const unsigned* wam = nullptr, float* sw = nullptr) {
    const int nblk = N / 32, kb = item / nblk, nb = item % nblk, k0 = 64 * kb, n0 = 32 * nb;
#pragma unroll
    for (int i = 0; i < 32; ++i) { const int kk = 2 * i + (lane >> 5); float v = W[(size_t)(k0 + kk) * ldw + c0 + n0 + (lane & 31)]; if (gain) v *= gain[k0 + kk]; scr[kk * 33 + (lane & 31)] = v; }
    LDS_WAIT(); asm volatile("" ::: "memory");
    const int c = lane & 7;
    int rbase = n0;
    if (MODE == 1 || MODE == 2 || MODE == 6) { const int isB = n0 >> 10, ch = n0 & 1023; rbase = 256 * (ch >> 7) + 128 * isB + (ch & 127); }
#pragma unroll
    for (int j = 0; j < 4; ++j) { const int n = (lane >> 3) + 8 * j; const LAS float* s = scr + (8 * c) * 33 + n;
        if (MODE >= 5) { const float am = __uint_as_float(__hip_atomic_load(wam + c0 + n0 + n, __ATOMIC_RELAXED, __HIP_MEMORY_SCOPE_AGENT)); const float inv = am > 0.f ? 127.f / am : 0.f;
            const unsigned w0 = pack_i8x4(s[0 * 33] * inv, s[1 * 33] * inv, s[2 * 33] * inv, s[3 * 33] * inv), w1 = pack_i8x4(s[4 * 33] * inv, s[5 * 33] * inv, s[6 * 33] * inv, s[7 * 33] * inv);
            *(u32x2*)((unsigned char*)WT + (size_t)(rbase + n) * K + k0 + 8 * c) = (u32x2){w0, w1};
            if (c == 0 && k0 == 0) sw[rbase + n] = am * (1.f / 127.f); }
        else if (MODE >= 2) { constexpr float WS8 = (MODE == 2 || MODE == 4) ? GATE_WSCALE : CROSS_WSCALE; int w0 = __builtin_amdgcn_cvt_pk_fp8_f32(s[0 * 33] * WS8, s[1 * 33] * WS8, 0, false); w0 = __builtin_amdgcn_cvt_pk_fp8_f32(s[2 * 33] * WS8, s[3 * 33] * WS8, w0, true);
            int w1 = __builtin_amdgcn_cvt_pk_fp8_f32(s[4 * 33] * WS8, s[5 * 33] * WS8, 0, false); w1 = __builtin_amdgcn_cvt_pk_fp8_f32(s[6 * 33] * WS8, s[7 * 33] * WS8, w1, true);
            *(u32x2*)((unsigned char*)WT + (size_t)(rbase + n) * K + k0 + 8 * c) = (u32x2){(unsigned)w0, (unsigned)w1}; }
        else { u32x4 o; o.x = pk_bf16(s[0 * 33], s[1 * 33]); o.y = pk_bf16(s[2 * 33], s[3 * 33]); o.z = pk_bf16(s[4 * 33], s[5 * 33]); o.w = pk_bf16(s[6 * 33], s[7 * 33]);
            *(u32x4*)(WT + (size_t)(rbase + n) * K + k0 + 8 * c) = o; } }
    LDS_WAIT(); asm volatile("" ::: "memory");
}
__device__ __forceinline__ void rms_row_to_bf16(const float* xrow, const float* gain, bf16_t* orow, int lane) {
    const f32x4* xr = (const f32x4*)xrow + lane; const f32x4* gr = (const f32x4*)gain + lane;
    f32x4 v[4]; float s = 0.f;
#pragma unroll
    for (int j = 0; j < 4; ++j) { v[j] = xr[64 * j]; s += (v[j].x * v[j].x + v[j].y * v[j].y) + (v[j].z * v[j].z + v[j].w * v[j].w); }
    const float rstd = 1.f / sqrtf(wave_sum(s) * (1.f / D_MODEL) + RMS_EPS);
    u32x2* o8 = (u32x2*)orow + lane;
#pragma unroll
    for (int j = 0; j < 4; ++j) { const f32x4 g = gr[64 * j]; u32x2 w; w.x = pk_bf16(v[j].x * rstd * g.x, v[j].y * rstd * g.y); w.y = pk_bf16(v[j].z * rstd * g.z, v[j].w * rstd * g.w); o8[64 * j] = w; }
}
__device__ __forceinline__ void cvt_row_to_bf16(const float* xrow, const float* gain, bf16_t* orow, int lane) {
    const f32x4* xr = (const f32x4*)xrow + lane; u32x2* o8 = (u32x2*)orow + lane;
#pragma unroll
    for (int j = 0; j < 4; ++j) { f32x4 v = xr[64 * j]; if (gain) v = v * ((const f32x4*)gain + lane)[64 * j]; u32x2 w; w.x = pk_bf16(v.x, v.y); w.y = pk_bf16(v.z, v.w); o8[64 * j] = w; }
}
__device__ __forceinline__ bf16_t bf16_of_(float v) { return (bf16_t)(pk_bf16(v, 0.f) & 0xffffu); }
__device__ __forceinline__ void cvt_row_to_fp8(const float* xrow, const float* gain, float scale, unsigned char* orow, int lane) {
    const f32x4* xr = (const f32x4*)(xrow + 16 * lane); u32x4 o;
#pragma unroll
    for (int q = 0; q < 4; ++q) { f32x4 v = xr[q] * scale; if (gain) v = v * ((const f32x4*)(gain + 16 * lane))[q];
        int w = __builtin_amdgcn_cvt_pk_fp8_f32(v.x, v.y, 0, false); w = __builtin_amdgcn_cvt_pk_fp8_f32(v.z, v.w, w, true); o[q] = (unsigned)w; }
    *(u32x4*)(orow + 16 * lane) = o;
}
__device__ __forceinline__ void cvt_row_to_fp6_planes(const float* xrow, float scale, unsigned char* orow, int n) {
    const f32x4* xr = (const f32x4*)(xrow + 32 * n); u32x16 w;
#pragma unroll
    for (int q = 0; q < 8; ++q) { const f32x4 v = xr[q] * scale; w[2 * q] = pk_bf16(v.x, v.y); w[2 * q + 1] = pk_bf16(v.z, v.w); }
    const u32x6 r = __builtin_amdgcn_cvt_scalef32_pk32_fp6_bf16(__builtin_bit_cast(bf16x32_t, w), 1.0f);
    *(u32x4*)(orow + 16 * n) = (u32x4){r[0], r[1], r[2], r[3]}; *(u32x2*)(orow + 512 + 8 * n) = (u32x2){r[4], r[5]};
}
__device__ __forceinline__ void cvt_row_to_i4(const float* xrow, const float* gain, float scale, unsigned char* orow, int n) {
    const f32x4* xr = (const f32x4*)(xrow + 32 * n); const f32x4* gr = (const f32x4*)(gain + 32 * n); u32x4 o;
#pragma unroll
    for (int d = 0; d < 4; ++d) { const f32x4 a = xr[2 * d] * gr[2 * d] * scale, b = xr[2 * d + 1] * gr[2 * d + 1] * scale; unsigned w = 0u;
#pragma unroll
        for (int k = 0; k < 4; ++k) { const int qa = (int)fminf(fmaxf(rintf(a[k]), -7.f), 7.f), qb = (int)fminf(fmaxf(rintf(b[k]), -7.f), 7.f);
            w |= ((unsigned)qa & 15u) << (8 * k) | ((unsigned)qb & 15u) << (8 * k + 4); }
        o[d] = w; }
    *(u32x4*)(orow + 16 * n) = o;
}
#ifndef TABLES_LATE
#define TABLES_LATE 0
#endif
__device__ __forceinline__ void peer_tables_lowp(const Params& p, int wave, int lane) {
    unsigned char* ws = p.ws; const int gw = blockIdx.x * NWAVES + wave, NGW = gridDim.x * NWAVES; (void)ws; (void)gw; (void)NGW;
#if GATHER_UI4
    for (int m0 = 2 * gw; m0 < N_EXPERTS; m0 += 2 * NGW) { const int m = m0 + (lane >> 5);
        cvt_row_to_i4(p.in[27] + (size_t)m * D_MODEL, p.in[23], PU_QS, ws + WS_PU + (size_t)m * PU_ROWB, lane & 31); }
#endif
#if GATHER_VMMA == 2 && !V6_DIAG_FP8
    for (int m0 = 2 * gw; m0 < N_EXPERTS; m0 += 2 * NGW) { const int m = m0 + (lane >> 5);
        cvt_row_to_fp6_planes(p.in[28] + (size_t)m * D_MODEL, PV_SCALE, ws + WS_PV + (size_t)m * PV_ROWB, lane & 31); }
#endif
}
__device__ __forceinline__ void quant_tile_rows_i8(const bf16_t* src, unsigned char* dst8, float* sxo, int pm, int wave, int lane) {
    for (int r0 = wave * 32; r0 < wave * 32 + 32; r0 += 8) {
        u32x4 h[8][2];
#pragma unroll
        for (int r = 0; r < 8; ++r) { const bf16_t* hr = src + (size_t)(pm * 256 + r0 + r) * D_MODEL + 8 * lane; h[r][0] = *(const u32x4*)hr; h[r][1] = *(const u32x4*)(hr + 512); }
#pragma unroll
        for (int r = 0; r < 8; ++r) { const size_t row = (size_t)pm * 256 + r0 + r; float f[16];
#pragma unroll
            for (int q = 0; q < 2; ++q) { f[8 * q + 0] = bf_lo(h[r][q].x); f[8 * q + 1] = bf_hi(h[r][q].x); f[8 * q + 2] = bf_lo(h[r][q].y); f[8 * q + 3] = bf_hi(h[r][q].y); f[8 * q + 4] = bf_lo(h[r][q].z); f[8 * q + 5] = bf_hi(h[r][q].z); f[8 * q + 6] = bf_lo(h[r][q].w); f[8 * q + 7] = bf_hi(h[r][q].w); }
            float am = 0.f;
#pragma unroll
            for (int e = 0; e < 16; ++e) am = fmaxf(am, fabsf(f[e]));
            am = wave_max(am); const float inv = am > 0.f ? 127.f / am : 0.f;
            unsigned char* o8 = dst8 + row * D_MODEL + 8 * lane;
            *(u32x2*)o8 = (u32x2){pack_i8x4(f[0] * inv, f[1] * inv, f[2] * inv, f[3] * inv), pack_i8x4(f[4] * inv, f[5] * inv, f[6] * inv, f[7] * inv)};
            *(u32x2*)(o8 + 512) = (u32x2){pack_i8x4(f[8] * inv, f[9] * inv, f[10] * inv, f[11] * inv), pack_i8x4(f[12] * inv, f[13] * inv, f[14] * inv, f[15] * inv)};
            if (lane == 0) sxo[row] = am * (1.f / 127.f); } }
}
__device__ __forceinline__ void p0_prologue(const Params& p, LAS unsigned char* lds, int wave, int lane) {
    LAS float* scr = (LAS float*)(lds + wave * 16384);
    const int gw = blockIdx.x * NWAVES + wave, NGW = gridDim.x * NWAVES;
    unsigned char* ws = p.ws;
#if PROJ_I8
    {
        unsigned* wam = (unsigned*)(ws + CTL_WAMAX);
        for (int it = gw; it < 16 * (IN_WIDTH / 64); it += NGW) { const int kb = it / (IN_WIDTH / 64), cb = it % (IN_WIDTH / 64); const float* wp = p.in[4] + (size_t)(64 * kb) * IN_WIDTH + 64 * cb + lane; float m = 0.f;
#pragma unroll 32
            for (int k = 0; k < 64; ++k) m = fmaxf(m, fabsf(wp[(size_t)k * IN_WIDTH]));
            __hip_atomic_fetch_max(wam + 64 * cb + lane, __float_as_uint(m), __ATOMIC_RELAXED, __HIP_MEMORY_SCOPE_AGENT); }
#if PQ_I8
        {   unsigned* wam2 = (unsigned*)(ws + CTL_WAMAX2); const int nI = 16 * (IN_WIDTH / 64);
            for (int it = (gw - nI % NGW + NGW) % NGW; it < 16 * 32; it += NGW) { const int kb = it / 32, cb = it % 32; const float* wp = p.in[24] + (size_t)(64 * kb) * 2048 + 64 * cb + lane; const float* gp = p.in[23] + 64 * kb; float m = 0.f;
#pragma unroll 32
                for (int k = 0; k < 64; ++k) m = fmaxf(m, fabsf(wp[(size_t)k * 2048] * gp[k]));
                __hip_atomic_fetch_max(wam2 + 64 * cb + lane, __float_as_uint(m), __ATOMIC_RELAXED, __HIP_MEMORY_SCOPE_AGENT); } }
#endif
#if G2_I8
        {   unsigned* wam3 = (unsigned*)(ws + CTL_WAMAX3); const int nI = 16 * (IN_WIDTH / 64) + (PQ_I8 ? 16 * 32 : 0);
            for (int it = (gw - nI % NGW + NGW) % NGW; it < 16 * 16; it += NGW) { const int kb = it / 16, cb = it % 16; const float* wp = p.in[17] + (size_t)(64 * kb) * 1024 + 64 * cb + lane; float m = 0.f;
#pragma unroll 32
                for (int k = 0; k < 64; ++k) m = fmaxf(m, fabsf(wp[(size_t)k * 1024]));
                __hip_atomic_fetch_max(wam3 + 64 * cb + lane, __float_as_uint(m), __ATOMIC_RELAXED, __HIP_MEMORY_SCOPE_AGENT); } }
#endif
        __syncthreads();
        if (threadIdx.x == 0) { __threadfence(); __hip_atomic_fetch_add((unsigned*)(ws + CTL_WARRIVE), 1u, __ATOMIC_RELEASE, __HIP_MEMORY_SCOPE_AGENT); }
    }
#endif
    int base = 0;
#define TJOB(MODE, W, LDW, C0, KK, NN, WT, GAIN) do { const int nitems_ = ((KK) / 64) * ((NN) / 32); const int first_ = (gw - base % NGW + NGW) % NGW; \
        for (int it = first_; it < nitems_; it += NGW) transpose_item<MODE>((W), (LDW), (C0), (KK), (NN), (bf16_t*)(ws + (WT)), (GAIN), scr, it, lane); base += nitems_; } while (0)
#if PROJ_I8
#elif PROJ_FP8 == 3
    TJOB(4, p.in[4], IN_WIDTH, 0, 1024, 256 * PROJ_SK_LO, WS_WINA, nullptr);
    TJOB(4, p.in[4], IN_WIDTH, 256 * (PROJ_SK_LO + PROJ_SK_N), 1024, N_PROJA - 256 * (PROJ_SK_LO + PROJ_SK_N), WS_WINA + (size_t)256 * PROJ_SK_LO * 1024, nullptr);
    TJOB(0, p.in[4], IN_WIDTH, 256 * PROJ_SK_LO, 1024, 256 * PROJ_SK_N, WS_WINA + (size_t)(N_PROJA - 256 * PROJ_SK_N) * 1024, nullptr);
#elif PROJ_FP8 == 2
#define PROJ_TJ(LO, HI, F8) TJOB((F8) ? 4 : 0, p.in[4], IN_WIDTH, 256 * (LO), 1024, 256 * ((HI) - (LO)), WS_WINA + (size_t)(LO) * 256 * 2048, nullptr)
    PROJ_RUNS(PROJ_TJ);
#undef PROJ_TJ
#else
    TJOB(PROJ_FP8 ? 4 : 0, p.in[4], IN_WIDTH, 0, 1024, N_PROJA, WS_WINA, nullptr);
#endif
#if !PROJ_I8
    TJOB(GATE_FP8 ? 2 : 1, p.in[4], IN_WIDTH, N_PROJA, 1024, 2048, WS_WING, nullptr);
#endif
#if !(PROJ_I8 && G2_I8)
    TJOB(0, p.in[17], 1024, 0, 1024, 1024, WS_WOUT, nullptr);
#endif
    TJOB(0, p.in[20], 512, 0, 1024, 512, WS_WQC, p.in[18]);
    TJOB(0, p.in[21], 1024, 0, 1024, 1024, WS_WKVC, nullptr);
    TJOB(CROSS_FP8 ? 3 : 0, p.in[22], 1024, 0, 512, 1024, WS_WOC, nullptr);
#if !(PROJ_I8 && PQ_I8)
    TJOB(0, p.in[24], 2048, 0, 1024, 2048, WS_WPQ, p.in[23]);
#endif
    TJOB(0, p.in[8], 1024, 0, 64, 1024, WS_W2T, nullptr);
    TJOB(0, p.in[10], 1024, 0, 64, 1024, WS_A2T, nullptr);
    TJOB(0, p.in[11], 1024, 0, 128, 1024, WS_G2T, nullptr);
#undef TJOB
    {
        const f32x4* gr = (const f32x4*)p.in[3] + lane; const f32x4 gq0 = gr[0], gq1 = gr[64], gq2 = gr[128], gq3 = gr[192];
        for (int m0 = gw * 4; m0 < T_TOK; m0 += NGW * 4) {
            f32x4 v[4][4];
#pragma unroll
            for (int r = 0; r < 4; ++r) { const f32x4* xr = (const f32x4*)(p.in[0] + (size_t)(m0 + r) * D_MODEL) + lane;
#pragma unroll
                for (int j = 0; j < 4; ++j) v[r][j] = xr[64 * j]; }
#pragma unroll
            for (int r = 0; r < 4; ++r) { float s_ = 0.f;
#pragma unroll
                for (int j = 0; j < 4; ++j) s_ += (v[r][j].x * v[r][j].x + v[r][j].y * v[r][j].y) + (v[r][j].z * v[r][j].z + v[r][j].w * v[r][j].w);
                const float rstd = 1.f / sqrtf(wave_sum(s_) * (1.f / D_MODEL) + RMS_EPS);
                u32x2* o8 = (u32x2*)((bf16_t*)(ws + WS_XN) + (size_t)(m0 + r) * D_MODEL) + lane;
#pragma unroll
                for (int j = 0; j < 4; ++j) { const f32x4 gq = j == 0 ? gq0 : (j == 1 ? gq1 : (j == 2 ? gq2 : gq3)); u32x2 w; w.x = pk_bf16(v[r][j].x * rstd * gq.x, v[r][j].y * rstd * gq.y); w.y = pk_bf16(v[r][j].z * rstd * gq.z, v[r][j].w * rstd * gq.w); if (!(PROJ_FP8 == 1 && GATE_FP8)) o8[64 * j] = w;
#if GATE_FP8 && !PROJ_I8
                    { int q8 = __builtin_amdgcn_cvt_pk_fp8_f32(v[r][j].x * rstd * gq.x, v[r][j].y * rstd * gq.y, 0, false); q8 = __builtin_amdgcn_cvt_pk_fp8_f32(v[r][j].z * rstd * gq.z, v[r][j].w * rstd * gq.w, q8, true);
                      ((unsigned*)((unsigned char*)p.out + (size_t)(m0 + r) * D_MODEL))[lane + 64 * j] = (unsigned)q8; }
#endif
                }
#if PROJ_I8
                {   float am_ = 0.f;
#pragma unroll
                    for (int j = 0; j < 4; ++j) { const f32x4 gq = j == 0 ? gq0 : (j == 1 ? gq1 : (j == 2 ? gq2 : gq3));
                        am_ = fmaxf(am_, fmaxf(fmaxf(fabsf(v[r][j].x * gq.x), fabsf(v[r][j].y * gq.y)), fmaxf(fabsf(v[r][j].z * gq.z), fabsf(v[r][j].w * gq.w)))); }
                    am_ = wave_max(am_) * rstd; const float inv_ = am_ > 0.f ? 127.f / am_ : 0.f, qs_ = rstd * inv_;
#pragma unroll
                    for (int j = 0; j < 4; ++j) { const f32x4 gq = j == 0 ? gq0 : (j == 1 ? gq1 : (j == 2 ? gq2 : gq3));
                        ((unsigned*)((unsigned char*)p.out + (size_t)(m0 + r) * D_MODEL))[lane + 64 * j] = pack_i8x4(v[r][j].x * gq.x * qs_, v[r][j].y * gq.y * qs_, v[r][j].z * gq.z * qs_, v[r][j].w * gq.w * qs_); }
                    if (lane == 0) ((float*)(ws + WS_SX))[m0 + r] = am_ * (1.f / 127.f); }
#endif
                }
        }
    }
    for (int m = gw; m < MEM_ROWS; m += NGW) rms_row_to_bf16(p.in[1] + (size_t)m * D_MODEL, p.in[19], (bf16_t*)(ws + WS_MEMN) + (size_t)m * D_MODEL, lane);
    for (int m = gw; m < N_EXPERTS; m += NGW) {
#if !GATHER_UI4
        cvt_row_to_fp8(p.in[27] + (size_t)m * D_MODEL, p.in[23], 512.f, ws + WS_PU + (size_t)m * D_MODEL, lane);
#endif
#if GATHER_VMMA != 2 || V6_DIAG_FP8
        cvt_row_to_fp8(p.in[28] + (size_t)m * D_MODEL, nullptr, 64.f, ws + WS_PV + (size_t)m * D_MODEL, lane);
#endif
    }
#if !TABLES_LATE
    peer_tables_lowp(p, wave, lane);
#endif
    { const int gt = blockIdx.x * NTHREADS + threadIdx.x, NGT = gridDim.x * NTHREADS;
      for (int i = gt; i < 2 * 128 * 128 / 4; i += NGT) { const int which = i / 4096, j = i % 4096; const f32x4 v = which ? ((const f32x4*)p.in[26])[j] : ((const f32x4*)p.in[25])[j];
          u32x2 w; w.x = pk_bf16(v.x, v.y); w.y = pk_bf16(v.z, v.w); ((u32x2*)(ws + (which ? WS_PK2 : WS_PK1)))[j] = w; }
      const int* pos = (const int*)p.in[2];
      for (int i = gt; i < T_TOK * 8; i += NGT) { const int t = i >> 3, f = i & 7;
          const double inv = f == 0 ? 1.0 : f == 1 ? 0.19392274474868576 : f == 2 ? 0.03760603093086393 : f == 3 ? 0.007292664737217109 : f == 4 ? 0.001414213562373095 : f == 5 ? 0.0002742481756762073 : f == 6 ? 5.318295896944988e-05 : 1.031338537721246e-05;
          const double rev = (double)pos[t] * inv * 0.15915494309189535; const float fr = (float)(rev - floor(rev));
          bf16_t* rt = (bf16_t*)(ws + WS_ROPE_C) + (size_t)t * 16; rt[f] = bf16_of_(__builtin_amdgcn_cosf(fr)); rt[8 + f] = bf16_of_(__builtin_amdgcn_sinf(fr)); }
    }
#if PROJ_I8
    {
        if (threadIdx.x == 0) { while (__hip_atomic_load((unsigned*)(ws + CTL_WARRIVE), __ATOMIC_ACQUIRE, __HIP_MEMORY_SCOPE_AGENT) < gridDim.x) __builtin_amdgcn_s_sleep(2); }
        __syncthreads();
        const unsigned* wam = (const unsigned*)(ws + CTL_WAMAX);
        const int nA = (1024 / 64) * (N_PROJA / 32), nG = (1024 / 64) * (2048 / 32), nP = PQ_I8 ? (1024 / 64) * (2048 / 32) : 0, nO = G2_I8 ? (1024 / 64) * (1024 / 32) : 0;
        for (int it = gw; it < nA + nG + nP + nO; it += NGW) {
            if (it >= nA + nG + nP) { transpose_item<5>(p.in[17], 1024, 0, 1024, 1024, (bf16_t*)(ws + WS_WOUT), nullptr, scr, it - nA - nG - nP, lane, (const unsigned*)(ws + CTL_WAMAX3), (float*)(ws + WS_SWO)); continue; }
            if (it >= nA + nG) transpose_item<5>(p.in[24], 2048, 0, 1024, 2048, (bf16_t*)(ws + WS_WPQ), p.in[23], scr, it - nA - nG, lane, (const unsigned*)(ws + CTL_WAMAX2), (float*)(ws + WS_SWP));
            else if (it < nA) transpose_item<5>(p.in[4], IN_WIDTH, 0, 1024, N_PROJA, (bf16_t*)(ws + WS_WINA), nullptr, scr, it, lane, wam, (float*)(ws + WS_SWA));
            else transpose_item<6>(p.in[4], IN_WIDTH, N_PROJA, 1024, 2048, (bf16_t*)(ws + WS_WING), nullptr, scr, it - nA, lane, wam, (float*)(ws + WS_SWG)); }
    }
#endif
}
__device__ __forceinline__ void final_norm_rows(const bf16_t* H, const float* gain, float* out, int wave, int lane) {
    const int gw = blockIdx.x * NWAVES + wave, NGW = gridDim.x * NWAVES;
    for (int m = gw; m < T_TOK; m += NGW) {
        const u32x2* hr = (const u32x2*)(H + (size_t)m * D_MODEL) + lane; const f32x4* gr = (const f32x4*)gain + lane;
        f32x4 v[4]; float s = 0.f;
#pragma unroll
        for (int j = 0; j < 4; ++j) { const u32x2 w = hr[64 * j]; v[j] = (f32x4){bf_lo(w.x), bf_hi(w.x), bf_lo(w.y), bf_hi(w.y)}; s += (v[j].x * v[j].x + v[j].y * v[j].y) + (v[j].z * v[j].z + v[j].w * v[j].w); }
        const float rstd = 1.f / sqrtf(wave_sum(s) * (1.f / D_MODEL) + RMS_EPS);
        f32x4* orow = (f32x4*)(out + (size_t)m * D_MODEL) + lane;
#pragma unroll
        for (int j = 0; j < 4; ++j) orow[64 * j] = v[j] * rstd * gr[64 * j];
    }
}
#define MFMA16(a, b, c) __builtin_amdgcn_mfma_f32_16x16x32_bf16((a), (b), (c), 0, 0, 0)
template <int HD, int NT, bool SWA, bool OUT8 = false>
__device__ __forceinline__ void attn_group(const bf16_t* qp, LAS const unsigned char* Kimg, int kstr, LAS const unsigned char* VTimg, int vstr, bf16_t* op, int lane,
                                           int i0, int jmin, int jt0, float sink2, unsigned char* op8 = nullptr) {
    const int fr = lane & 15, g = lane >> 4;
    constexpr int KS = HD / 32, DT = HD / 16, NP = NT / 2;
    bf16x8 qf[KS];
#pragma unroll
    for (int ks = 0; ks < KS; ++ks) qf[ks] = *(const bf16x8*)(qp + 32 * ks);
    f32x4 s[NT];
#pragma unroll
    for (int kt = 0; kt < NT; ++kt) { s[kt] = (f32x4){0.f, 0.f, 0.f, 0.f};
#pragma unroll
        for (int ks = 0; ks < KS; ++ks) { const bf16x8 kf = *(const LAS bf16x8*)(Kimg + (16 * kt + fr) * kstr + 16 * g + 64 * ks); s[kt] = MFMA16(kf, qf[ks], s[kt]); }
        if ((kt & 1) == 1) __builtin_amdgcn_sched_barrier(0); }
    if (SWA) { const int i = i0 + fr;
#pragma unroll
        for (int kt = 0; kt < NT; ++kt)
#pragma unroll
            for (int r = 0; r < 4; ++r) { const int j = 16 * (jt0 + kt) + 4 * g + r; const bool valid = (j > i) && (j <= i + 128) && (j >= jmin); s[kt][r] = valid ? s[kt][r] : -1e30f; } }
    float m = -1e30f;
#pragma unroll
    for (int kt = 0; kt < NT; ++kt) m = fmaxf(fmaxf(m, fmaxf(s[kt][0], s[kt][1])), fmaxf(s[kt][2], s[kt][3]));
    m = xrow_max(m);
    if (SWA) m = fmaxf(m, sink2);
    float l = 0.f;
#pragma unroll
    for (int kt = 0; kt < NT; ++kt)
#pragma unroll
        for (int r = 0; r < 4; ++r) { const float pe = fast_exp2(s[kt][r] - m); s[kt][r] = pe; l += pe; }
    l = xrow_sum(l);
    if (SWA) l += fast_exp2(sink2 - m);
    const float rl = 1.f / l;
    bf16x8 pf[NP];
#pragma unroll
    for (int sp = 0; sp < NP; ++sp) { u32x4 w; w.x = pk_bf16(s[2 * sp][0], s[2 * sp][1]); w.y = pk_bf16(s[2 * sp][2], s[2 * sp][3]); w.z = pk_bf16(s[2 * sp + 1][0], s[2 * sp + 1][1]); w.w = pk_bf16(s[2 * sp + 1][2], s[2 * sp + 1][3]);
        pf[sp] = __builtin_bit_cast(bf16x8, w); }
    u32x2 owv[DT];
#pragma unroll
    for (int dt = 0; dt < DT; ++dt) { f32x4 o = (f32x4){0.f, 0.f, 0.f, 0.f};
#pragma unroll
        for (int sp = 0; sp < NP; ++sp) { LAS const unsigned char* vp = VTimg + (16 * dt + fr) * vstr + (32 * sp + 4 * g) * 2;
            const u32x2 lo = *(const LAS u32x2*)vp, hi = *(const LAS u32x2*)(vp + 32); const u32x4 w = {lo.x, lo.y, hi.x, hi.y};
            o = MFMA16(__builtin_bit_cast(bf16x8, w), pf[sp], o); }
        if constexpr (OUT8) { const float r8 = rl * CROSS_OSCALE; int w8 = __builtin_amdgcn_cvt_pk_fp8_f32(o[0] * r8, o[1] * r8, 0, false); w8 = __builtin_amdgcn_cvt_pk_fp8_f32(o[2] * r8, o[3] * r8, w8, true); *(unsigned*)(op8 + 16 * dt) = (unsigned)w8; }
        else { owv[dt].x = pk_bf16(o[0] * rl, o[1] * rl); owv[dt].y = pk_bf16(o[2] * rl, o[3] * rl); }
        __builtin_amdgcn_sched_barrier(0); }
    if constexpr (!OUT8) {
        bf16_t* opw = op - 4 * g + 16 * (g & 1) + 8 * (g >> 1);
#pragma unroll
        for (int k = 0; k < DT; k += 2) { const auto sx = __builtin_amdgcn_permlane16_swap(owv[k].x, owv[k + 1].x, false, false); const auto sy = __builtin_amdgcn_permlane16_swap(owv[k].y, owv[k + 1].y, false, false);
            *(u32x4*)(opw + 16 * k) = (u32x4){sx[0], sy[0], sx[1], sy[1]}; } }
}
constexpr int SWA_KSTR = 144, SWA_VSTR = 560, SWA_VT_OFF = 40960, SWA_NT = 10;
__device__ __forceinline__ void swa_phase(const Params& p, LAS unsigned char* lds, int tid, int wave, int lane) {
    unsigned char* ws = p.ws; bf16_t* Q = (bf16_t*)(ws + WS_Q); const bf16_t* Kb = (const bf16_t*)(ws + WS_K); const bf16_t* Vb = (const bf16_t*)(ws + WS_V);
    LAS unsigned char* Kimg = lds; LAS unsigned char* VTimg = lds + SWA_VT_OFF;
    for (int i = tid; i < 16 * SWA_KSTR / 4; i += NTHREADS) ((LAS unsigned*)(Kimg + 256 * SWA_KSTR))[i] = 0u;
    for (int i = tid; i < 64 * 8; i += NTHREADS) ((LAS unsigned*)(VTimg + (i >> 3) * SWA_VSTR + 512))[i & 7] = 0u;
    const int fr = lane & 15, g = lane >> 4;
    for (int unit = blockIdx.x; unit < BATCH * 4 * 16; unit += gridDim.x) {
        const int b = unit >> 6, kvh = (unit >> 4) & 3, qb = unit & 15;
        const bf16_t* Kg = Kb + (size_t)b * SEQ * 256 + kvh * 64; const bf16_t* Vg = Vb + (size_t)b * SEQ * 256 + kvh * 64;
        __syncthreads();
        u32x4 kvr[4], vvr[4];
#pragma unroll
        for (int it = 0; it < 4; ++it) { const int idx = tid + NTHREADS * it, key = idx & 255, c = idx >> 8, t = qb * 128 - 128 + key, tc = t >= 0 ? t : 0;
            kvr[it] = *(const u32x4*)(Kg + (size_t)tc * 256 + 8 * c); vvr[it] = *(const u32x4*)(Vg + (size_t)tc * 256 + 8 * c); }
#pragma unroll
        for (int it = 0; it < 4; ++it) { const int idx = tid + NTHREADS * it, key = idx & 255, c = idx >> 8, t = qb * 128 - 128 + key;
            const u32x4 z = {0u, 0u, 0u, 0u}; const u32x4 kv = t >= 0 ? kvr[it] : z, vv = t >= 0 ? vvr[it] : z;
            *(LAS u32x4*)(Kimg + key * SWA_KSTR + 16 * c) = kv;
#pragma unroll
            for (int i = 0; i < 8; ++i) *(LAS bf16_t*)(VTimg + (8 * c + i) * SWA_VSTR + key * 2) = (bf16_t)((vv[i >> 1] >> (16 * (i & 1))) & 0xffffu); }
        __syncthreads();
        const int head = kvh * 4 + (wave >> 1); const float sink2 = p.in[5][head] * LOG2E;
#pragma unroll 1
        for (int gi = 0; gi < 4; ++gi) { const int i0 = (wave & 1) * 64 + 16 * gi, jt0 = i0 >> 4; const size_t tok = (size_t)b * SEQ + qb * 128 + i0 + fr;
            attn_group<64, SWA_NT, true>(Q + tok * D_MODEL + head * 64 + 8 * g, Kimg + jt0 * 16 * SWA_KSTR, SWA_KSTR, VTimg + jt0 * 32, SWA_VSTR,
                                        Q + tok * D_MODEL + head * 64 + 4 * g, lane, i0, qb == 0 ? 128 : 0, jt0, sink2); }
    }
    __syncthreads();
}
constexpr int CR_KSTR = 272, CR_VSTR = 528, CR_VT_OFF = 69632;
__device__ __forceinline__ void cross_phase(const Params& p, LAS unsigned char* lds, int tid, int wave, int lane) {
    unsigned char* ws = p.ws; bf16_t* QC = (bf16_t*)(ws + WS_QC); const bf16_t* KVC = (const bf16_t*)(ws + WS_KVC);
    LAS unsigned char* Kimg = lds; LAS unsigned char* VTimg = lds + CR_VT_OFF;
    const int fr = lane & 15, g = lane >> 4;
    for (int unit = blockIdx.x; unit < BATCH * 4 * 2; unit += gridDim.x) {
        const int b = unit >> 3, h = (unit >> 1) & 3, half = unit & 1;
        const bf16_t* src = KVC + (size_t)b * MEM_LEN * 1024 + h * 128;
        __syncthreads();
        u32x4 kvr[8], vvr[8];
#pragma unroll
        for (int it = 0; it < 8; ++it) { const int idx = tid + NTHREADS * it, key = idx & 255, c = idx >> 8;
            kvr[it] = *(const u32x4*)(src + (size_t)key * 1024 + 8 * c); vvr[it] = *(const u32x4*)(src + (size_t)key * 1024 + 512 + 8 * c); }
#pragma unroll
        for (int it = 0; it < 8; ++it) { const int idx = tid + NTHREADS * it, key = idx & 255, c = idx >> 8; const u32x4 vv = vvr[it];
            *(LAS u32x4*)(Kimg + key * CR_KSTR + 16 * c) = kvr[it];
#pragma unroll
            for (int i = 0; i < 8; ++i) *(LAS bf16_t*)(VTimg + (8 * c + i) * CR_VSTR + key * 2) = (bf16_t)((vv[i >> 1] >> (16 * (i & 1))) & 0xffffu); }
        __syncthreads();
#pragma unroll 1
        for (int gi = 0; gi < 8; ++gi) { const size_t tok = (size_t)b * SEQ + half * 1024 + (wave * 8 + gi) * 16 + fr;
#if CROSS_FP8
            attn_group<128, 16, false, true>(QC + tok * 512 + h * 128 + 8 * g, Kimg, CR_KSTR, VTimg, CR_VSTR, nullptr, lane, 0, 0, 0, 0.f, ws + WS_QC8 + tok * 512 + h * 128 + 4 * g); }
#else
            attn_group<128, 16, false>(QC + tok * 512 + h * 128 + 8 * g, Kimg, CR_KSTR, VTimg, CR_VSTR, QC + tok * 512 + h * 128 + 4 * g, lane, 0, 0, 0, 0.f); }
#endif
    }
    __syncthreads();
}
constexpr int CK_STR = 144, CK_TSTR = 80;
constexpr int RW_LAM = 0, RW_A = 4096, RW_G = 8192, RW_V = 16384, RW_O = 24576;
constexpr int RW_AT = 28672, RW_RT = RW_AT + 16 * CK_STR, RW_BT = RW_RT + 16 * CK_STR, RW_KT = RW_BT + 16 * CK_STR;
constexpr int CK_VSTR = 40;
constexpr int RW_BKT = RW_KT + 16 * CK_STR, RW_VT = RW_BKT + 64 * CK_TSTR, RW_GA = RW_VT + 64 * CK_VSTR;
constexpr int RW_NN = RW_GA + 2 * 16 * CK_TSTR, RW_GC = RW_NN + 1024, RW_BON = RW_GC + 256, RW_C = RW_BON + 128, RWG_BYTES = RW_C + 2560;
constexpr int RW_MU = 2 * RWG_BYTES;
static_assert(RW_MU + 1024 <= LDS_BYTES - 16, "rwkv LDS map");
#define LBAR() do { asm volatile("s_waitcnt lgkmcnt(0)" ::: "memory"); __builtin_amdgcn_s_barrier(); asm volatile("" ::: "memory"); } while (0)
__device__ __forceinline__ f32x4 lds4(LAS const unsigned char* p) { return *(const LAS f32x4*)p; }
__device__ __forceinline__ void unpack8(const u32x4 w, float (&o)[8]) { o[0] = bf_lo(w.x); o[1] = bf_hi(w.x); o[2] = bf_lo(w.y); o[3] = bf_hi(w.y); o[4] = bf_lo(w.z); o[5] = bf_hi(w.z); o[6] = bf_lo(w.w); o[7] = bf_hi(w.w); }
__device__ __forceinline__ f32x4 unpack4(const u32x2 w) { return (f32x4){bf_lo(w.x), bf_hi(w.x), bf_lo(w.y), bf_hi(w.y)}; }
__device__ __forceinline__ u32x2 pack4(const f32x4 v) { u32x2 w; w.x = pk_bf16(v[0], v[1]); w.y = pk_bf16(v[2], v[3]); return w; }
__device__ __forceinline__ bf16_t bf16_of(float v) { return (bf16_t)(pk_bf16(v, 0.f) & 0xffffu); }
__device__ __forceinline__ float prefix16(float x) {
    x += dpp<0x111>(x); x += dpp<0x112>(x); x += dpp<0x114>(x); x += dpp<0x118>(x); return x; }
__device__ __forceinline__ bf16x8 frag2(LAS const unsigned char* p, int d) { const u32x2 lo = *(const LAS u32x2*)p, hi = *(const LAS u32x2*)(p + d); const u32x4 w = {lo.x, lo.y, hi.x, hi.y}; return __builtin_bit_cast(bf16x8, w); }
__device__ __forceinline__ bf16_t* act_row(unsigned char* ws, size_t row) { return (bf16_t*)(ws + (row < (size_t)T_TOK / 2 ? WS_ACT0 : WS_ACT1)) + (row & ((size_t)T_TOK / 2 - 1)) * 256; }
__device__ __forceinline__ void rwkv_act_phase(const Params& p, int wave, int lane) {
    unsigned char* ws = p.ws; const bf16_t* RW = (const bf16_t*)(ws + WS_RW);
    const int gw = blockIdx.x * NWAVES + wave, NGW = gridDim.x * NWAVES;
    const f32x4 mu4 = *(const f32x4*)(p.in[6] + 3072 + 4 * lane);
    for (int r0 = gw * 8; r0 < T_TOK; r0 += NGW * 8) {
        u32x2 raw[9];
        { const int rp = (r0 & (SEQ - 1)) ? r0 - 1 : r0; raw[0] = *(const u32x2*)(RW + (size_t)rp * RW_W + 3072 + 4 * lane); }
#pragma unroll
        for (int i = 0; i < 8; ++i) raw[i + 1] = *(const u32x2*)(RW + (size_t)(r0 + i) * RW_W + 3072 + 4 * lane);
#pragma unroll
        for (int i = 0; i < 8; ++i) { const int row = r0 + i; const f32x4 cu = unpack4(raw[i + 1]); const f32x4 z4 = {0.f, 0.f, 0.f, 0.f};
            const f32x4 pv = (row & (SEQ - 1)) ? unpack4(raw[i]) : z4;
            f32x4 x = cu + (pv - cu) * mu4;
#pragma unroll
            for (int e = 0; e < 4; ++e) { const float th = 1.f - 2.f * fast_rcp(1.f + fast_exp2(2.f * LOG2E * x[e])), sg = sigmoidf_(x[e]); x[e] = lane < 16 ? th : (lane < 32 ? x[e] : sg); }
            *(u32x2*)(act_row(ws, (size_t)row) + 4 * lane) = pack4(x); }
    }
}
__device__ __forceinline__ void rwkv_phase(const Params& p, LAS unsigned char* lds, int tid, int wave, int lane) {
    unsigned char* ws = p.ws;
    const bf16_t* RW = (const bf16_t*)(ws + WS_RW); bf16_t* Y = (bf16_t*)(ws + WS_Y);
    const int gidx = wave >> 2, wv = wave & 3, L = wv * 64 + lane;
    LAS unsigned char* gb = lds + gidx * RWG_BYTES;
    const int fr = lane & 15, g = lane >> 4;
    const int tk = L >> 4, cg = L & 15;
    const float* mu = p.in[6];
#if TABLES_LATE
    peer_tables_lowp(p, wave, lane);
#endif
#pragma unroll 1
    for (int pp = blockIdx.x; pp < BATCH * 16 / 2; pp += gridDim.x) {
        const int pair = pp * 2 + gidx, b = pair >> 4, h = pair & 15;
        __syncthreads();
        if (L < 64) { LAS float* C = (LAS float*)(gb + RW_C); const int c = h * 64 + L;
            C[0 * 64 + L] = mu[c]; C[1 * 64 + L] = mu[1024 + c]; C[2 * 64 + L] = mu[2048 + c]; C[3 * 64 + L] = p.in[12][c]; C[4 * 64 + L] = p.in[13][c];
            C[5 * 64 + L] = p.in[14][c]; C[6 * 64 + L] = p.in[15][c]; C[7 * 64 + L] = p.in[16][c]; C[8 * 64 + L] = p.in[7][c]; C[9 * 64 + L] = p.in[9][c]; }
        for (int i = L; i < 2 * 16 * CK_TSTR / 4; i += 256) ((LAS unsigned*)(gb + RW_GA))[i] = 0u;
        bf16x8 wf[8];
        {   const bf16_t* W2 = (const bf16_t*)(ws + WS_W2T) + (size_t)(h * 64 + 16 * wv + fr) * 64 + 8 * g; const bf16_t* A2 = (const bf16_t*)(ws + WS_A2T) + (size_t)(h * 64 + 16 * wv + fr) * 64 + 8 * g;
            const bf16_t* G2 = (const bf16_t*)(ws + WS_G2T) + (size_t)(h * 64 + 16 * wv + fr) * 128 + 8 * g;
#pragma unroll
            for (int ks = 0; ks < 2; ++ks) { wf[ks] = *(const bf16x8*)(W2 + 32 * ks); wf[2 + ks] = *(const bf16x8*)(A2 + 32 * ks); }
#pragma unroll
            for (int ks = 0; ks < 4; ++ks) wf[4 + ks] = *(const bf16x8*)(G2 + 32 * ks); }
        f32x4 M[4];
#pragma unroll
        for (int kt = 0; kt < 4; ++kt) M[kt] = (f32x4){0.f, 0.f, 0.f, 0.f};
        const bf16_t* rwb = RW + (size_t)b * SEQ * RW_W;
        u32x4 p1c[8]; u32x2 p2c[3], p2p[3];
#define RW_PREF1(T0) do { const int tq_ = (T0) + fr < SEQ ? (T0) + fr : SEQ - 1; const bf16_t* ar_ = act_row(ws, (size_t)b * SEQ + tq_) + 8 * g; \
            _Pragma("unroll") for (int ks = 0; ks < 8; ++ks) p1c[ks] = *(const u32x4*)(ar_ + 32 * ks); } while (0)
#define RW_PREF2(T0) do { const int u_ = (T0) + tk < SEQ ? (T0) + tk : SEQ - 1, up_ = u_ > 0 ? u_ - 1 : 0; \
            _Pragma("unroll") for (int q = 0; q < 3; ++q) { p2c[q] = *(const u32x2*)(rwb + (size_t)u_ * RW_W + 1024 * q + h * 64 + 4 * cg); p2p[q] = *(const u32x2*)(rwb + (size_t)up_ * RW_W + 1024 * q + h * 64 + 4 * cg); } } while (0)
        RW_PREF1(0); RW_PREF2(0);
        LBAR();
#pragma unroll 1
        for (int ci = -1; ci < SEQ / 16; ++ci) {
            const int cn = ci + 1; const bool has_n = cn < SEQ / 16, has_c = ci >= 0;
            if (has_n) {
            {   f32x4 aw = lds4(gb + RW_C + 8 * 256 + (16 * wv + 4 * g) * 4), aa = lds4(gb + RW_C + 9 * 256 + (16 * wv + 4 * g) * 4), ag = (f32x4){0.f, 0.f, 0.f, 0.f};
#pragma unroll
                for (int ks = 0; ks < 2; ++ks) { aw = MFMA16(wf[ks], __builtin_bit_cast(bf16x8, p1c[ks]), aw); aa = MFMA16(wf[2 + ks], __builtin_bit_cast(bf16x8, p1c[2 + ks]), aa); }
#pragma unroll
                for (int ks = 0; ks < 4; ++ks) ag = MFMA16(wf[4 + ks], __builtin_bit_cast(bf16x8, p1c[4 + ks]), ag);
                f32x4 ow, oa;
#pragma unroll
                for (int r = 0; r < 4; ++r) { ow[r] = prefix16(-0.8750387749145276f * sigmoidf_(aw[r])); oa[r] = sigmoidf_(aa[r]); }
                const int o_ = fr * 256 + (16 * wv + 4 * g) * 4;
                *(LAS f32x4*)(gb + RW_LAM + o_) = ow; *(LAS f32x4*)(gb + RW_A + o_) = oa; *(LAS f32x4*)(gb + RW_G + (cn & 1) * 4096 + o_) = ag;
            }
            }
            RW_PREF1(16 * cn + 16);
            if (has_c) {
            {   bf16x8 mf[2];
#pragma unroll
                for (int ks = 0; ks < 2; ++ks) { u32x4 w; w.x = pk_bf16(M[2 * ks][0], M[2 * ks][1]); w.y = pk_bf16(M[2 * ks][2], M[2 * ks][3]); w.z = pk_bf16(M[2 * ks + 1][0], M[2 * ks + 1][1]); w.w = pk_bf16(M[2 * ks + 1][2], M[2 * ks + 1][3]);
                    mf[ks] = __builtin_bit_cast(bf16x8, w); }
                f32x4 x1 = (f32x4){0.f, 0.f, 0.f, 0.f}, x2 = x1;
#pragma unroll
                for (int ks = 0; ks < 2; ++ks) { x1 = MFMA16(frag2(gb + RW_AT + fr * CK_STR + (32 * ks + 4 * g) * 2, 32), mf[ks], x1); x2 = MFMA16(frag2(gb + RW_RT + fr * CK_STR + (32 * ks + 4 * g) * 2, 32), mf[ks], x2); }
                const u32x2 vfr = *(const LAS u32x2*)(gb + RW_VT + (16 * wv + fr) * CK_VSTR + 8 * g);
                f32x4 nt[15];
#pragma unroll
                for (int sc = 0; sc < 15; ++sc) nt[sc] = lds4(gb + RW_NN + sc * 64 + g * 16);
                const bf16x8 ga_r = *(const LAS bf16x8*)(gb + RW_GA + fr * CK_TSTR + 16 * g), ga_o = *(const LAS bf16x8*)(gb + RW_GA + 16 * CK_TSTR + fr * CK_TSTR + 16 * g);
                { const u32x4 w = {0u, 0u, vfr.x, vfr.y}; x1 = MFMA16(ga_r, __builtin_bit_cast(bf16x8, w), x1); }
                float u[4] = {x1[0], x1[1], x1[2], x1[3]};
#pragma unroll
                for (int sc = 0; sc < 15; ++sc) {
                    const auto a_ = __builtin_amdgcn_permlane32_swap(__float_as_uint(u[sc & 3]), __float_as_uint(u[sc & 3]), false, false); const unsigned y_ = (sc >> 2) >= 2 ? a_[1] : a_[0];
                    const auto b_ = __builtin_amdgcn_permlane16_swap(y_, y_, false, false); const float ub = __uint_as_float(((sc >> 2) & 1) ? b_[1] : b_[0]);
#pragma unroll
                    for (int r = 0; r < 4; ++r) u[r] = fmaf(nt[sc][r], ub, u[r]); }
                const u32x4 uvw = {pk_bf16(u[0], u[1]), pk_bf16(u[2], u[3]), vfr.x, vfr.y}; const bf16x8 uv1 = __builtin_bit_cast(bf16x8, uvw);
                x2 = MFMA16(ga_o, uv1, x2);
#pragma unroll
                for (int r = 0; r < 4; ++r) *(LAS float*)(gb + RW_O + (4 * g + r) * 256 + (16 * wv + fr) * 4) = x2[r];
#pragma unroll
                for (int kt = 0; kt < 4; ++kt) { M[kt] = MFMA16(*(const LAS bf16x8*)(gb + RW_BKT + (16 * kt + fr) * CK_TSTR + 16 * g), uv1, M[kt]); M[kt] = M[kt] * lds4(gb + RW_GC + (16 * kt + 4 * g) * 4); }
            }
            }
            LBAR();
            if (has_n) {
            {   LAS const unsigned char* C = gb + RW_C + cg * 16; const bool first = (16 * cn + tk) == 0;
                const f32x4 rc = unpack4(p2c[0]), kc = unpack4(p2c[1]), vc = unpack4(p2c[2]);
                const f32x4 z4 = {0.f, 0.f, 0.f, 0.f};
                const f32x4 rp = first ? z4 : unpack4(p2p[0]), kp_ = first ? z4 : unpack4(p2p[1]), vp = first ? z4 : unpack4(p2p[2]);
                const f32x4 rs = rc + (rp - rc) * lds4(C), ksh = kc + (kp_ - kc) * lds4(C + 256), vs = vc + (vp - vc) * lds4(C + 512);
                const f32x4 a = lds4(gb + RW_A + tk * 256 + cg * 16);
                f32x4 kk = ksh * lds4(C + 768);
                const float ss = sum16((kk[0] * kk[0] + kk[1] * kk[1]) + (kk[2] * kk[2] + kk[3] * kk[3]));
                kk = kk * (1.f / fmaxf(sqrtf(ss), 1e-12f));
                const f32x4 kpv = ksh * (1.f + (a - 1.f) * lds4(C + 1024));
                const f32x4 rkk = rs * kpv * lds4(C + 1280);
                const float bon = sum16((rkk[0] + rkk[1]) + (rkk[2] + rkk[3]));
                const f32x4 lam = lds4(gb + RW_LAM + tk * 256 + cg * 16), lamp = tk > 0 ? lds4(gb + RW_LAM + (tk - 1) * 256 + cg * 16) : z4;
                f32x4 gm, gp, gi;
#pragma unroll
                for (int e = 0; e < 4; ++e) { gm[e] = fast_exp2(lam[e]); gp[e] = fast_exp2(lamp[e]); gi[e] = fast_exp2(-lam[e]); }
                const f32x4 At = -kk * gp, Rt = rs * gm, Bt = kk * a * gi, Kt = kpv * gi;
                const int ro = tk * CK_STR + cg * 8;
                *(LAS u32x2*)(gb + RW_AT + ro) = pack4(At); *(LAS u32x2*)(gb + RW_RT + ro) = pack4(Rt); *(LAS u32x2*)(gb + RW_BT + ro) = pack4(Bt); *(LAS u32x2*)(gb + RW_KT + ro) = pack4(Kt);
#pragma unroll
                for (int e = 0; e < 4; ++e) { LAS unsigned char* q = gb + RW_BKT + (4 * cg + e) * CK_TSTR + (8 * (tk >> 2) + (tk & 3)) * 2;
                    *(LAS bf16_t*)q = bf16_of(Bt[e]); *(LAS bf16_t*)(q + 8) = bf16_of(Kt[e]); *(LAS bf16_t*)(gb + RW_VT + (4 * cg + e) * CK_VSTR + tk * 2) = bf16_of(vs[e]); }
                *(LAS f32x4*)(gb + RW_V + (cn & 1) * 4096 + tk * 256 + cg * 16) = vs;
                if (tk == 15) *(LAS f32x4*)(gb + RW_GC + cg * 16) = gm;
                if (cg == 0) *(LAS float*)(gb + RW_BON + (cn & 1) * 64 + tk * 4) = bon; }
            }
            RW_PREF2(16 * cn + 16);
            if (has_c) {
            {   LAS const unsigned char* C = gb + RW_C + cg * 16; const int o_ = tk * 256 + cg * 16;
                const f32x4 o = lds4(gb + RW_O + o_);
                const float mean = sum16((o[0] + o[1]) + (o[2] + o[3])) * (1.f / 64.f);
                const f32x4 d = o - mean;
                const float var = sum16((d[0] * d[0] + d[1] * d[1]) + (d[2] * d[2] + d[3] * d[3])) * (1.f / 64.f);
                const f32x4 on = d * (1.f / sqrtf(var + 64e-5f)) * lds4(C + 1536) + lds4(C + 1792);
                const f32x4 vs = lds4(gb + RW_V + (ci & 1) * 4096 + o_); const float bon = *(const LAS float*)(gb + RW_BON + (ci & 1) * 64 + tk * 4);
                const f32x4 gg = lds4(gb + RW_G + (ci & 1) * 4096 + o_);
                const f32x4 y = (on + vs * bon) * gg;
                *(u32x2*)(Y + ((size_t)b * SEQ + 16 * ci + tk) * D_MODEL + h * 64 + 4 * cg) = pack4(y); }
            }
            LBAR();
            if (has_n) {
            {   LAS const unsigned char* Xa = gb + (wv < 2 ? RW_AT : RW_RT) + fr * CK_STR + 16 * g; LAS const unsigned char* Yb = gb + ((wv & 1) ? RW_KT : RW_BT) + fr * CK_STR + 16 * g;
                f32x4 d = (f32x4){0.f, 0.f, 0.f, 0.f};
#pragma unroll
                for (int ks = 0; ks < 2; ++ks) d = MFMA16(*(const LAS bf16x8*)(Xa + 64 * ks), *(const LAS bf16x8*)(Yb + 64 * ks), d);
                f32x4 dm;
#pragma unroll
                for (int r = 0; r < 4; ++r) { const int t = 4 * g + r; const bool keep = wv < 2 ? (fr < t) : (fr <= t); dm[r] = keep ? d[r] : 0.f; }
                if (wv == 0) *(LAS f32x4*)(gb + RW_NN + fr * 64 + g * 16) = dm;
                else {
#pragma unroll
                    for (int r = 0; r < 4; ++r) *(LAS bf16_t*)(gb + RW_GA + (wv == 1 ? 0 : 16 * CK_TSTR) + (4 * g + r) * CK_TSTR + (8 * (fr >> 2) + (fr & 3) + (wv == 2 ? 0 : 4)) * 2) = bf16_of(dm[r]); } }
            }
            LBAR();
        }
#undef RW_PREF1
#undef RW_PREF2
    }
    __syncthreads();
}
#define MFMA32(a, b, c) __builtin_amdgcn_mfma_f32_32x32x16_bf16((a), (b), (c), 0, 0, 0)
constexpr int PK_STR = 272, PK2_OFF = 128 * PK_STR;
__device__ __forceinline__ void ce_(float& a, float& b) { const float hi = fmaxf(a, b), lo = fminf(a, b); a = hi; b = lo; }
template <int LO, int N, int R> __device__ __forceinline__ void oe_merge(float (&v)[16]) {
    constexpr int M = R * 2;
    if constexpr (M < N) { oe_merge<LO, N, M>(v); oe_merge<LO + R, N, M>(v);
#pragma unroll
        for (int i = LO + R; i + R < LO + N; i += M) ce_(v[i], v[i + R]); }
    else ce_(v[LO], v[LO + R]);
}
template <int LO, int N> __device__ __forceinline__ void oe_sort(float (&v)[16]) {
    if constexpr (N > 1) { oe_sort<LO, N / 2>(v); oe_sort<LO + N / 2, N / 2>(v); oe_merge<LO, N, 1>(v); }
}
__device__ __forceinline__ void merge_top16(float (&a)[16], const float (&b)[16]) {
#pragma unroll
    for (int i = 0; i < 16; ++i) a[i] = fmaxf(a[i], b[15 - i]);
#pragma unroll
    for (int st = 8; st >= 1; st >>= 1)
#pragma unroll
        for (int i = 0; i < 16; ++i) if ((i & st) == 0) ce_(a[i], a[i + st]);
}
__device__ __forceinline__ void topk_side(float (&Lst)[16], const bf16x8 (&qf)[8], LAS const unsigned char* Kimg, int c, int hh) {
    f32x16 acc[4];
#pragma unroll
    for (int kt = 0; kt < 4; ++kt)
#pragma unroll
        for (int i = 0; i < 16; ++i) acc[kt][i] = 0.f;
#pragma unroll
    for (int ks = 0; ks < 8; ++ks) { const bf16x8 bq = qf[ks];
#pragma unroll
        for (int kt = 0; kt < 4; ++kt) { const bf16x8 ak = *(const LAS bf16x8*)(Kimg + (32 * kt + c) * PK_STR + (16 * ks + 8 * hh) * 2); acc[kt] = MFMA32(ak, bq, acc[kt]); } }
    float g1[16], g2[16], g3[16];
#pragma unroll
    for (int i = 0; i < 16; ++i) { const unsigned idx = (unsigned)((i & 3) + 8 * (i >> 2)) + 4u * (unsigned)hh;
        Lst[i] = __uint_as_float((__float_as_uint(acc[0][i]) & 0xFFFFFF80u) | idx); g1[i] = __uint_as_float((__float_as_uint(acc[1][i]) & 0xFFFFFF80u) | (idx + 32u));
        g2[i] = __uint_as_float((__float_as_uint(acc[2][i]) & 0xFFFFFF80u) | (idx + 64u)); g3[i] = __uint_as_float((__float_as_uint(acc[3][i]) & 0xFFFFFF80u) | (idx + 96u)); }
    oe_sort<0, 16>(Lst); oe_sort<0, 16>(g1); oe_sort<0, 16>(g2); oe_sort<0, 16>(g3);
    merge_top16(Lst, g1); merge_top16(g2, g3); merge_top16(Lst, g2);
    float oth[16];
#pragma unroll
    for (int q = 0; q < 16; ++q) { auto r = __builtin_amdgcn_permlane32_swap(__float_as_uint(Lst[q]), __float_as_uint(Lst[q]), false, false); oth[q] = __uint_as_float(hh ? r[0] : r[1]); }
    merge_top16(Lst, oth);
}
__device__ __forceinline__ void peer_route_stage_keys(const Params& p, LAS unsigned char* lds, int tid) {
    unsigned char* ws = p.ws;
    __syncthreads();
    for (int idx = tid; idx < 2 * 128 * 16; idx += NTHREADS) { const int which = idx >> 11, rem = idx & 2047, key = rem >> 4, cc = rem & 15;
        *(LAS u32x4*)(lds + which * PK2_OFF + key * PK_STR + 16 * cc) = ((const u32x4*)(ws + (which ? WS_PK2 : WS_PK1)))[key * 16 + cc]; }
    __syncthreads();
}
__device__ __forceinline__ void peer_route_task(const Params& p, LAS unsigned char* lds, int task, int lane) {
    unsigned char* ws = p.ws; const bf16_t* PQ = (const bf16_t*)(ws + WS_PQ); int* RE = (int*)(ws + WS_RE); float* RS = (float*)(ws + WS_RS);
    const int c = lane & 31, hh = lane >> 5;
    LAS int* stE = (LAS int*)(lds + 2 * PK2_OFF + (threadIdx.x >> 6) * 4096); LAS float* stS = (LAS float*)(stE + 512);
    {
        const size_t row = (size_t)task * 32 + c; const bf16_t* qptr = PQ + row * 256;
        float L1[16], L2[16];
        bf16x8 q1[8], q2[8];
#pragma unroll
        for (int ks = 0; ks < 8; ++ks) { q1[ks] = *(const bf16x8*)(qptr + 16 * ks + 8 * hh); q2[ks] = *(const bf16x8*)(qptr + 128 + 16 * ks + 8 * hh); }
        __builtin_amdgcn_sched_barrier(0);
        topk_side(L1, q1, lds, c, hh);
        topk_side(L2, q2, lds + PK2_OFF, c, hh);
        float v1[16], v2[16];
#pragma unroll
        for (int q = 0; q < 16; ++q) { v1[q] = __uint_as_float(__float_as_uint(L1[q]) & 0xFFFFFF80u); v2[q] = __uint_as_float(__float_as_uint(L2[q]) & 0xFFFFFF80u); }
        float Tt[16], T1[16];
        {   float cand[64]; int nc = 0;
#pragma unroll
            for (int i = 0; i < 16; ++i)
#pragma unroll
                for (int j = 0; j < 16; ++j) if ((i + 1) * (j + 1) <= 16) { cand[nc] = v1[i] + v2[j]; ++nc; }
#pragma unroll
            for (int q = 0; q < 16; ++q) { Tt[q] = hh ? cand[32 + q] : cand[q]; T1[q] = hh ? ((48 + q < 50) ? cand[48 + q] : -3.0e38f) : cand[16 + q]; } }
        oe_sort<0, 16>(Tt); oe_sort<0, 16>(T1);
        merge_top16(Tt, T1);
        {   float oth[16];
#pragma unroll
            for (int q = 0; q < 16; ++q) { auto r = __builtin_amdgcn_permlane32_swap(__float_as_uint(Tt[q]), __float_as_uint(Tt[q]), false, false); oth[q] = __uint_as_float(hh ? r[0] : r[1]); }
            merge_top16(Tt, oth); }
        const float tau = Tt[15];
        int cnt = 0;
#pragma unroll
        for (int i = 0; i < 16; ++i)
#pragma unroll
            for (int j = 0; j < 16; ++j) if ((i + 1) * (j + 1) <= 16) { const float sm = v1[i] + v2[j];
                if (sm >= tau && cnt < 16 && hh == 0) { const int e = (int)((__float_as_uint(L1[i]) & 127u) * 128u + (__float_as_uint(L2[j]) & 127u)); stE[c * 16 + cnt] = e; stS[c * 16 + cnt] = sm; ++cnt; } }
        LDS_WAIT();
        { const size_t ob = (size_t)task * 512 + 4 * lane;
          *(u32x4*)(RE + ob) = *(const LAS u32x4*)(stE + 4 * lane); *(u32x4*)(RE + ob + 256) = *(const LAS u32x4*)(stE + 256 + 4 * lane);
          *(u32x4*)(RS + ob) = *(const LAS u32x4*)(stS + 4 * lane); *(u32x4*)(RS + ob + 256) = *(const LAS u32x4*)(stS + 256 + 4 * lane); }
        LDS_WAIT();
    }
}
__device__ __forceinline__ void peer_route_phase(const Params& p, LAS unsigned char* lds, int tid, int wave, int lane) {
    peer_route_stage_keys(p, lds, tid);
#pragma unroll 1
#if PROJ_I8 && PQ_I8 && STAGE_CROSS
    for (int pm = blockIdx.x; pm < T_TOK / 256; pm += gridDim.x)
#pragma unroll 1
        for (int k = 0; k < 64 / NWAVES; ++k) peer_route_task(p, lds, pm * 64 + wave + NWAVES * k, lane);
#else
    for (int task = blockIdx.x * NWAVES + wave; task < T_TOK / 4; task += gridDim.x * NWAVES) peer_route_task(p, lds, task, lane);
#endif
}
__device__ __forceinline__ float gelu_erf(float v) {
    const float av = fabsf(v), t = fast_rcp(av * 0.2316418882f + 1.0f);
    float q = t * 0.5307027145f + (-0.7265760135f); q = q * t + 0.7107068705f; q = q * t + (-0.142248368f); q = q * t + 0.127414796f; q = q * t;
    const float e = fast_exp2(v * v * (-0.72134752044f)); const float m = v * (q * e);
    return v < 0.f ? m : v - m;
}
__device__ __forceinline__ void unpack_fp8x16(const u32x4 w, float (&o)[16]) {
#pragma unroll
    for (int q = 0; q < 4; ++q) { const f32x2 lo = __builtin_amdgcn_cvt_pk_f32_fp8((int)w[q], false), hi = __builtin_amdgcn_cvt_pk_f32_fp8((int)w[q], true);
        o[4 * q] = lo.x; o[4 * q + 1] = lo.y; o[4 * q + 2] = hi.x; o[4 * q + 3] = hi.y; }
}
__device__ __forceinline__ float wave_prefix_incl(float x) {
    x = prefix16(x);
    const float t0 = __builtin_bit_cast(float, __builtin_amdgcn_readlane(__builtin_bit_cast(int, x), 15)), t1 = __builtin_bit_cast(float, __builtin_amdgcn_readlane(__builtin_bit_cast(int, x), 31)),
                t2 = __builtin_bit_cast(float, __builtin_amdgcn_readlane(__builtin_bit_cast(int, x), 47));
    const int row = (int)(__builtin_amdgcn_mbcnt_hi(~0u, __builtin_amdgcn_mbcnt_lo(~0u, 0u)) >> 4);
    return x + (row >= 1 ? t0 : 0.f) + (row >= 2 ? t1 : 0.f) + (row >= 3 ? t2 : 0.f);
}
template <class BarT> __device__ __forceinline__ void bar_sync(const BarT& b);
#ifndef GNT
#define GNT 2
#endif
#ifndef GATHER_SPLIT
#define GATHER_SPLIT 0
#endif

#ifndef GATHER_PROBE_LOADS
#define GATHER_PROBE_LOADS 0
#endif
#ifndef GATHER_PROBE2
#define GATHER_PROBE2 0
#endif
#ifndef VSET
#define VSET 4
#endif
constexpr int GFIN_LDS_OFF = 8 * (512 + 4096 + 8192) + 1024;
#ifndef VBUF4
#define VBUF4 0
#endif
#ifndef UBUF4
#define UBUF4 0
#endif
#ifndef PEER_FUSED
#define PEER_FUSED 0
#endif
template <class BarT> __device__ __forceinline__ void bar_sync(const BarT& b);
template <class BarT> __device__ __forceinline__ void peer_gather_phase(const Params& p, LAS unsigned char* lds, int wave, int lane, float amp, const BarT& bar) {
    unsigned char* ws = p.ws; const bf16_t* H = (const bf16_t*)(ws + WS_H); const unsigned char* PU = ws + WS_PU; const unsigned char* PV = ws + WS_PV;
    const int* RE = (const int*)(ws + WS_RE); const float* RS = (const float*)(ws + WS_RS);
    const int gw = blockIdx.x * NWAVES + wave, NGW = gridDim.x * NWAVES;
    const float* gf = p.in[29] + 16 * lane;
#if PEER_FUSED
    LAS unsigned char* wb = lds + 2 * PK2_OFF + wave * (512 + 4096); LAS unsigned* cnt = (LAS unsigned*)wb; LAS unsigned char* lst = wb + 512;
    peer_route_stage_keys(p, lds, (int)(wave * 64 + lane));
#else
    LAS unsigned char* wb = lds + wave * (512 + 4096 + 8192); LAS unsigned* cnt = (LAS unsigned*)wb; LAS unsigned char* lst = wb + 512; LAS unsigned char* hxl = wb + 512 + 4096 + lane * 32;
#endif
    __syncthreads();
    LAS float* gfl = (LAS float*)(lds + GFIN_LDS_OFF);
    for (int i = wave * 64 + lane; i < D_MODEL / 4; i += NTHREADS) ((LAS f32x4*)gfl)[i] = ((const f32x4*)p.in[29])[i];
    __syncthreads();
    const f32x4 g0 = *(const f32x4*)(gf), g1 = *(const f32x4*)(gf + 4), g2 = *(const f32x4*)(gf + 8), g3 = *(const f32x4*)(gf + 12);
    const int ngroups = (T_TOK + GNT - 1) / GNT, nrounds = (ngroups + NGW - 1) / NGW;
#pragma unroll 1
    for (int rnd = 0; rnd < nrounds; ++rnd) {
        const int tok0 = (rnd * NGW + gw) * GNT;
#if GATHER_SYNC
        if (rnd > 0 && (rnd % GATHER_SYNC) == 0) bar_sync(bar);
#endif
#if PEER_FUSED
        if (tok0 < T_TOK) peer_route_task(p, lds, tok0 >> 2, lane);
        asm volatile("s_waitcnt vmcnt(0)" ::: "memory");
#endif
#if PEER_FUSED
#define GS_KEEP(S) do { } while (0)
#else
#define GS_KEEP(S) do { *(LAS u32x4*)(hxl + S * 2048) = xa; *(LAS u32x4*)(hxl + S * 2048 + 16) = xb; } while (0)
#endif
#if GATHER_UI4
#define GS_DECL(S) float ac##S[16]; float c1_##S; float hs_##S
#define GS_AMAX(S) do { float am_ = 0.f; _Pragma("unroll") for (int j = 0; j < 16; ++j) am_ = fmaxf(am_, fabsf(hx_[j])); \
            hs_##S = 119.f / fmaxf(xrow_max(max16(am_)), 1e-20f); c1_##S = c1_##S * (512.f / PU_QS) / hs_##S; } while (0)
#else
#define GS_DECL(S) float ac##S[16]; float c1_##S
#define GS_AMAX(S) do { } while (0)
#endif
#define GS_HX(XA, XB) float hx_[16]; hx_[0] = bf_lo(XA.x); hx_[1] = bf_hi(XA.x); hx_[2] = bf_lo(XA.y); hx_[3] = bf_hi(XA.y); hx_[4] = bf_lo(XA.z); hx_[5] = bf_hi(XA.z); hx_[6] = bf_lo(XA.w); hx_[7] = bf_hi(XA.w); \
            hx_[8] = bf_lo(XB.x); hx_[9] = bf_hi(XB.x); hx_[10] = bf_lo(XB.y); hx_[11] = bf_hi(XB.y); hx_[12] = bf_lo(XB.z); hx_[13] = bf_hi(XB.z); hx_[14] = bf_lo(XB.w); hx_[15] = bf_hi(XB.w)
#define GS_SETUP(S) do { const int t_ = tok0 + S < T_TOK ? tok0 + S : T_TOK - 1; \
            const u32x4 xa = *(const u32x4*)(H + (size_t)t_ * D_MODEL + 16 * lane), xb = *(const u32x4*)(H + (size_t)t_ * D_MODEL + 16 * lane + 8); \
            GS_KEEP(S); GS_HX(xa, xb); \
            float ss_ = 0.f; _Pragma("unroll") for (int j = 0; j < 16; ++j) { ss_ = fmaf(hx_[j], hx_[j], ss_); ac##S[j] = 0.f; } \
            c1_##S = (1.f / 512.f) / sqrtf(wave_sum(ss_) * (1.f / D_MODEL) + RMS_EPS); \
            GS_AMAX(S); \
            const int e0_ = RE[(size_t)t_ * 128 + lane], e1_ = RE[(size_t)t_ * 128 + 64 + lane]; const float s0_ = RS[(size_t)t_ * 128 + lane], s1_ = RS[(size_t)t_ * 128 + 64 + lane]; \
            const float p0_ = fast_exp2((s0_ - max16(s0_)) * LOG2E), p1_ = fast_exp2((s1_ - max16(s1_)) * LOG2E); \
            const float gt0_ = p0_ / sum16(p0_) * (1.f / PV_SCALE), gt1_ = p1_ / sum16(p1_) * (1.f / PV_SCALE); \
            cnt[lane] = 0u; LDS_WAIT(); \
            const unsigned r0_ = __hip_atomic_fetch_add(cnt + (e0_ >> 8), 1u, __ATOMIC_RELAXED, __HIP_MEMORY_SCOPE_WAVEFRONT), r1_ = __hip_atomic_fetch_add(cnt + (e1_ >> 8), 1u, __ATOMIC_RELAXED, __HIP_MEMORY_SCOPE_WAVEFRONT); \
            LDS_WAIT(); \
            { const float cf_ = (float)cnt[lane]; const float incl_ = wave_prefix_incl(cf_); LDS_WAIT(); cnt[lane] = (unsigned)(incl_ - cf_); LDS_WAIT(); } \
            { LAS u32x2* list_ = (LAS u32x2*)(lst + S * 1024); list_[cnt[e0_ >> 8] + r0_] = (u32x2){(unsigned)e0_, __float_as_uint(gt0_)}; list_[cnt[e1_ >> 8] + r1_] = (u32x2){(unsigned)e1_, __float_as_uint(gt1_)}; } \
            LDS_WAIT(); } while (0)
#define GS_FIN(S) do { const u32x4 xa = *(const LAS u32x4*)(hxl + S * 2048), xb = *(const LAS u32x4*)(hxl + S * 2048 + 16); GS_HX(xa, xb); float s3_ = 0.f; _Pragma("unroll") for (int j = 0; j < 16; ++j) { hx_[j] = fmaf(amp, ac##S[j], hx_[j]); s3_ = fmaf(hx_[j], hx_[j], s3_); } \
            const float r3_ = 1.f / sqrtf(wave_sum(s3_) * (1.f / D_MODEL) + RMS_EPS); float* orow = p.out + (size_t)(tok0 + S) * D_MODEL + 16 * lane; if (tok0 + S < T_TOK) { \
            *(f32x4*)(orow) = (f32x4){hx_[0], hx_[1], hx_[2], hx_[3]} * r3_ * g0; *(f32x4*)(orow + 4) = (f32x4){hx_[4], hx_[5], hx_[6], hx_[7]} * r3_ * g1; \
            *(f32x4*)(orow + 8) = (f32x4){hx_[8], hx_[9], hx_[10], hx_[11]} * r3_ * g2; *(f32x4*)(orow + 12) = (f32x4){hx_[12], hx_[13], hx_[14], hx_[15]} * r3_ * g3; } } while (0)
#define G_LOAD(X, S, C) do { _Pragma("unroll") for (int i = 0; i < 4; ++i) { const size_t e_ = (size_t)(unsigned)__builtin_amdgcn_readfirstlane((int)((const LAS u32x2*)(lst + S * 1024))[4 * (C) + i].x); \
            X##u[i] = *(const u32x4*)(PU + e_ * D_MODEL + 16 * lane); X##v[i] = *(const u32x4*)(PV + e_ * D_MODEL + 16 * lane); } } while (0)
#define G_PROC(X, S, C) do { float pd_[4]; const u32x4 xa = *(const LAS u32x4*)(hxl + S * 2048), xb = *(const LAS u32x4*)(hxl + S * 2048 + 16); GS_HX(xa, xb); \
            _Pragma("unroll") for (int i = 0; i < 4; ++i) { float uf[16]; unpack_fp8x16(X##u[i], uf); float da = uf[0] * hx_[0], db = uf[1] * hx_[1]; \
                _Pragma("unroll") for (int j = 2; j < 16; j += 2) { da = fmaf(uf[j], hx_[j], da); db = fmaf(uf[j + 1], hx_[j + 1], db); } pd_[i] = da + db; } \
              \
            const auto s01_ = __builtin_amdgcn_permlane32_swap(__float_as_uint(pd_[0]), __float_as_uint(pd_[1]), false, false); const float r01_ = __uint_as_float(s01_[0]) + __uint_as_float(s01_[1]); \
            const auto s23_ = __builtin_amdgcn_permlane32_swap(__float_as_uint(pd_[2]), __float_as_uint(pd_[3]), false, false); const float r23_ = __uint_as_float(s23_[0]) + __uint_as_float(s23_[1]); \
            const auto sq_ = __builtin_amdgcn_permlane16_swap(__float_as_uint(r01_), __float_as_uint(r23_), false, false); const float dsum_ = sum16(__uint_as_float(sq_[0]) + __uint_as_float(sq_[1])); \
            const float q0_ = __uint_as_float(((const LAS u32x2*)(lst + S * 1024))[4 * (C)].y), q1_ = __uint_as_float(((const LAS u32x2*)(lst + S * 1024))[4 * (C) + 1].y), \
                        q2_ = __uint_as_float(((const LAS u32x2*)(lst + S * 1024))[4 * (C) + 2].y), q3_ = __uint_as_float(((const LAS u32x2*)(lst + S * 1024))[4 * (C) + 3].y); \
            const float gsel_ = lane < 16 ? q0_ : (lane < 32 ? q2_ : (lane < 48 ? q1_ : q3_)); \
            const float wvec_ = gelu_erf(dsum_ * c1_##S) * gsel_; float w_[4]; \
            w_[0] = __builtin_bit_cast(float, __builtin_amdgcn_readlane(__builtin_bit_cast(int, wvec_), 0)); w_[2] = __builtin_bit_cast(float, __builtin_amdgcn_readlane(__builtin_bit_cast(int, wvec_), 16)); \
            w_[1] = __builtin_bit_cast(float, __builtin_amdgcn_readlane(__builtin_bit_cast(int, wvec_), 32)); w_[3] = __builtin_bit_cast(float, __builtin_amdgcn_readlane(__builtin_bit_cast(int, wvec_), 48)); \
            _Pragma("unroll") for (int i = 0; i < 4; ++i) { float vf[16]; unpack_fp8x16(X##v[i], vf); _Pragma("unroll") for (int j = 0; j < 16; ++j) ac##S[j] = fmaf(w_[i], vf[j], ac##S[j]); } } while (0)
        u32x4 Au[4], Av[4], Bu[4], Bv[4];
#if GNT == 2
        GS_DECL(0); GS_DECL(1); GS_SETUP(0); GS_SETUP(1);
        G_LOAD(A, 0, 0);
#pragma unroll 1
        for (int c = 0; c < 32; ++c) {
            G_LOAD(B, 1, c); G_PROC(A, 0, c);
            if (c < 31) G_LOAD(A, 0, c + 1);
            G_PROC(B, 1, c);
        }
        GS_FIN(0); GS_FIN(1);
#elif GNT == 3
        GS_DECL(0); GS_DECL(1); GS_DECL(2); GS_SETUP(0); GS_SETUP(1); GS_SETUP(2);
        G_LOAD(A, 0, 0);
#pragma unroll 1
        for (int c = 0; c < 32; c += 2) {
            G_LOAD(B, 1, c); G_PROC(A, 0, c);
            G_LOAD(A, 2, c); G_PROC(B, 1, c);
            G_LOAD(B, 0, c + 1); G_PROC(A, 2, c);
            G_LOAD(A, 1, c + 1); G_PROC(B, 0, c + 1);
            G_LOAD(B, 2, c + 1); G_PROC(A, 1, c + 1);
            if (c < 30) G_LOAD(A, 0, c + 2);
            G_PROC(B, 2, c + 1);
        }
        GS_FIN(0); GS_FIN(1); GS_FIN(2);
#elif GNT == 4 && GATHER_SPLIT
        GS_DECL(0); GS_DECL(1); GS_DECL(2); GS_DECL(3); GS_SETUP(0); GS_SETUP(1); GS_SETUP(2); GS_SETUP(3);
#if GATHER_UI4
        {   u32x4 Ar[8], Br[8];
            const int un = lane & 31, uh = lane >> 5; const unsigned char* PUl = PU + 16 * un;
#if PEER_FUSED
#define U_HROW(S) const u32x4* hr_ = (const u32x4*)(H + (size_t)(tok0 + S < T_TOK ? tok0 + S : T_TOK - 1) * D_MODEL + 32 * un)
#else
#define U_HROW(S) LAS const u32x4* hr_ = (const LAS u32x4*)(wb + 512 + 4096 + S * 2048 + 64 * un)
#endif
#define U_HQ(S) unsigned h0_##S[4], h1_##S[4]; { U_HROW(S); unsigned bb_[8]; \
                _Pragma("unroll") for (int q = 0; q < 4; ++q) { const u32x4 x_ = hr_[q]; unsigned b0_ = 0u, b1_ = 0u; \
                    b0_ = __builtin_amdgcn_cvt_pk_u8_f32(__builtin_rintf(fmaf(bf_lo(x_.x), hs_##S, 136.f)), 0, b0_); b0_ = __builtin_amdgcn_cvt_pk_u8_f32(__builtin_rintf(fmaf(bf_hi(x_.x), hs_##S, 136.f)), 1, b0_); \
                    b0_ = __builtin_amdgcn_cvt_pk_u8_f32(__builtin_rintf(fmaf(bf_lo(x_.y), hs_##S, 136.f)), 2, b0_); b0_ = __builtin_amdgcn_cvt_pk_u8_f32(__builtin_rintf(fmaf(bf_hi(x_.y), hs_##S, 136.f)), 3, b0_); \
                    b1_ = __builtin_amdgcn_cvt_pk_u8_f32(__builtin_rintf(fmaf(bf_lo(x_.z), hs_##S, 136.f)), 0, b1_); b1_ = __builtin_amdgcn_cvt_pk_u8_f32(__builtin_rintf(fmaf(bf_hi(x_.z), hs_##S, 136.f)), 1, b1_); \
                    b1_ = __builtin_amdgcn_cvt_pk_u8_f32(__builtin_rintf(fmaf(bf_lo(x_.w), hs_##S, 136.f)), 2, b1_); b1_ = __builtin_amdgcn_cvt_pk_u8_f32(__builtin_rintf(fmaf(bf_hi(x_.w), hs_##S, 136.f)), 3, b1_); \
                    bb_[2 * q] = b0_ ^ 0x88888888u; bb_[2 * q + 1] = b1_ ^ 0x88888888u; } \
                _Pragma("unroll") for (int d = 0; d < 4; ++d) { h0_##S[d] = (bb_[2 * d] & 0x0f0f0f0fu) | ((bb_[2 * d + 1] & 0x0f0f0f0fu) << 4); h1_##S[d] = ((bb_[2 * d] >> 4) & 0x0f0f0f0fu) | (bb_[2 * d + 1] & 0xf0f0f0f0u); } }
            U_HQ(0); U_HQ(1); U_HQ(2); U_HQ(3);
#define U_LOAD16(X, S, C) do { _Pragma("unroll") for (int i = 0; i < 8; ++i) X##r[i] = *(const u32x4*)(PUl + (size_t)((const LAS u32x2*)(lst + (S) * 1024))[16 * (C) + 2 * i + uh].x * PU_ROWB); } while (0)
#define U_DOTB(X, S, C, BH) do { float pd_[4]; \
                _Pragma("unroll") for (int k = 0; k < 4; ++k) { const u32x4 w_ = X##r[4 * (BH) + k]; int d1_ = 0, d0_ = 0; \
                    _Pragma("unroll") for (int d = 0; d < 4; ++d) { d1_ = __builtin_amdgcn_sdot8((int)w_[d], (int)h1_##S[d], d1_, false); d0_ = __builtin_amdgcn_sdot8((int)w_[d], (int)h0_##S[d], d0_, false); } \
                    pd_[k] = (float)(16 * d1_ + d0_); } \
                const auto sa_ = __builtin_amdgcn_permlane16_swap(__float_as_uint(pd_[0]), __float_as_uint(pd_[1]), false, false); const float q0_ = __uint_as_float(sa_[0]) + __uint_as_float(sa_[1]); \
                const auto sb_ = __builtin_amdgcn_permlane16_swap(__float_as_uint(pd_[2]), __float_as_uint(pd_[3]), false, false); const float q1_ = __uint_as_float(sb_[0]) + __uint_as_float(sb_[1]); \
                const bool hi8_ = (lane & 8) != 0; const float dsum_ = sum8((hi8_ ? q1_ : q0_) + dpp<DPP_ROR8>(hi8_ ? q0_ : q1_)); \
                const int rr_ = lane >> 4; const int pi_ = 8 * (BH) + 2 * ((rr_ & 1) + (hi8_ ? 2 : 0)) + (rr_ >> 1); \
                LAS u32x2* le_ = (LAS u32x2*)(lst + (S) * 1024) + 16 * (C); \
                const float wvec_ = gelu_erf(dsum_ * c1_##S) * __uint_as_float(le_[pi_].y); \
                LDS_WAIT(); if ((lane & 7) == 0) le_[pi_].y = __float_as_uint(wvec_); } while (0)
#if UBUF4
            u32x4 Cr[8], Dr[8];
            U_LOAD16(A, 0, 0); U_LOAD16(B, 1, 0); U_LOAD16(C, 2, 0);
#pragma unroll 1
            for (int c = 0; c < 7; ++c) {
                U_LOAD16(D, 3, c); U_DOTB(A, 0, c, 0); U_DOTB(A, 0, c, 1); __builtin_amdgcn_sched_barrier(0);
                U_LOAD16(A, 0, c + 1); U_DOTB(B, 1, c, 0); U_DOTB(B, 1, c, 1); __builtin_amdgcn_sched_barrier(0);
                U_LOAD16(B, 1, c + 1); U_DOTB(C, 2, c, 0); U_DOTB(C, 2, c, 1); __builtin_amdgcn_sched_barrier(0);
                U_LOAD16(C, 2, c + 1); U_DOTB(D, 3, c, 0); U_DOTB(D, 3, c, 1); __builtin_amdgcn_sched_barrier(0);
            }
            {
                U_LOAD16(D, 3, 7); U_DOTB(A, 0, 7, 0); U_DOTB(A, 0, 7, 1); __builtin_amdgcn_sched_barrier(0);
                U_DOTB(B, 1, 7, 0); U_DOTB(B, 1, 7, 1); __builtin_amdgcn_sched_barrier(0);
                U_DOTB(C, 2, 7, 0); U_DOTB(C, 2, 7, 1); __builtin_amdgcn_sched_barrier(0);
                U_DOTB(D, 3, 7, 0); U_DOTB(D, 3, 7, 1); __builtin_amdgcn_sched_barrier(0);
            }
#else
            U_LOAD16(A, 0, 0);
#pragma unroll 1
            for (int c = 0; c < 8; ++c) {
                U_LOAD16(B, 1, c); U_DOTB(A, 0, c, 0); U_DOTB(A, 0, c, 1); __builtin_amdgcn_sched_barrier(0);
                U_LOAD16(A, 2, c); U_DOTB(B, 1, c, 0); U_DOTB(B, 1, c, 1); __builtin_amdgcn_sched_barrier(0);
                U_LOAD16(B, 3, c); U_DOTB(A, 2, c, 0); U_DOTB(A, 2, c, 1); __builtin_amdgcn_sched_barrier(0);
                if (c < 7) U_LOAD16(A, 0, c + 1);
                U_DOTB(B, 3, c, 0); U_DOTB(B, 3, c, 1); __builtin_amdgcn_sched_barrier(0);
            }
#endif
#undef U_HQ
#undef U_HROW
#undef U_LOAD16
#undef U_DOTB
#else
        {   u32x4 Ar[8], Br[8];
#define U_LOAD2(X, S0, C) do { _Pragma("unroll") for (int i = 0; i < 8; ++i) { const size_t e_ = (size_t)(unsigned)__builtin_amdgcn_readfirstlane((int)((const LAS u32x2*)(lst + ((S0) + (i >> 2)) * 1024))[4 * (C) + (i & 3)].x); \
                X##r[i] = *(const u32x4*)(PU + e_ * D_MODEL + 16 * lane); } } while (0)
#define U_HX2(S) f32x2 h2_##S[8]; { const u32x4 xa = *(const LAS u32x4*)(hxl + S * 2048), xb = *(const LAS u32x4*)(hxl + S * 2048 + 16); \
                _Pragma("unroll") for (int q = 0; q < 4; ++q) { h2_##S[q] = (f32x2){bf_lo(xa[q]), bf_hi(xa[q])}; h2_##S[4 + q] = (f32x2){bf_lo(xb[q]), bf_hi(xb[q])}; } }
            U_HX2(0); U_HX2(1); U_HX2(2); U_HX2(3);
#define U_LOAD8(X, S, C2) do { _Pragma("unroll") for (int i = 0; i < 8; ++i) { const size_t e_ = (size_t)(unsigned)__builtin_amdgcn_readfirstlane((int)((const LAS u32x2*)(lst + (S) * 1024))[8 * (C2) + i].x); \
                X##r[i] = *(const u32x4*)(PU + e_ * D_MODEL + 16 * lane); } } while (0)
#define U_DOTS8(X, S, C2) do { float pd_[8]; \
                _Pragma("unroll") for (int i = 0; i < 8; ++i) { const u32x4 w_ = X##r[i]; f32x2 d_ = __builtin_amdgcn_cvt_pk_f32_fp8((int)w_[0], false) * h2_##S[0]; \
                    d_ = __builtin_elementwise_fma(__builtin_amdgcn_cvt_pk_f32_fp8((int)w_[0], true), h2_##S[1], d_); \
                    _Pragma("unroll") for (int q = 1; q < 4; ++q) { d_ = __builtin_elementwise_fma(__builtin_amdgcn_cvt_pk_f32_fp8((int)w_[q], false), h2_##S[2 * q], d_); \
                        d_ = __builtin_elementwise_fma(__builtin_amdgcn_cvt_pk_f32_fp8((int)w_[q], true), h2_##S[2 * q + 1], d_); } pd_[i] = d_.x + d_.y; } \
                float r_[4]; _Pragma("unroll") for (int i = 0; i < 4; ++i) { const auto s_ = __builtin_amdgcn_permlane32_swap(__float_as_uint(pd_[2 * i]), __float_as_uint(pd_[2 * i + 1]), false, false); r_[i] = __uint_as_float(s_[0]) + __uint_as_float(s_[1]); } \
                const auto sa_ = __builtin_amdgcn_permlane16_swap(__float_as_uint(r_[0]), __float_as_uint(r_[1]), false, false); const float q0_ = __uint_as_float(sa_[0]) + __uint_as_float(sa_[1]); \
                const auto sb_ = __builtin_amdgcn_permlane16_swap(__float_as_uint(r_[2]), __float_as_uint(r_[3]), false, false); const float q1_ = __uint_as_float(sb_[0]) + __uint_as_float(sb_[1]); \
                const bool hi8_ = (lane & 8) != 0; const float dsum_ = sum8((hi8_ ? q1_ : q0_) + dpp<DPP_ROR8>(hi8_ ? q0_ : q1_)); \
                LAS u32x2* le_ = (LAS u32x2*)(lst + (S) * 1024) + 8 * (C2); \
                const int pi_ = (lane < 16 ? 0 : (lane < 32 ? 2 : (lane < 48 ? 1 : 3))) + (hi8_ ? 4 : 0); \
                const float wvec_ = gelu_erf(dsum_ * c1_##S) * __uint_as_float(le_[pi_].y); \
                LDS_WAIT(); if ((lane & 7) == 0) le_[pi_].y = __float_as_uint(wvec_); } while (0)
            U_LOAD8(A, 0, 0);
#pragma unroll 1
            for (int c = 0; c < 16; ++c) {
                U_LOAD8(B, 1, c); U_DOTS8(A, 0, c); __builtin_amdgcn_sched_barrier(0);
                U_LOAD8(A, 2, c); U_DOTS8(B, 1, c); __builtin_amdgcn_sched_barrier(0);
                U_LOAD8(B, 3, c); U_DOTS8(A, 2, c); __builtin_amdgcn_sched_barrier(0);
                if (c < 15) U_LOAD8(A, 0, c + 1);
                U_DOTS8(B, 3, c); __builtin_amdgcn_sched_barrier(0);
            }
#undef U_LOAD8
#undef U_DOTS8
#if GATHER_PROBE2
            {
                unsigned x_ = 0u; const int pm_ = lane & 31, pg_ = lane >> 5;
#define P2_BATCH(S, BT, KH) do { const unsigned char* rp_ = PU + (size_t)((const LAS u32x2*)(lst + (S) * 1024))[32 * (BT) + pm_].x * D_MODEL + 16 * pg_ + 512 * (KH); u32x4 t_[16]; \
                    _Pragma("unroll") for (int i = 0; i < 16; ++i) t_[i] = *(const u32x4*)(rp_ + 32 * i); \
                    _Pragma("unroll") for (int i = 0; i < 16; ++i) x_ |= (t_[i].x ^ t_[i].y) & (t_[i].z ^ t_[i].w); } while (0)
#pragma unroll 1
                for (int bt = 0; bt < 4; ++bt) { P2_BATCH(0, bt, 0); P2_BATCH(0, bt, 1); P2_BATCH(1, bt, 0); P2_BATCH(1, bt, 1); P2_BATCH(2, bt, 0); P2_BATCH(2, bt, 1); P2_BATCH(3, bt, 0); P2_BATCH(3, bt, 1); }
                asm volatile("" :: "v"(x_));
#undef P2_BATCH
            }
#endif
#undef U_LOAD2
#undef U_HX2
#endif
            LDS_WAIT();
#if GATHER_VMMA == 2
            f32x16 vc0, vc1, vc2, vc3;
#pragma unroll
            for (int t = 0; t < 16; ++t) { vc0[t] = 0.f; vc1[t] = 0.f; vc2[t] = 0.f; vc3[t] = 0.f; }
            const int vn = lane & 31, vg = lane >> 5;
            const unsigned char* PVl = PV + 16 * vn; const unsigned char* PVh = PV + 512 + 8 * vn;
            const int vsel = vn >> 2, vsh = 8 * (vn & 3); const int d6 = (6 * vn) >> 5, sh6 = (6 * vn) & 31;
#if V6_DIAG_FP8
#define V6_BOP(X, S) const u32x4 d_ = X##r[i], d2_ = X##r2[i]; const i32x8g b_ = {(int)d_.x, (int)d_.y, (int)d_.z, (int)d_.w, (int)d2_.x, (int)d2_.y, (int)d2_.z, (int)d2_.w}; \
                vc##S = __builtin_amdgcn_mfma_scale_f32_32x32x64_f8f6f4(a_, b_, vc##S, 0, 0, 0, 0, 0, 0)
#else
#define V6_BOP(X, S) const u32x4 d_ = X##r[i]; const u32x2 e2_ = X##q[i]; const i32x8g b_ = {(int)d_.x, (int)d_.y, (int)d_.z, (int)d_.w, (int)e2_.x, (int)e2_.y, 0, 0}; \
                vc##S = __builtin_amdgcn_mfma_scale_f32_32x32x64_f8f6f4(a_, b_, vc##S, 0, 2, 0, 0x7f7f7f7f, 0, 0x7f7f7f7f)
#endif
            { u32x4 Ar[VSET], Br[VSET]; u32x2 Aq[VSET], Bq[VSET]; u32x4 Ar2[V6_DIAG_FP8 ? VSET : 1], Br2[V6_DIAG_FP8 ? VSET : 1];
#if VBUF4
              u32x4 Cr[VSET], Dr[VSET]; u32x2 Cq[VSET], Dq[VSET];
#endif
#if V6_DIAG_FP8
#define V_LOAD6(X, S, C) do { _Pragma("unroll") for (int i = 0; i < VSET; ++i) { const size_t ro_ = (size_t)((const LAS u32x2*)(lst + (S) * 1024))[2 * VSET * (C) + 2 * i + vg].x * 1024; \
                X##r[i] = *(const u32x4*)(PV + 32 * vn + ro_); X##r2[i] = *(const u32x4*)(PV + 32 * vn + 16 + ro_); } } while (0)
#else
#define V_LOAD6(X, S, C) do { _Pragma("unroll") for (int i = 0; i < VSET; ++i) { const size_t ro_ = (size_t)((const LAS u32x2*)(lst + (S) * 1024))[2 * VSET * (C) + 2 * i + vg].x * PV_ROWB; \
                X##r[i] = *(const u32x4*)(PVl + ro_); X##q[i] = *(const u32x2*)(PVh + ro_); } } while (0)
#endif
#if V6_DIAG_FP8
#define V_MMA6(X, S, C) do { _Pragma("unroll") for (int i = 0; i < VSET; ++i) { const float w64_ = fminf(__uint_as_float(((const LAS u32x2*)(lst + (S) * 1024))[2 * VSET * (C) + 2 * i + vg].y) * (64.f * PV_SCALE), 440.f); \
                const unsigned sh_ = (unsigned)(__builtin_amdgcn_cvt_pk_fp8_f32(w64_, 0.f, 0, false) & 0xff) << vsh; \
                const i32x8g a_ = {(int)(vsel == 0 ? sh_ : 0u), (int)(vsel == 1 ? sh_ : 0u), (int)(vsel == 2 ? sh_ : 0u), (int)(vsel == 3 ? sh_ : 0u), (int)(vsel == 4 ? sh_ : 0u), (int)(vsel == 5 ? sh_ : 0u), (int)(vsel == 6 ? sh_ : 0u), (int)(vsel == 7 ? sh_ : 0u)}; \
                V6_BOP(X, S); } } while (0)
#else
#define V_MMA6(X, S, C) do { _Pragma("unroll") for (int i = 0; i < VSET; ++i) { const unsigned t_ = ((const LAS u32x2*)(lst + (S) * 1024))[2 * VSET * (C) + 2 * i + vg].y + 0x00080000u; \
                const unsigned code_ = ((t_ >> 26) & 0x20u) | 0x8u | ((t_ >> 20) & 7u); const int sc_ = (int)((t_ >> 23) & 0xffu); \
                const unsigned long long v_ = (unsigned long long)code_ << sh6; const unsigned lo_ = (unsigned)v_, hi_ = (unsigned)(v_ >> 32); \
                const i32x8g a_ = {(int)(d6 == 0 ? lo_ : 0u), (int)((d6 == 1 ? lo_ : 0u) | (d6 == 0 ? hi_ : 0u)), (int)((d6 == 2 ? lo_ : 0u) | (d6 == 1 ? hi_ : 0u)), (int)((d6 == 3 ? lo_ : 0u) | (d6 == 2 ? hi_ : 0u)), \
                                   (int)((d6 == 4 ? lo_ : 0u) | (d6 == 3 ? hi_ : 0u)), (int)((d6 == 5 ? lo_ : 0u) | (d6 == 4 ? hi_ : 0u)), 0, 0}; \
                const u32x4 d_ = X##r[i]; const u32x2 e2_ = X##q[i]; const i32x8g b_ = {(int)d_.x, (int)d_.y, (int)d_.z, (int)d_.w, (int)e2_.x, (int)e2_.y, 0, 0}; \
                vc##S = __builtin_amdgcn_mfma_scale_f32_32x32x64_f8f6f4(a_, b_, vc##S, 2, 2, 0, sc_, 0, 0x7f); } } while (0)
#endif
#if VBUF4
            V_LOAD6(A, 0, 0); V_LOAD6(B, 1, 0); V_LOAD6(C, 2, 0);
#pragma unroll 1
            for (int c = 0; c < 64 / VSET; ++c) { const int cn = c + 1 < 64 / VSET ? c + 1 : c;
                V_LOAD6(D, 3, c); V_MMA6(A, 0, c); __builtin_amdgcn_sched_barrier(0);
                V_LOAD6(A, 0, cn); V_MMA6(B, 1, c); __builtin_amdgcn_sched_barrier(0);
                V_LOAD6(B, 1, cn); V_MMA6(C, 2, c); __builtin_amdgcn_sched_barrier(0);
                V_LOAD6(C, 2, cn); V_MMA6(D, 3, c); __builtin_amdgcn_sched_barrier(0);
            }
#else
            V_LOAD6(A, 0, 0);
#pragma unroll 1
            for (int c = 0; c < 64 / VSET; ++c) {
                V_LOAD6(B, 1, c); V_MMA6(A, 0, c); __builtin_amdgcn_sched_barrier(0);
                V_LOAD6(A, 2, c); V_MMA6(B, 1, c); __builtin_amdgcn_sched_barrier(0);
                V_LOAD6(B, 3, c); V_MMA6(A, 2, c); __builtin_amdgcn_sched_barrier(0);
                if (c < 64 / VSET - 1) V_LOAD6(A, 0, c + 1);
                V_MMA6(B, 3, c); __builtin_amdgcn_sched_barrier(0);
            }
#endif
#undef V_LOAD6
#undef V_MMA6
#undef V6_BOP
            }
#if PEER_FUSED
#define V6_HB(S, Q) (*(const u32x2*)(H + (size_t)(tok0 + S < T_TOK ? tok0 + S : T_TOK - 1) * D_MODEL + cb_ + 8 * (Q)))
#else
#define V6_HB(S, Q) (*(const LAS u32x2*)(wb + 512 + 4096 + S * 2048 + 2 * (cb_ + 8 * (Q))))
#endif
#define V_FIN6(S) do { const int cb_ = 32 * vn + 4 * vg; float s3_ = 0.f; f32x4 h3_[4]; \
                _Pragma("unroll") for (int q = 0; q < 4; ++q) { const u32x2 hb_ = V6_HB(S, q); \
                    const f32x4 a_ = {vc##S[4 * q], vc##S[4 * q + 1], vc##S[4 * q + 2], vc##S[4 * q + 3]}; \
                    h3_[q] = (f32x4){bf_lo(hb_.x), bf_hi(hb_.x), bf_lo(hb_.y), bf_hi(hb_.y)} + a_ * (amp * (V6_DIAG_FP8 ? 1.f / (64.f * PV_SCALE) : 1.f)); \
                    s3_ += h3_[q][0] * h3_[q][0] + h3_[q][1] * h3_[q][1] + h3_[q][2] * h3_[q][2] + h3_[q][3] * h3_[q][3]; } \
                const float r3_ = 1.f / sqrtf(wave_sum(s3_) * (1.f / D_MODEL) + RMS_EPS); \
                  \
                { LAS float* stg_ = (LAS float*)wb; \
                  _Pragma("unroll") for (int q = 0; q < 4; ++q) { const f32x4 gq_ = *(const LAS f32x4*)(gfl + cb_ + 8 * q); const int c_ = cb_ + 8 * q; *(LAS f32x4*)(stg_ + c_ + 4 * (c_ >> 5)) = h3_[q] * r3_ * gq_; } \
                  LDS_WAIT(); \
                  if (tok0 + S < T_TOK) { _Pragma("unroll") for (int j = 0; j < 4; ++j) { const int c_ = 256 * j + 4 * lane; \
                      *(f32x4*)(p.out + (size_t)(tok0 + S) * D_MODEL + c_) = *(const LAS f32x4*)(stg_ + c_ + 4 * (c_ >> 5)); } } \
                  LDS_WAIT(); } } while (0)
            V_FIN6(0); V_FIN6(1); V_FIN6(2); V_FIN6(3);
#undef V_FIN6
#undef V6_HB
        }
#elif GATHER_VMMA
            f32x4 vc0[8], vc1[8], vc2[8], vc3[8];
#pragma unroll
            for (int t = 0; t < 8; ++t) { vc0[t] = (f32x4){0.f, 0.f, 0.f, 0.f}; vc1[t] = vc0[t]; vc2[t] = vc0[t]; vc3[t] = vc0[t]; }
            const int vn = lane & 15, vg = lane >> 4;
            const unsigned char* PVl = PV + 16 * vn;
            { u32x4 Ar[8], Br[8]; unsigned Aw[2], Bw[2];
#define V_LOAD4(X, O, S, C) do { const u32x2 ew_ = ((const LAS u32x2*)(lst + (S) * 1024))[4 * (C) + vg]; X##w[(O) >> 2] = ew_.y; const unsigned char* rp_ = PVl + (size_t)ew_.x * D_MODEL; \
                _Pragma("unroll") for (int s2 = 0; s2 < 4; ++s2) X##r[(O) + s2] = *(const u32x4*)(rp_ + 256 * s2); } while (0)
#define V_MMA(X, O, S) do { const float w64_ = fminf(__uint_as_float(X##w[(O) >> 2]) * 4096.f, 440.f); \
                const int hi8_ = __builtin_amdgcn_cvt_pk_fp8_f32(w64_, 0.f, 0, false); const float hif_ = __builtin_amdgcn_cvt_pk_f32_fp8(hi8_, false)[0]; \
                const int lo8_ = __builtin_amdgcn_cvt_pk_fp8_f32((w64_ - hif_) * 16.f, 0.f, 0, false); \
                const unsigned sh_ = (unsigned)((vn < 8 ? hi8_ : lo8_) & 0xff) << (8 * (vn & 3)); \
                const long a_ = (long)(((unsigned long long)((vn & 4) ? sh_ : 0u) << 32) | (unsigned long long)((vn & 4) ? 0u : sh_)); \
                _Pragma("unroll") for (int s2 = 0; s2 < 4; ++s2) { const u32x4 d_ = X##r[(O) + s2]; \
                    vc##S[2 * s2] = __builtin_amdgcn_mfma_f32_16x16x32_fp8_fp8(a_, (long)(((unsigned long long)d_.y << 32) | d_.x), vc##S[2 * s2], 0, 0, 0); \
                    vc##S[2 * s2 + 1] = __builtin_amdgcn_mfma_f32_16x16x32_fp8_fp8(a_, (long)(((unsigned long long)d_.w << 32) | d_.z), vc##S[2 * s2 + 1], 0, 0, 0); } } while (0)
            V_LOAD4(A, 0, 0, 0); V_LOAD4(A, 4, 1, 0);
#pragma unroll 1
            for (int c = 0; c < 32; ++c) {
                V_LOAD4(B, 0, 2, c); V_LOAD4(B, 4, 3, c); V_MMA(A, 0, 0); V_MMA(A, 4, 1); __builtin_amdgcn_sched_barrier(0);
                if (c < 31) { V_LOAD4(A, 0, 0, c + 1); V_LOAD4(A, 4, 1, c + 1); }
                V_MMA(B, 0, 2); V_MMA(B, 4, 3); __builtin_amdgcn_sched_barrier(0);
            }
#undef V_LOAD4
#undef V_MMA
            }
#define V_FIN(S) do { const float sc_ = vg < 2 ? (1.f / 4096.f) : (1.f / 65536.f); const int cb_ = 16 * vn + 8 * (vg >> 1) + 4 * (vg & 1); float s3_ = 0.f; f32x4 h3_[4]; \
                _Pragma("unroll") for (int s2 = 0; s2 < 4; ++s2) { f32x4 a_; \
                    _Pragma("unroll") for (int r = 0; r < 4; ++r) { const float x0_ = vc##S[2 * s2][r] * sc_, x1_ = vc##S[2 * s2 + 1][r] * sc_; \
                        const auto p0_ = __builtin_amdgcn_permlane32_swap(__float_as_uint(x0_), __float_as_uint(x0_), false, false); const auto p1_ = __builtin_amdgcn_permlane32_swap(__float_as_uint(x1_), __float_as_uint(x1_), false, false); \
                        const float y0_ = __uint_as_float(p0_[0]) + __uint_as_float(p0_[1]), y1_ = __uint_as_float(p1_[0]) + __uint_as_float(p1_[1]); a_[r] = (vg >> 1) ? y1_ : y0_; } \
                    const u32x2 hb_ = *(const LAS u32x2*)(wb + 512 + 4096 + S * 2048 + 2 * (256 * s2 + cb_)); \
                    h3_[s2] = (f32x4){bf_lo(hb_.x), bf_hi(hb_.x), bf_lo(hb_.y), bf_hi(hb_.y)} + a_ * amp; \
                    s3_ += h3_[s2][0] * h3_[s2][0] + h3_[s2][1] * h3_[s2][1] + h3_[s2][2] * h3_[s2][2] + h3_[s2][3] * h3_[s2][3]; } \
                const float r3_ = 1.f / sqrtf(wave_sum(s3_) * (1.f / D_MODEL) + RMS_EPS); \
                if (tok0 + S < T_TOK) { _Pragma("unroll") for (int s2 = 0; s2 < 4; ++s2) { const f32x4 gq_ = *(const f32x4*)(p.in[29] + 256 * s2 + cb_); \
                    *(f32x4*)(p.out + (size_t)(tok0 + S) * D_MODEL + 256 * s2 + cb_) = h3_[s2] * r3_ * gq_; } } } while (0)
            V_FIN(0); V_FIN(1); V_FIN(2); V_FIN(3);
#undef V_FIN
        }
#else
#pragma unroll
            for (int j = 0; j < 16; ++j) { ac0[j] = 0.f; ac1[j] = 0.f; ac2[j] = 0.f; ac3[j] = 0.f; }
#define V_LOAD2(X, S0, C) do { _Pragma("unroll") for (int i = 0; i < 8; ++i) { const size_t e_ = (size_t)(unsigned)__builtin_amdgcn_readfirstlane((int)((const LAS u32x2*)(lst + ((S0) + (i >> 2)) * 1024))[4 * (C) + (i & 3)].x); \
                X##r[i] = *(const u32x4*)(PV + e_ * D_MODEL + 16 * lane); } } while (0)
#define V_ACC(X, O, S, C) do { LAS const u32x2* le_ = (const LAS u32x2*)(lst + S * 1024) + 4 * (C); \
                _Pragma("unroll") for (int i = 0; i < 4; ++i) { const float w_ = __builtin_bit_cast(float, __builtin_amdgcn_readfirstlane((int)le_[i].y)); float vf[16]; unpack_fp8x16(X##r[(O) + i], vf); \
                    _Pragma("unroll") for (int j = 0; j < 16; ++j) ac##S[j] = fmaf(w_, vf[j], ac##S[j]); } } while (0)
            V_LOAD2(A, 0, 0);
#pragma unroll 1
            for (int c = 0; c < 32; ++c) {
                V_LOAD2(B, 2, c); V_ACC(A, 0, 0, c); V_ACC(A, 4, 1, c); __builtin_amdgcn_sched_barrier(0);
                if (c < 31) V_LOAD2(A, 0, c + 1);
                V_ACC(B, 0, 2, c); V_ACC(B, 4, 3, c); __builtin_amdgcn_sched_barrier(0);
            }
#undef V_LOAD2
#undef V_ACC
        }
        GS_FIN(0); GS_FIN(1); GS_FIN(2); GS_FIN(3);
#endif
#elif GNT == 4
        GS_DECL(0); GS_DECL(1); GS_DECL(2); GS_DECL(3); GS_SETUP(0); GS_SETUP(1); GS_SETUP(2); GS_SETUP(3);
        G_LOAD(A, 0, 0);
#pragma unroll 1
        for (int c = 0; c < 32; ++c) {
            G_LOAD(B, 1, c); G_PROC(A, 0, c); __builtin_amdgcn_sched_barrier(0);
            G_LOAD(A, 2, c); G_PROC(B, 1, c); __builtin_amdgcn_sched_barrier(0);
            G_LOAD(B, 3, c); G_PROC(A, 2, c); __builtin_amdgcn_sched_barrier(0);
            if (c < 31) G_LOAD(A, 0, c + 1);
            G_PROC(B, 3, c); __builtin_amdgcn_sched_barrier(0);
        }
        GS_FIN(0); GS_FIN(1); GS_FIN(2); GS_FIN(3);
#else
        GS_DECL(0); GS_SETUP(0);
        G_LOAD(A, 0, 0);
#pragma unroll 1
        for (int c = 0; c < 32; c += 2) {
            G_LOAD(B, 0, c + 1); G_PROC(A, 0, c);
            if (c < 30) G_LOAD(A, 0, c + 2);
            G_PROC(B, 0, c + 1);
        }
        GS_FIN(0);
#endif
#undef GS_DECL
#undef GS_AMAX
#undef GS_KEEP
#undef GS_HX
#undef GS_SETUP
#undef GS_FIN
#undef G_LOAD
#undef G_PROC
    }
}
#define XB_TMO      128
#define XB_XCNT(j)  (256  + 64 * (j))
#define XB_XSUB(j)  (1280 + 64 * (j))
#define XB_XGEN(j)  (2304 + 64 * (j))
#define XB_TOP      3328
#define XB_TOPGEN   3392
#define XCD_BAR_WORDS 3456
#define XB_SPIN_CAP (1u << 18)

__device__ __forceinline__ unsigned xb_ld(unsigned* p)              { return __hip_atomic_load(p, __ATOMIC_RELAXED, __HIP_MEMORY_SCOPE_AGENT); }
__device__ __forceinline__ unsigned xb_add(unsigned* p, unsigned v) { return __hip_atomic_fetch_add(p, v, __ATOMIC_RELAXED, __HIP_MEMORY_SCOPE_AGENT); }
__device__ __forceinline__ unsigned xb_xcc_id() { return (unsigned)__builtin_amdgcn_s_getreg((3 << 11) | 20) & 0xFu; }
#define XB_SPIN(cond, bar) do { unsigned _sp = 0; while (cond) { __builtin_amdgcn_s_sleep(1); \
    if ((++_sp & 255u) == 0u) { if (xb_ld(&(bar)[XB_TMO])) break; if (_sp > XB_SPIN_CAP) { atomicAdd(&(bar)[XB_TMO], 1u); break; } } } } while (0)

struct XcdBarrier {
    unsigned* bar; unsigned x;
    volatile LAS unsigned* st;
};

__device__ __forceinline__ XcdBarrier xcd_barrier_post(unsigned* bar, volatile LAS unsigned* st) {
    XcdBarrier b; b.bar = bar; b.x = xb_xcc_id(); b.st = st;
    if (threadIdx.x == 0) (void)xb_add(&bar[XB_XCNT(b.x)], 1u);
    return b;
}
__device__ __forceinline__ void xcd_barrier_complete(unsigned* bar, unsigned x, unsigned& nloc, unsigned& nx) {
    const unsigned G = gridDim.x * gridDim.y * gridDim.z;
    unsigned sum, cnt, mine, sp = 0u;
    for (;;) {
        sum = 0u; cnt = 0u; mine = 0u;
#pragma unroll
        for (unsigned j = 0; j < 16; ++j) { const unsigned c = xb_ld(&bar[XB_XCNT(j)]); sum += c; cnt += (c > 0u) ? 1u : 0u; mine = (j == x) ? c : mine; }
        if (sum == G) break;
        __builtin_amdgcn_s_sleep(1);
        if ((++sp & 255u) == 0u) { if (xb_ld(&bar[XB_TMO])) break; if (sp > XB_SPIN_CAP) { atomicAdd(&bar[XB_TMO], 1u); break; } }
    }
    nloc = mine > 0u ? mine : 1u; nx = cnt > 0u ? cnt : 1u;
}

__device__ __forceinline__ void xcd_barrier(const XcdBarrier& b) {
    asm volatile("s_waitcnt vmcnt(0)" ::: "memory");
    __syncthreads();
    if (threadIdx.x == 0) {
        unsigned* bar = b.bar;
        __builtin_amdgcn_s_waitcnt(0);
        unsigned nloc = b.st[0], nx = b.st[1];
        if (nloc == 0u) { xcd_barrier_complete(bar, b.x, nloc, nx); b.st[0] = nloc; b.st[1] = nx; }
        const unsigned old = xb_add(&bar[XB_XSUB(b.x)], 1u);
        const unsigned gen = old / nloc;
        if (old + 1u == (gen + 1u) * nloc) {
            __builtin_amdgcn_fence(__ATOMIC_RELEASE, "agent");
            asm volatile("s_waitcnt vmcnt(0)" ::: "memory");
            const unsigned og = xb_add(&bar[XB_TOP], 1u);
            const unsigned tg = og / nx;
            if (og + 1u == (tg + 1u) * nx) xb_add(&bar[XB_TOPGEN], 1u);
            else XB_SPIN(xb_ld(&bar[XB_TOPGEN]) == tg, bar);
            __builtin_amdgcn_fence(__ATOMIC_ACQUIRE, "agent");
            xb_add(&bar[XB_XGEN(b.x)], 1u);
            asm volatile("s_waitcnt vmcnt(0)" ::: "memory");
        } else {
            XB_SPIN(xb_ld(&bar[XB_XGEN(b.x)]) == gen, bar);
            __builtin_amdgcn_fence(__ATOMIC_ACQUIRE, "agent");
            asm volatile("s_waitcnt vmcnt(0)" ::: "memory");
        }
    }
    __syncthreads();
}
template <> __device__ __forceinline__ void bar_sync<XcdBarrier>(const XcdBarrier& b) { xcd_barrier(b); }
#ifndef STAGE_MIX
#define STAGE_MIX 0
#endif
#ifndef STAGE_CROSS
#define STAGE_CROSS 1
#endif
#ifndef USE_A
#define USE_A 1
#endif
#ifndef USE_B
#define USE_B 1
#endif
#ifndef AMP_MIX
#define AMP_MIX 1.f
#endif
#ifndef DUP_EMASK
#define DUP_EMASK 0xffffffffu
#endif
#ifndef GATHER_SYNC
#define GATHER_SYNC 0
#endif
#ifndef DUP_PHASE
#define DUP_PHASE 0
#endif
#ifndef AMP_PEER
#define AMP_PEER 1.f
#endif
#ifndef AMP_CROSS
#define AMP_CROSS 1.f
#endif
#ifndef STAGE_PEER
#define STAGE_PEER 0
#endif
__device__ __forceinline__ void h_from_x(const Params& p, int wave, int lane) {
    const int gw = blockIdx.x * NWAVES + wave, NGW = gridDim.x * NWAVES;
    for (int m = gw; m < T_TOK; m += NGW) {
        const f32x4* xr = (const f32x4*)(p.in[0] + (size_t)m * D_MODEL) + lane; u32x2* o8 = (u32x2*)((bf16_t*)(p.ws + WS_H) + (size_t)m * D_MODEL) + lane; float s = 0.f;
#pragma unroll
        for (int j = 0; j < 4; ++j) { const f32x4 v = xr[64 * j]; s += (v.x * v.x + v.y * v.y) + (v.z * v.z + v.w * v.w); u32x2 w; w.x = pk_bf16(v.x, v.y); w.y = pk_bf16(v.z, v.w); o8[64 * j] = w; }
        s = wave_sum(s);
        if (lane < 16) ((float*)(p.ws + WS_SSQ1))[(size_t)m * 16 + lane] = lane == 0 ? s : 0.f;
    }
}
__global__ void __launch_bounds__(NTHREADS, 2) fwd_megakernel(Params p) {
    extern __shared__ __attribute__((aligned(16))) unsigned char lds_raw[];
    LAS unsigned char* lds = (LAS unsigned char*)lds_raw;
    cg::grid_group grid = cg::this_grid();
    const int wave = __builtin_amdgcn_readfirstlane((int)threadIdx.x >> 6);
#define FRESH_TID() int tid = threadIdx.x; asm volatile("" : "+v"(tid)); const int lane = tid & 63
    unsigned char* ws = p.ws;
    const int G = gridDim.x, bx = blockIdx.x;
    volatile LAS unsigned* bst = (volatile LAS unsigned*)(lds + LDS_BYTES - 16);
    if (threadIdx.x < 4) bst[threadIdx.x] = 0u;
    __syncthreads();
    const XcdBarrier bar = xcd_barrier_post((unsigned*)(ws + WS_CTL), bst);
#define GRID_BAR() xcd_barrier(bar)
    { FRESH_TID(); p0_prologue(p, lds, wave, lane); }
#if DUP_PHASE == 5
    { FRESH_TID(); __syncthreads(); p0_prologue(p, lds, wave, lane); }
#endif
    grid.sync();
#if STAGE_MIX
#if PROJ_FP8 == 3
    {
        {   pg8::Gemm g{(const bf16_t*)p.out, (const bf16_t*)(ws + WS_WINA), T_TOK, N_PROJA - 256 * PROJ_SK_N, 512}; pg8::StaticOrder S; S.init(T_TOK, N_PROJA - 256 * PROJ_SK_N, G, bx);
            pg8::EpiProj E{(bf16_t*)(ws + WS_Q), (bf16_t*)(ws + WS_K), (bf16_t*)(ws + WS_V), (bf16_t*)(ws + WS_RW), (const bf16_t*)(ws + WS_ROPE_C), 0.125f * LOG2E, 0, 1.f / GATE_WSCALE, 0, PROJ_SK_LO, PROJ_SK_N};
            pg8::gemm_phase<pg8::EpiProj, pg8::StaticOrder, true, true, 1>(lds, g, S, E); }
        {   pg8::Gemm g{(const bf16_t*)(ws + WS_XN), (const bf16_t*)(ws + WS_WINA + (size_t)(N_PROJA - 256 * PROJ_SK_N) * 1024), T_TOK, 256 * PROJ_SK_N, 1024}; pg8::StaticOrder S; S.init(T_TOK, 256 * PROJ_SK_N, G, bx);
            pg8::EpiProj E{(bf16_t*)(ws + WS_Q), (bf16_t*)(ws + WS_K), (bf16_t*)(ws + WS_V), (bf16_t*)(ws + WS_RW), (const bf16_t*)(ws + WS_ROPE_C), 0.125f * LOG2E, 0, 1.f, PROJ_SK_LO, 1000, 0};
            pg8::gemm_phase<pg8::EpiProj, pg8::StaticOrder, true, true>(lds, g, S, E); }
    }
#elif PROJ_FP8 == 2
    {
#define PROJ_RUN(LO, HI, F8) do { \
        pg8::Gemm g{(F8) ? (const bf16_t*)p.out : (const bf16_t*)(ws + WS_XN), (const bf16_t*)(ws + WS_WINA + (size_t)(LO) * 256 * 2048), T_TOK, ((HI) - (LO)) * 256, (F8) ? 512 : 1024}; \
        pg8::StaticOrder S; S.init(T_TOK, ((HI) - (LO)) * 256, G, bx); \
        pg8::EpiProj E{(bf16_t*)(ws + WS_Q), (bf16_t*)(ws + WS_K), (bf16_t*)(ws + WS_V), (bf16_t*)(ws + WS_RW), (const bf16_t*)(ws + WS_ROPE_C), 0.125f * LOG2E, 0, (F8) ? 1.f / GATE_WSCALE : 1.f, (LO)}; \
        pg8::gemm_phase<pg8::EpiProj, pg8::StaticOrder, true, true, ((F8) ? 1 : 0)>(lds, g, S, E); } while (0)
        PROJ_RUNS(PROJ_RUN);
#undef PROJ_RUN
    }
#else
    {
#if PROJ_FP8 && PROJ_I8
        pg8::Gemm g{(const bf16_t*)p.out, (const bf16_t*)(ws + WS_WINA), T_TOK, N_PROJA, 512, (const float*)(ws + WS_SX), (const float*)(ws + WS_SWA)}; pg8::StaticOrder S; S.init(T_TOK, N_PROJA, G, bx);
        constexpr float POSC = 1.f; constexpr int PF8 = 2;
#elif PROJ_FP8
        pg8::Gemm g{(const bf16_t*)p.out, (const bf16_t*)(ws + WS_WINA), T_TOK, N_PROJA, 512}; pg8::StaticOrder S; S.init(T_TOK, N_PROJA, G, bx);
        constexpr float POSC = 1.f / GATE_WSCALE; constexpr int PF8 = 1;
#else
        pg8::Gemm g{(const bf16_t*)(ws + WS_XN), (const bf16_t*)(ws + WS_WINA), T_TOK, N_PROJA, 1024}; pg8::StaticOrder S; S.init(T_TOK, N_PROJA, G, bx);
        constexpr float POSC = 1.f; constexpr int PF8 = 0;
#endif
#if DUP_PHASE == 8
        { pg8::EpiProj E0{(bf16_t*)(ws + WS_Q), (bf16_t*)(ws + WS_K), (bf16_t*)(ws + WS_V), (bf16_t*)(ws + WS_RW), (const bf16_t*)(ws + WS_ROPE_C), 0.125f * LOG2E, 1, POSC, 0};
          pg8::gemm_phase<pg8::EpiProj, pg8::StaticOrder, true, true, PF8>(lds, g, S, E0); }
#endif
        pg8::EpiProj E{(bf16_t*)(ws + WS_Q), (bf16_t*)(ws + WS_K), (bf16_t*)(ws + WS_V), (bf16_t*)(ws + WS_RW), (const bf16_t*)(ws + WS_ROPE_C), 0.125f * LOG2E, 0, POSC, 0};
        pg8::gemm_phase<pg8::EpiProj, pg8::StaticOrder, true, true, PF8>(lds, g, S, E);
#if DUP_PHASE == 4
        pg8::gemm_phase<pg8::EpiProj, pg8::StaticOrder, true, true, PF8>(lds, g, S, E);
#endif
    }
#endif
    GRID_BAR();
#if USE_B
    { FRESH_TID(); rwkv_act_phase(p, wave, lane); }
#endif
#if USE_A
    { FRESH_TID(); swa_phase(p, lds, tid, wave, lane); }
#endif
#if USE_B
    GRID_BAR();
    { FRESH_TID(); rwkv_phase(p, lds, tid, wave, lane); }
#if DUP_PHASE == 3
    { FRESH_TID(); rwkv_phase(p, lds, tid, wave, lane); }
#endif
#endif
    GRID_BAR();
    {
#if GATE_FP8 && PROJ_I8
#if G2_I8
        pg8::Gemm g{(const bf16_t*)p.out, (const bf16_t*)(ws + WS_WING), T_TOK, 2048, 512, (const float*)(ws + WS_SX), (const float*)(ws + WS_SWG)}; pg8::RowOrder S; S.init(T_TOK, 2048, G, bx);
        pg8::EpiGate E{(bf16_t*)(ws + WS_Q), (const bf16_t*)(ws + WS_Y), USE_A, USE_B, -LOG2E};
        pg8::gemm_phase<pg8::EpiGate, pg8::RowOrder, true, true, 2>(lds, g, S, E);
        {   FRESH_TID(); __syncthreads();
            for (int pm = bx; pm < T_TOK / 256; pm += G) quant_tile_rows_i8((const bf16_t*)(ws + WS_Q), (unsigned char*)p.out + OUT_MIX8, (float*)(ws + WS_SX3), pm, wave, lane);
            __syncthreads(); }
#else
        pg8::Gemm g{(const bf16_t*)p.out, (const bf16_t*)(ws + WS_WING), T_TOK, 2048, 512, (const float*)(ws + WS_SX), (const float*)(ws + WS_SWG)}; pg8::StaticOrder S; S.init(T_TOK, 2048, G, bx);
        pg8::EpiGate E{(bf16_t*)(ws + WS_Q), (const bf16_t*)(ws + WS_Y), USE_A, USE_B, -LOG2E};
        pg8::gemm_phase<pg8::EpiGate, pg8::StaticOrder, true, true, 2>(lds, g, S, E);
#endif
#elif GATE_FP8
        pg8::Gemm g{(const bf16_t*)p.out, (const bf16_t*)(ws + WS_WING), T_TOK, 2048, 512}; pg8::StaticOrder S; S.init(T_TOK, 2048, G, bx);
        pg8::EpiGate E{(bf16_t*)(ws + WS_Q), (const bf16_t*)(ws + WS_Y), USE_A, USE_B, -LOG2E / GATE_WSCALE};
        pg8::gemm_phase<pg8::EpiGate, pg8::StaticOrder, true, true, 1>(lds, g, S, E);
#else
        pg8::Gemm g{(const bf16_t*)(ws + WS_XN), (const bf16_t*)(ws + WS_WING), T_TOK, 2048, 1024}; pg8::StaticOrder S; S.init(T_TOK, 2048, G, bx);
        pg8::EpiGate E{(bf16_t*)(ws + WS_Q), (const bf16_t*)(ws + WS_Y), USE_A, USE_B, -LOG2E};
        pg8::gemm_phase<pg8::EpiGate, pg8::StaticOrder, true, true>(lds, g, S, E);
#endif
    }
#if !(GATE_FP8 && PROJ_I8 && G2_I8)
    GRID_BAR();
#endif
    {
#if GATE_FP8 && PROJ_I8 && G2_I8
        pg8::Gemm g{(const bf16_t*)((unsigned char*)p.out + OUT_MIX8), (const bf16_t*)(ws + WS_WOUT), T_TOK, 1024, 512, (const float*)(ws + WS_SX3), (const float*)(ws + WS_SWO)}; pg8::RowOrder S; S.init(T_TOK, 1024, G, bx);
        pg8::EpiRes<true> E{p.in[0], (bf16_t*)(ws + WS_H), (float*)(ws + WS_SSQ1), AMP_MIX};
        pg8::gemm_phase<pg8::EpiRes<true>, pg8::RowOrder, true, true, 2>(lds, g, S, E);
#else
        pg8::Gemm g{(const bf16_t*)(ws + WS_Q), (const bf16_t*)(ws + WS_WOUT), T_TOK, 1024, 1024}; pg8::StaticOrder S; S.init(T_TOK, 1024, G, bx);
        pg8::EpiRes<true> E{p.in[0], (bf16_t*)(ws + WS_H), (float*)(ws + WS_SSQ1), AMP_MIX};
        pg8::gemm_phase<pg8::EpiRes<true>, pg8::StaticOrder, true, true>(lds, g, S, E);
#endif
    }
#if GATE_FP8 && PROJ_I8 && G2_I8 && STAGE_CROSS
    __syncthreads();
#else
    GRID_BAR();
#endif
#else
    { FRESH_TID(); h_from_x(p, wave, lane); }
#endif
#if STAGE_CROSS
    {
#if STAGE_MIX && GATE_FP8 && PROJ_I8 && G2_I8
        pg8::Gemm g{(const bf16_t*)(ws + WS_H), (const bf16_t*)(ws + WS_WQC), T_TOK, 512, 1024}; pg8::RowOrder S; S.init(T_TOK, 512, G, bx);
        pg8::EpiScaled E{(bf16_t*)(ws + WS_QC), 512, (const float*)(ws + WS_SSQ1), 0.08838834764831845f * LOG2E};
        pg8::gemm_phase<pg8::EpiScaled, pg8::RowOrder, true, true>(lds, g, S, E);
#else
        pg8::Gemm g{(const bf16_t*)(ws + WS_H), (const bf16_t*)(ws + WS_WQC), T_TOK, 512, 1024}; pg8::StaticOrder S; S.init(T_TOK, 512, G, bx);
        pg8::EpiScaled E{(bf16_t*)(ws + WS_QC), 512, (const float*)(ws + WS_SSQ1), 0.08838834764831845f * LOG2E};
        pg8::gemm_phase<pg8::EpiScaled, pg8::StaticOrder, true, true>(lds, g, S, E);
#endif
    }
    {
        pg8::Gemm g{(const bf16_t*)(ws + WS_MEMN), (const bf16_t*)(ws + WS_WKVC), MEM_ROWS, 1024, 1024}; pg8::StaticOrder S; S.init(MEM_ROWS, 1024, G, (bx + G / 2) % G);
        pg8::EpiPlain E{(bf16_t*)(ws + WS_KVC), 1024};
        pg8::gemm_phase<pg8::EpiPlain, pg8::StaticOrder, true, true>(lds, g, S, E);
    }
    GRID_BAR();
    { FRESH_TID(); cross_phase(p, lds, tid, wave, lane); }
    GRID_BAR();
    {
#if CROSS_FP8
        pg8::Gemm g{(const bf16_t*)(ws + WS_QC8), (const bf16_t*)(ws + WS_WOC), T_TOK, 1024, 256}; pg8::StaticOrder S; S.init(T_TOK, 1024, G, bx);
        pg8::EpiRes<false> E{nullptr, (bf16_t*)(ws + WS_H), (float*)(ws + WS_SSQ2), AMP_CROSS / (CROSS_OSCALE * CROSS_WSCALE)};
        pg8::gemm_phase<pg8::EpiRes<false>, pg8::StaticOrder, true, true, true>(lds, g, S, E);
#else
#if PROJ_I8 && PQ_I8 && STAGE_PEER
        pg8::Gemm g{(const bf16_t*)(ws + WS_QC), (const bf16_t*)(ws + WS_WOC), T_TOK, 1024, 512}; pg8::RowOrder S; S.init(T_TOK, 1024, G, bx);
        pg8::EpiRes<false> E{nullptr, (bf16_t*)(ws + WS_H), (float*)(ws + WS_SSQ2), AMP_CROSS};
        pg8::gemm_phase<pg8::EpiRes<false>, pg8::RowOrder, true, true>(lds, g, S, E);
        {
            FRESH_TID(); __syncthreads();
            for (int pm = bx; pm < T_TOK / 256; pm += G) quant_tile_rows_i8((const bf16_t*)(ws + WS_H), ws + WS_H8, (float*)(ws + WS_SX2), pm, wave, lane);
            __syncthreads();
        }
#else
        pg8::Gemm g{(const bf16_t*)(ws + WS_QC), (const bf16_t*)(ws + WS_WOC), T_TOK, 1024, 512}; pg8::StaticOrder S; S.init(T_TOK, 1024, G, bx);
        pg8::EpiRes<false> E{nullptr, (bf16_t*)(ws + WS_H), (float*)(ws + WS_SSQ2), AMP_CROSS};
        pg8::gemm_phase<pg8::EpiRes<false>, pg8::StaticOrder, true, true>(lds, g, S, E);
#endif
#endif
    }
#if !(PROJ_I8 && PQ_I8 && STAGE_PEER)
    GRID_BAR();
#endif
#endif
#if STAGE_PEER
    {
#if PROJ_I8 && PQ_I8 && STAGE_CROSS
        pg8::Gemm g{(const bf16_t*)(ws + WS_H8), (const bf16_t*)(ws + WS_WPQ), T_TOK, 2048, 512, (const float*)(ws + WS_SX2), (const float*)(ws + WS_SWP)}; pg8::RowOrder S; S.init(T_TOK, 2048, G, bx);
        pg8::EpiScaled E{(bf16_t*)(ws + WS_PQ), 2048, (const float*)(ws + WS_SSQ2), 1.f};
        pg8::gemm_phase<pg8::EpiScaled, pg8::RowOrder, true, true, 2>(lds, g, S, E);
#else
        pg8::Gemm g{(const bf16_t*)(ws + WS_H), (const bf16_t*)(ws + WS_WPQ), T_TOK, 2048, 1024}; pg8::StaticOrder S; S.init(T_TOK, 2048, G, bx);
        pg8::EpiScaled E{(bf16_t*)(ws + WS_PQ), 2048, (const float*)(ws + (STAGE_CROSS ? WS_SSQ2 : WS_SSQ1)), 1.f};
        pg8::gemm_phase<pg8::EpiScaled, pg8::StaticOrder, true, true>(lds, g, S, E);
#endif
#if DUP_PHASE == 6
        pg8::gemm_phase<pg8::EpiScaled, pg8::StaticOrder, true, true>(lds, g, S, E);
#endif
    }
#if PROJ_I8 && PQ_I8 && STAGE_CROSS && !PEER_FUSED
    __syncthreads();
#else
    GRID_BAR();
#endif
#if !PEER_FUSED
    { FRESH_TID(); peer_route_phase(p, lds, tid, wave, lane); }
#if DUP_PHASE == 2
    { FRESH_TID(); peer_route_phase(p, lds, tid, wave, lane); }
#endif
    GRID_BAR();
#endif
    { FRESH_TID(); peer_gather_phase(p, lds, wave, lane, AMP_PEER, bar); }
#if DUP_PHASE == 1
    { FRESH_TID(); peer_gather_phase(p, lds, wave, lane, AMP_PEER, bar); }
#endif
#else
    { FRESH_TID(); final_norm_rows((const bf16_t*)(ws + WS_H), p.in[29], p.out, wave, lane); }
#endif
}

extern "C" void kernel_launch(void* const* d_in, const int* in_sizes, int n_in, void* d_out, int out_size, void* d_ws, size_t ws_size, hipStream_t stream) {
    static int grid_blocks = 0;
    if (grid_blocks == 0) {
        if (n_in != 30 || in_sizes[0] != T_TOK * D_MODEL || out_size != T_TOK * D_MODEL || ws_size < WS_END) {
            fprintf(stderr, "kernel_launch: unexpected shapes: n_in %d in0 %d out %d ws %zu (need %zu)\n", n_in, n_in > 0 ? in_sizes[0] : -1, out_size, ws_size, (size_t)WS_END); grid_blocks = -1; return; }
        int dev = 0, cus = 0, per_cu = 0;
        (void)hipGetDevice(&dev);
        (void)hipDeviceGetAttribute(&cus, hipDeviceAttributeMultiprocessorCount, dev);
        (void)hipFuncSetAttribute((const void*)fwd_megakernel, hipFuncAttributeMaxDynamicSharedMemorySize, LDS_BYTES);
        (void)hipOccupancyMaxActiveBlocksPerMultiprocessor(&per_cu, (const void*)fwd_megakernel, NTHREADS, LDS_BYTES);
        if (per_cu < 1) { fprintf(stderr, "kernel_launch: occupancy query says %d blocks per CU\n", per_cu); per_cu = 1; }
        if (per_cu > 1) per_cu = 1;
        grid_blocks = cus * per_cu;
    }
    if (grid_blocks < 0) return;
    (void)hipMemsetAsync((char*)d_ws + WS_CTL, 0, 65536, stream);
    Params p{};
    for (int i = 0; i < 30; ++i) p.in[i] = (const float*)d_in[i];
    p.out = (float*)d_out; p.ws = (unsigned char*)d_ws;
    void* args[] = {&p};
    hipError_t e = hipLaunchCooperativeKernel((const void*)fwd_megakernel, dim3(grid_blocks), dim3(NTHREADS), args, LDS_BYTES, stream);
    if (e != hipSuccess) fprintf(stderr, "cooperative launch failed: %s (grid %d)\n", hipGetErrorString(e), grid_blocks);
}
```
